# Optimizing an MI355X kernel written in HIP

```python
import math
import jax, jax.numpy as jnp
from jax import lax
import numpy as np

D_MODEL = 1024
BATCH = 2
SEQ = 8192
DEPTH = 4

HEAD_DIM = 64
ROPE_THETA = 10000.0
EPS = 1e-6
SWA_WIDTH = D_MODEL // 2
SWA_Q_HEADS = SWA_WIDTH // HEAD_DIM
SWA_KV_HEADS = SWA_Q_HEADS // 4
SWA_GROUP = SWA_Q_HEADS // SWA_KV_HEADS
WINDOW = 128
BLOCK = 128
DIFF_V_DIM = 2 * HEAD_DIM
DIFF_WIDTH = D_MODEL - SWA_WIDTH
DIFF_HEADS = DIFF_WIDTH // DIFF_V_DIM
MIX_WIDTH = SWA_WIDTH + DIFF_WIDTH
COL_QA = SWA_Q_HEADS * HEAD_DIM
COL_KA = SWA_KV_HEADS * HEAD_DIM
COL_VA = SWA_KV_HEADS * HEAD_DIM
COL_QD = DIFF_HEADS * 2 * HEAD_DIM
COL_KD = DIFF_HEADS * 2 * HEAD_DIM
COL_VD = DIFF_HEADS * DIFF_V_DIM
IN_COLS = COL_QA + COL_KA + COL_VA + COL_QD + COL_KD + COL_VD
SPLITS = [COL_QA, COL_QA + COL_KA, COL_QA + COL_KA + COL_VA,
          COL_QA + COL_KA + COL_VA + COL_QD,
          COL_QA + COL_KA + COL_VA + COL_QD + COL_KD]
D_FF = 3584
N_EXPERTS = 8
TOP_K = 2
MOE_ROWS = 256
N_DENSE = (DEPTH + 1) // 2
N_MOE = DEPTH // 2
N_MOD = 6

kernel_name = "hybrid_swa_sink_diffattn_moe_adaln_encoder"


def rms_norm(x, g):
    xf = x.astype(jnp.float32)
    y = xf * lax.rsqrt(jnp.mean(xf * xf, axis=-1, keepdims=True) + EPS)
    return (y * g.astype(jnp.float32)).astype(x.dtype)


def rope_tables(positions):
    inv = 1.0 / (ROPE_THETA ** (jnp.arange(0, HEAD_DIM, 2, dtype=jnp.float32) / HEAD_DIM))
    ang = positions.astype(jnp.float32)[..., None] * inv
    return jnp.cos(ang)[:, :, None, :], jnp.sin(ang)[:, :, None, :]


def apply_rope(t, cos, sin):
    t1, t2 = jnp.split(t.astype(jnp.float32), 2, axis=-1)
    return jnp.concatenate([t1 * cos - t2 * sin, t2 * cos + t1 * sin], axis=-1).astype(t.dtype)


def window_attention(q, k, v, sink):
    B, S = q.shape[0], q.shape[1]
    nb = S // BLOCK
    qb = q.reshape(B, nb, BLOCK, SWA_KV_HEADS, SWA_GROUP, HEAD_DIM)

    def band(t):
        tb = t.reshape(B, nb, BLOCK, SWA_KV_HEADS, HEAD_DIM)
        tp = jnp.pad(tb, ((0, 0), (1, 1), (0, 0), (0, 0), (0, 0)))
        return jnp.concatenate([tp[:, :-2], tp[:, 1:-1], tp[:, 2:]], axis=2)

    kb, vb = band(k), band(v)
    q_pos = jnp.arange(S).reshape(nb, BLOCK)
    k_pos = (jnp.arange(nb)[:, None] - 1) * BLOCK + jnp.arange(3 * BLOCK)[None, :]
    kp = k_pos[:, None, :]
    valid = (jnp.abs(q_pos[:, :, None] - kp) <= WINDOW) & (kp >= 0) & (kp < S)
    s = jnp.einsum('bnqhgd,bnkhd->bnhgqk', qb, kb,
                   preferred_element_type=jnp.float32) * (HEAD_DIM ** -0.5)
    s = jnp.where(valid[None, :, None, None], s, -jnp.inf)
    sk = sink.astype(jnp.float32).reshape(1, 1, SWA_KV_HEADS, SWA_GROUP, 1, 1)
    m = jnp.maximum(s.max(axis=-1, keepdims=True), sk)
    p = jnp.exp(s - m)
    p = p / (p.sum(axis=-1, keepdims=True) + jnp.exp(sk - m))
    o = jnp.einsum('bnhgqk,bnkhd->bnqhgd', p.astype(v.dtype), vb)
    return o.reshape(B, S, SWA_WIDTH)


def diff_attention(q, k, v, lam, subln_g, lambda_init):
    B, S = q.shape[0], q.shape[1]
    nb = S // BLOCK
    qb = jnp.moveaxis(q.reshape(B, nb, BLOCK, DIFF_HEADS, 2, HEAD_DIM), 1, 0)

    def one_block(q_blk):
        s = jnp.einsum('bqhcd,bkhcd->bhcqk', q_blk, k,
                       preferred_element_type=jnp.float32) * (HEAD_DIM ** -0.5)
        p = jax.nn.softmax(s, axis=-1)
        a = p[:, :, 0] - lam * p[:, :, 1]
        return jnp.einsum('bhqk,bkhe->bqhe', a.astype(v.dtype), v)

    o = lax.map(one_block, qb)
    o = jnp.moveaxis(o, 0, 1).reshape(B, S, DIFF_HEADS, DIFF_V_DIM)
    o = rms_norm(o, subln_g) * (1.0 - lambda_init)
    return o.reshape(B, S, DIFF_WIDTH)


def token_mixer(h, cos, sin, w_in, w_out, sink, lq1, lk1, lq2, lk2, subln_g, lambda_init):
    B, S = h.shape[0], h.shape[1]
    proj = h @ w_in
    qa, ka, va, qd, kd, vd = jnp.split(proj, SPLITS, axis=-1)
    qa = apply_rope(qa.reshape(B, S, SWA_Q_HEADS, HEAD_DIM), cos, sin)
    ka = apply_rope(ka.reshape(B, S, SWA_KV_HEADS, HEAD_DIM), cos, sin)
    va = va.reshape(B, S, SWA_KV_HEADS, HEAD_DIM)
    qd = apply_rope(qd.reshape(B, S, 2 * DIFF_HEADS, HEAD_DIM), cos, sin).reshape(B, S, DIFF_HEADS, 2, HEAD_DIM)
    kd = apply_rope(kd.reshape(B, S, 2 * DIFF_HEADS, HEAD_DIM), cos, sin).reshape(B, S, DIFF_HEADS, 2, HEAD_DIM)
    vd = vd.reshape(B, S, DIFF_HEADS, DIFF_V_DIM)
    lam = (jnp.exp(jnp.sum(lq1.astype(jnp.float32) * lk1.astype(jnp.float32)))
           - jnp.exp(jnp.sum(lq2.astype(jnp.float32) * lk2.astype(jnp.float32))) + lambda_init)
    ya = window_attention(qa, ka, va, sink)
    yd = diff_attention(qd, kd, vd, lam, subln_g, lambda_init)
    return jnp.concatenate([ya, yd], axis=-1) @ w_out


def swiglu(h, w_gate, w_up, w_down):
    return (jax.nn.silu(h @ w_gate) * (h @ w_up)) @ w_down


def moe_swiglu(h, router_w, w_gate, w_up, w_down):
    B, S, D = h.shape
    xt = h.reshape(-1, D)
    N = xt.shape[0]
    logits = jnp.dot(xt, router_w, preferred_element_type=jnp.float32)
    top_val, top_idx = lax.top_k(logits, TOP_K)
    top_w = jax.nn.softmax(top_val, axis=-1)
    flat_e = top_idx.reshape(-1)
    flat_tok = jnp.repeat(jnp.arange(N, dtype=jnp.int32), TOP_K)
    flat_w = top_w.reshape(-1)
    order = jnp.argsort(flat_e)
    sorted_e = flat_e[order]
    counts = jnp.bincount(flat_e, length=N_EXPERTS)
    starts = jnp.cumsum(counts) - counts
    padded = (counts + MOE_ROWS - 1) // MOE_ROWS * MOE_ROWS
    pad_ends = jnp.cumsum(padded)
    pad_starts = pad_ends - padded
    dest = pad_starts[sorted_e] + jnp.arange(N * TOP_K) - starts[sorted_e]
    P = (N * TOP_K + MOE_ROWS - 1) // MOE_ROWS * MOE_ROWS + N_EXPERTS * MOE_ROWS
    n_chunks = P // MOE_ROWS
    buf_tok = jnp.full((P,), N, jnp.int32).at[dest].set(flat_tok[order])
    buf_w = jnp.zeros((P,), jnp.float32).at[dest].set(flat_w[order])
    chunk_e = jnp.minimum(jnp.searchsorted(pad_ends, jnp.arange(n_chunks) * MOE_ROWS, side='right'),
                          N_EXPERTS - 1)
    xs = xt[jnp.minimum(buf_tok, N - 1)].reshape(n_chunks, MOE_ROWS, D)

    def expert_block(args):
        xc, e = args
        return swiglu(xc, w_gate[e], w_up[e], w_down[e])

    ys = lax.map(expert_block, (xs, chunk_e)).reshape(P, D)
    out = jnp.zeros((N, D), ys.dtype).at[buf_tok].add(ys * buf_w[:, None].astype(ys.dtype), mode='drop')
    return out.reshape(B, S, D)


def setup_inputs(seed: int = 0) -> dict:
    key = jax.random.key(seed)
    ks = jax.random.split(key, 24)
    f32 = jnp.float32
    nrm = lambda k, shape, s: jax.random.normal(k, shape, f32) * s
    D, F, E = D_MODEL, D_FF, N_EXPERTS
    return {
        "x": nrm(ks[0], (BATCH, SEQ, D), 1.0),
        "c": nrm(ks[1], (BATCH, D), 1.0),
        "positions": jnp.broadcast_to(jnp.arange(SEQ, dtype=jnp.int32)[None, :], (BATCH, SEQ)),
        "ada_w": nrm(ks[2], (DEPTH, D, N_MOD * D), D ** -0.5),
        "ada_b": nrm(ks[3], (DEPTH, N_MOD * D), 0.02),
        "norm_mix_g": 1.0 + nrm(ks[4], (DEPTH, D), 0.02),
        "norm_ffn_g": 1.0 + nrm(ks[5], (DEPTH, D), 0.02),
        "w_in": nrm(ks[6], (DEPTH, D, IN_COLS), D ** -0.5),
        "w_out": nrm(ks[7], (DEPTH, MIX_WIDTH, D), MIX_WIDTH ** -0.5),
        "sink": nrm(ks[8], (DEPTH, SWA_Q_HEADS), 0.5),
        "lam_q1": nrm(ks[9], (DEPTH, HEAD_DIM), 0.1),
        "lam_k1": nrm(ks[10], (DEPTH, HEAD_DIM), 0.1),
        "lam_q2": nrm(ks[11], (DEPTH, HEAD_DIM), 0.1),
        "lam_k2": nrm(ks[12], (DEPTH, HEAD_DIM), 0.1),
        "subln_g": 1.0 + nrm(ks[13], (DEPTH, DIFF_V_DIM), 0.02),
        "ffn_w_gate": nrm(ks[14], (N_DENSE, D, F), D ** -0.5),
        "ffn_w_up": nrm(ks[15], (N_DENSE, D, F), D ** -0.5),
        "ffn_w_down": nrm(ks[16], (N_DENSE, F, D), F ** -0.5),
        "router_w": nrm(ks[17], (N_MOE, D, E), D ** -0.5),
        "moe_w_gate": nrm(ks[18], (N_MOE, E, D, F), D ** -0.5),
        "moe_w_up": nrm(ks[19], (N_MOE, E, D, F), D ** -0.5),
        "moe_w_down": nrm(ks[20], (N_MOE, E, F, D), F ** -0.5),
        "final_g": 1.0 + nrm(ks[21], (D,), 0.02),
    }


def reference(x, c, positions, ada_w, ada_b, norm_mix_g, norm_ffn_g, w_in, w_out, sink,
              lam_q1, lam_k1, lam_q2, lam_k2, subln_g, ffn_w_gate, ffn_w_up, ffn_w_down,
              router_w, moe_w_gate, moe_w_up, moe_w_down, final_g):
    cos, sin = rope_tables(positions)
    c_act = jax.nn.silu(c)
    for layer in range(DEPTH):
        mod = c_act @ ada_w[layer] + ada_b[layer]
        sh_m, sc_m, g_m, sh_f, sc_f, g_f = [t[:, None, :] for t in jnp.split(mod, N_MOD, axis=-1)]
        lambda_init = 0.8 - 0.6 * math.exp(-0.3 * layer)
        h = rms_norm(x, norm_mix_g[layer]) * (1.0 + sc_m) + sh_m
        x = x + g_m * token_mixer(h, cos, sin, w_in[layer], w_out[layer], sink[layer],
                                  lam_q1[layer], lam_k1[layer], lam_q2[layer], lam_k2[layer],
                                  subln_g[layer], lambda_init)
        h = rms_norm(x, norm_ffn_g[layer]) * (1.0 + sc_f) + sh_f
        if layer % 2 == 0:
            i = layer // 2
            y = swiglu(h, ffn_w_gate[i], ffn_w_up[i], ffn_w_down[i])
        else:
            i = layer // 2
            y = moe_swiglu(h, router_w[i], moe_w_gate[i], moe_w_up[i], moe_w_down[i])
        x = x + g_f * y
    return rms_norm(x, final_g)
```

```cpp
#include <hip/hip_runtime.h>
#include <cstdint>
#include <cmath>
#include <cstring>

constexpr int BATCH = 2, SEQ = 8192, DM = 1024, NTOK = BATCH * SEQ, DEPTH = 4;
constexpr int INC = 2304, FF = 3584, NE = 8, NMOD = 6;
constexpr int COL_QA = 0, COL_KA = 512, COL_VA = 640, COL_QD = 768, COL_KD = 1280, COL_VD = 1792;
constexpr int PMAX = NTOK * 2 + NE * 256;
constexpr int NCHUNK_MAX = PMAX / 256;
constexpr float EPS = 1e-6f;

typedef float f32x16 __attribute__((ext_vector_type(16)));
typedef float f32x4 __attribute__((ext_vector_type(4)));

__device__ __forceinline__ float wave_sum(float v) {
#pragma unroll
    for (int o = 1; o < 64; o <<= 1) v += __shfl_xor(v, o);
    return v;
}
__device__ __forceinline__ int kap(int r, int hh) { return (r & 3) + 8 * (r >> 2) + 4 * hh; }

__global__ void __launch_bounds__(256) ora_mod(const float* c, const float* ada_w, const float* ada_b, float* mod) {
    const int idx = blockIdx.x * 256 + threadIdx.x;
    if (idx >= DEPTH * NMOD * DM) return;
    const int l = idx / (NMOD * DM), col = idx % (NMOD * DM);
    const float* w = ada_w + (size_t)l * DM * NMOD * DM + col;
    float a0 = 0.f, a1 = 0.f;
    for (int k = 0; k < DM; ++k) {
        const float wv = w[(size_t)k * NMOD * DM];
        const float c0 = c[k], c1 = c[DM + k];
        a0 += (c0 / (1.f + expf(-c0))) * wv; a1 += (c1 / (1.f + expf(-c1))) * wv;
    }
    const float bb = ada_b[l * NMOD * DM + col];
    mod[((size_t)l * 2 + 0) * NMOD * DM + col] = a0 + bb;
    mod[((size_t)l * 2 + 1) * NMOD * DM + col] = a1 + bb;
}

struct RopeFreq { float inv[32]; };
__device__ __forceinline__ void sincos_acc(float angf, float& s, float& c) {
    const double a = (double)angf;
    const double k = rint(a * 0.63661977236758134308);
    double r = fma(-k, 1.57079632679489655800e+00, a); r = fma(-k, 6.12323399573676603587e-17, r);
    const double r2 = r * r;
    double sp = -2.5052108385441718775e-08; sp = sp * r2 + 2.7557319223985890653e-06; sp = sp * r2 - 1.9841269841269841253e-04; sp = sp * r2 + 8.3333333333333332177e-03; sp = sp * r2 - 1.6666666666666665741e-01;
    const double sn = r + r * r2 * sp;
    double cp = 2.0876756987868098979e-09; cp = cp * r2 - 2.7557319223985888e-07; cp = cp * r2 + 2.4801587301587301566e-05; cp = cp * r2 - 1.3888888888888889419e-03; cp = cp * r2 + 4.1666666666666664354e-02; cp = cp * r2 - 0.5;
    const double cs = 1.0 + r2 * cp;
    const int q = ((int)k) & 3;
    const double ss = (q == 0) ? sn : (q == 1) ? cs : (q == 2) ? -sn : -cs;
    const double cc = (q == 0) ? cs : (q == 1) ? -sn : (q == 2) ? -cs : sn;
    s = (float)ss; c = (float)cc;
}
__global__ void __launch_bounds__(256) ora_rope_tab(const int* positions, RopeFreq f, float* rc, float* rs) {
    const int idx = blockIdx.x * 256 + threadIdx.x;
    const int tok = idx >> 5, i = idx & 31;
    const float ang = (float)positions[tok] * f.inv[i];
    float s, c; sincos_acc(ang, s, c);
    rc[idx] = c; rs[idx] = s;
}
__global__ void __launch_bounds__(256) ora_norm_mod(const float* x, const float* g, const float* sh, const float* sc, int mod_bstride, float* h) {
    const int row = blockIdx.x * 4 + (threadIdx.x >> 6), lane = threadIdx.x & 63, b = row / SEQ;
    const f32x4* xr = (const f32x4*)(x + (size_t)row * DM) + lane;
    f32x4 v[4]; float s = 0.f;
#pragma unroll
    for (int j = 0; j < 4; ++j) { v[j] = xr[64 * j]; s += (v[j].x * v[j].x + v[j].y * v[j].y) + (v[j].z * v[j].z + v[j].w * v[j].w); }
    const float r = 1.f / sqrtf(wave_sum(s) * (1.f / DM) + EPS);
#pragma unroll
    for (int j = 0; j < 4; ++j) {
        const int col = 4 * lane + 256 * j;
        const f32x4 gg = *(const f32x4*)(g + col);
        f32x4 o = v[j] * r * gg;
        if (sh) { const f32x4 s1 = *(const f32x4*)(sc + (size_t)b * mod_bstride + col), s0 = *(const f32x4*)(sh + (size_t)b * mod_bstride + col); o = o * (1.f + s1) + s0; }
        *(f32x4*)(h + (size_t)row * DM + col) = o;
    }
}

struct OGemm {
    const float* A; int lda;
    const float* B0; const float* B1; int ldb;
    float* C; int ldc;
    int K;
    const int* row_tok; const int* chunk_e; const int* nchunks; size_t estride;
    const float* gate; int gate_bstride;
};
template <int MODE> __global__ void __launch_bounds__(256) ora_gemm(OGemm g) {
    const int wave = threadIdx.x >> 6, lane = threadIdx.x & 63, i = lane & 31, kk = lane >> 5;
    const int row0 = blockIdx.y * 64 + (wave >> 1) * 32, col0 = blockIdx.x * 64 + (wave & 1) * 32;
    const float* B0 = g.B0; const float* B1 = g.B1;
    if (g.chunk_e) { const int ch = row0 >> 8; if (ch >= *g.nchunks) return; const size_t off = (size_t)g.chunk_e[ch] * g.estride; B0 += off; if (MODE == 2) B1 += off; }
    int arow = row0 + i; if (g.row_tok) { arow = g.row_tok[arow]; if (arow > NTOK - 1) arow = NTOK - 1; }
    const float* ap = g.A + (size_t)arow * g.lda + 4 * kk;
    const float* bp0 = B0 + (size_t)(4 * kk) * g.ldb + col0 + i;
    const float* bp1 = (MODE == 2) ? (B1 + (size_t)(4 * kk) * g.ldb + col0 + i) : nullptr;
    f32x16 acc0 = {}, acc1 = {};
    for (int k = 0; k < g.K; k += 8) {
        const f32x4 a = *(const f32x4*)(ap + k);
        float b[4], d[4];
#pragma unroll
        for (int j = 0; j < 4; ++j) { b[j] = bp0[(size_t)(k + j) * g.ldb]; if (MODE == 2) d[j] = bp1[(size_t)(k + j) * g.ldb]; }
#pragma unroll
        for (int j = 0; j < 4; ++j) { acc0 = __builtin_amdgcn_mfma_f32_32x32x2f32(a[j], b[j], acc0, 0, 0, 0); if (MODE == 2) acc1 = __builtin_amdgcn_mfma_f32_32x32x2f32(a[j], d[j], acc1, 0, 0, 0); }
    }
    const int col = col0 + i;
#pragma unroll
    for (int r = 0; r < 16; ++r) {
        const int row = row0 + kap(r, kk);
        float* cp = g.C + (size_t)row * g.ldc + col;
        if (MODE == 0) *cp = acc0[r];
        else if (MODE == 1) { const int b = row / SEQ; *cp += g.gate[(size_t)b * g.gate_bstride + col] * acc0[r]; }
        else { const float gt = acc0[r]; *cp = (gt / (1.f + expf(-gt))) * acc1[r]; }
    }
}
__global__ void __launch_bounds__(256) ora_rope(float* proj, const float* rc, const float* rs) {
    const int idx = blockIdx.x * 256 + threadIdx.x;
    const int d = idx & 31, hc = (idx >> 5) % 26, tok = idx / (26 * 32);
    const int cb = (hc < 10) ? hc * 64 : COL_QD + (hc - 10) * 64;
    float* p = proj + (size_t)tok * INC + cb;
    const float c = rc[tok * 32 + d], s = rs[tok * 32 + d];
    const float t1 = p[d], t2 = p[d + 32];
    p[d] = t1 * c - t2 * s; p[d + 32] = t2 * c + t1 * s;
}
__global__ void __launch_bounds__(256) ora_win_attn(const float* proj, const float* sink, float* att) {
    const int b = blockIdx.y >> 3, hq = blockIdx.y & 7, hkv = hq >> 2;
    const int qi = blockIdx.x * 256 + threadIdx.x;
    const float* qp = proj + (size_t)(b * SEQ + qi) * INC + COL_QA + hq * 64;
    float q[64], o[64];
#pragma unroll
    for (int d = 0; d < 64; d += 4) { const f32x4 t = *(const f32x4*)(qp + d); q[d] = t.x * 0.125f; q[d + 1] = t.y * 0.125f; q[d + 2] = t.z * 0.125f; q[d + 3] = t.w * 0.125f; }
#pragma unroll
    for (int d = 0; d < 64; ++d) o[d] = 0.f;
    float m = sink[hq], l = 1.f;
    const int j0 = qi - 128 < 0 ? 0 : qi - 128, j1 = qi + 128 > SEQ - 1 ? SEQ - 1 : qi + 128;
    for (int j = j0; j <= j1; ++j) {
        const float* kp = proj + (size_t)(b * SEQ + j) * INC + COL_KA + hkv * 64;
        const float* vp = proj + (size_t)(b * SEQ + j) * INC + COL_VA + hkv * 64;
        float s = 0.f;
#pragma unroll
        for (int d = 0; d < 64; d += 4) { const f32x4 t = *(const f32x4*)(kp + d); s += q[d] * t.x + q[d + 1] * t.y + q[d + 2] * t.z + q[d + 3] * t.w; }
        const float mn = fmaxf(m, s), al = expf(m - mn), p = expf(s - mn);
        l = l * al + p; m = mn;
#pragma unroll
        for (int d = 0; d < 64; d += 4) { const f32x4 t = *(const f32x4*)(vp + d); o[d] = o[d] * al + p * t.x; o[d + 1] = o[d + 1] * al + p * t.y; o[d + 2] = o[d + 2] * al + p * t.z; o[d + 3] = o[d + 3] * al + p * t.w; }
    }
    const float il = 1.f / l;
    float* op = att + (size_t)(b * SEQ + qi) * DM + hq * 64;
#pragma unroll
    for (int d = 0; d < 64; d += 4) *(f32x4*)(op + d) = (f32x4){o[d] * il, o[d + 1] * il, o[d + 2] * il, o[d + 3] * il};
}
__global__ void __launch_bounds__(256) ora_diff_attn(const float* proj, float* Oc) {
    const int wave = threadIdx.x >> 6, lane = threadIdx.x & 63, i = lane & 31, kk = lane >> 5;
    const int b = blockIdx.y >> 3, h = (blockIdx.y >> 1) & 3, c = blockIdx.y & 1;
    const int q0 = blockIdx.x * 128 + wave * 32;
    const float* Qp = proj + (size_t)(b * SEQ + q0 + i) * INC + COL_QD + h * 128 + c * 64;
    const float* Kb = proj + (size_t)(b * SEQ) * INC + COL_KD + h * 128 + c * 64;
    const float* Vb = proj + (size_t)(b * SEQ) * INC + COL_VD + h * 128;
    f32x4 qf[8];
#pragma unroll
    for (int s = 0; s < 8; ++s) qf[s] = *(const f32x4*)(Qp + 8 * s + 4 * kk) * 0.125f;
    f32x16 o[4]; o[0] = f32x16{}; o[1] = f32x16{}; o[2] = f32x16{}; o[3] = f32x16{};
    float m = -INFINITY, l = 0.f;
    for (int key0 = 0; key0 < SEQ; key0 += 32) {
        f32x16 sc = {};
        const float* kp = Kb + (size_t)(key0 + i) * INC + 4 * kk;
#pragma unroll
        for (int s = 0; s < 8; ++s) { const f32x4 kf = *(const f32x4*)(kp + 8 * s);
#pragma unroll
            for (int j = 0; j < 4; ++j) sc = __builtin_amdgcn_mfma_f32_32x32x2f32(kf[j], qf[s][j], sc, 0, 0, 0); }
        float tm = sc[0];
#pragma unroll
        for (int r = 1; r < 16; ++r) tm = fmaxf(tm, sc[r]);
        tm = fmaxf(tm, __shfl_xor(tm, 32));
        const float mn = fmaxf(m, tm), al = expf(m - mn);
        float ps = 0.f;
#pragma unroll
        for (int r = 0; r < 16; ++r) { sc[r] = expf(sc[r] - mn); ps += sc[r]; }
        ps += __shfl_xor(ps, 32);
        l = l * al + ps; m = mn;
#pragma unroll
        for (int db = 0; db < 4; ++db) o[db] = o[db] * al;
#pragma unroll
        for (int r = 0; r < 16; ++r) {
            const float* vp = Vb + (size_t)(key0 + kap(r, kk)) * INC + i;
#pragma unroll
            for (int db = 0; db < 4; ++db) o[db] = __builtin_amdgcn_mfma_f32_32x32x2f32(vp[db * 32], sc[r], o[db], 0, 0, 0);
        }
    }
    const float il = 1.f / l;
    float* op = Oc + ((size_t)c * NTOK + b * SEQ + q0 + i) * 512 + h * 128;
#pragma unroll
    for (int db = 0; db < 4; ++db)
#pragma unroll
        for (int r = 0; r < 16; ++r) op[db * 32 + kap(r, kk)] = o[db][r] * il;
}
__global__ void __launch_bounds__(256) ora_diff_combine(const float* Oc, const float* lq1, const float* lk1, const float* lq2, const float* lk2, const float* subg, float lambda_init, float* att) {
    const int wv = blockIdx.x * 4 + (threadIdx.x >> 6), lane = threadIdx.x & 63, tok = wv >> 2, h = wv & 3;
    const float lam = expf(wave_sum(lq1[lane] * lk1[lane])) - expf(wave_sum(lq2[lane] * lk2[lane])) + lambda_init;
    const float* o1 = Oc + (size_t)tok * 512 + h * 128, *o2 = Oc + ((size_t)NTOK + tok) * 512 + h * 128;
    const float v0 = o1[lane] - lam * o2[lane], v1 = o1[lane + 64] - lam * o2[lane + 64];
    const float r = 1.f / sqrtf(wave_sum(v0 * v0 + v1 * v1) * (1.f / 128.f) + EPS);
    float* ap = att + (size_t)tok * DM + 512 + h * 128;
    ap[lane] = v0 * r * subg[lane] * (1.f - lambda_init); ap[lane + 64] = v1 * r * subg[lane + 64] * (1.f - lambda_init);
}
__global__ void __launch_bounds__(256) ora_router(const float* h, const float* rw, int* top_e, float* top_w) {
    const int tok = blockIdx.x * 4 + (threadIdx.x >> 6), lane = threadIdx.x & 63;
    float lg[8];
#pragma unroll
    for (int e = 0; e < 8; ++e) lg[e] = 0.f;
    for (int k = lane; k < DM; k += 64) { const float hv = h[(size_t)tok * DM + k]; const f32x4 w0 = *(const f32x4*)(rw + k * 8), w1 = *(const f32x4*)(rw + k * 8 + 4);
        lg[0] += hv * w0.x; lg[1] += hv * w0.y; lg[2] += hv * w0.z; lg[3] += hv * w0.w; lg[4] += hv * w1.x; lg[5] += hv * w1.y; lg[6] += hv * w1.z; lg[7] += hv * w1.w; }
#pragma unroll
    for (int e = 0; e < 8; ++e) lg[e] = wave_sum(lg[e]);
    if (lane == 0) {
        int e0 = 0; float v0 = lg[0];
#pragma unroll
        for (int e = 1; e < 8; ++e) if (lg[e] > v0) { v0 = lg[e]; e0 = e; }
        int e1 = -1; float v1 = -INFINITY;
#pragma unroll
        for (int e = 0; e < 8; ++e) if (e != e0 && lg[e] > v1) { v1 = lg[e]; e1 = e; }
        const float p1 = expf(v1 - v0), inv = 1.f / (1.f + p1);
        top_e[tok * 2] = e0; top_e[tok * 2 + 1] = e1; top_w[tok * 2] = inv; top_w[tok * 2 + 1] = p1 * inv;
    }
}
__global__ void __launch_bounds__(1024) ora_moe_plan(const int* top_e, int* row_tok, int* slot_dest, int* chunk_e, int* nchunks) {
    __shared__ int cnt[8], pstart[8], cur[8];
    const int tid = threadIdx.x;
    if (tid < 8) { cnt[tid] = 0; cur[tid] = 0; }
    __syncthreads();
    for (int s = tid; s < NTOK * 2; s += 1024) atomicAdd(&cnt[top_e[s]], 1);
    for (int r = tid; r < PMAX; r += 1024) row_tok[r] = NTOK;
    __syncthreads();
    if (tid == 0) { int acc = 0; for (int e = 0; e < 8; ++e) { pstart[e] = acc; const int pd = (cnt[e] + 255) / 256 * 256; for (int ch = acc / 256; ch < (acc + pd) / 256; ++ch) chunk_e[ch] = e; acc += pd; } *nchunks = acc / 256; }
    __syncthreads();
    for (int s = tid; s < NTOK * 2; s += 1024) { const int e = top_e[s]; const int pos = atomicAdd(&cur[e], 1); const int dest = pstart[e] + pos; row_tok[dest] = s >> 1; slot_dest[s] = dest; }
}
__global__ void __launch_bounds__(256) ora_moe_combine(float* x, const float* ys, const int* slot_dest, const float* top_w, const float* gate, int gate_bstride) {
    const int idx = blockIdx.x * 256 + threadIdx.x;
    const int tok = idx >> 8, col = (idx & 255) * 4, b = tok / SEQ;
    const int d0 = slot_dest[tok * 2], d1 = slot_dest[tok * 2 + 1]; const float w0 = top_w[tok * 2], w1 = top_w[tok * 2 + 1];
    const f32x4 y0 = *(const f32x4*)(ys + (size_t)d0 * DM + col), y1 = *(const f32x4*)(ys + (size_t)d1 * DM + col), gt = *(const f32x4*)(gate + (size_t)b * gate_bstride + col);
    f32x4* xp = (f32x4*)(x + (size_t)tok * DM + col);
    *xp = *xp + gt * (y0 * w0 + y1 * w1);
}

extern "C" void kernel_launch(void* const* d_in, const int* in_sizes, int n_in, void* d_out, int out_size, void* d_ws, size_t ws_size, hipStream_t stream) {
    const float* x_in = (const float*)d_in[0]; const float* c = (const float*)d_in[1]; const int* positions = (const int*)d_in[2];
    const float* ada_w = (const float*)d_in[3]; const float* ada_b = (const float*)d_in[4]; const float* norm_mix_g = (const float*)d_in[5]; const float* norm_ffn_g = (const float*)d_in[6];
    const float* w_in = (const float*)d_in[7]; const float* w_out = (const float*)d_in[8]; const float* sink = (const float*)d_in[9];
    const float* lq1 = (const float*)d_in[10]; const float* lk1 = (const float*)d_in[11]; const float* lq2 = (const float*)d_in[12]; const float* lk2 = (const float*)d_in[13];
    const float* subln_g = (const float*)d_in[14]; const float* ffn_wg = (const float*)d_in[15]; const float* ffn_wu = (const float*)d_in[16]; const float* ffn_wd = (const float*)d_in[17];
    const float* router_w = (const float*)d_in[18]; const float* moe_wg = (const float*)d_in[19]; const float* moe_wu = (const float*)d_in[20]; const float* moe_wd = (const float*)d_in[21];
    const float* final_g = (const float*)d_in[22];
    float* x = (float*)d_out;
    char* ws = (char*)d_ws; const size_t MiB = 1u << 20;
    float* mod = (float*)(ws + 1 * MiB);
    float* rc = (float*)(ws + 2 * MiB); float* rs = (float*)(ws + 4 * MiB);
    int* top_e = (int*)(ws + 6 * MiB); float* top_w = (float*)(ws + 6 * MiB + 256 * 1024); int* slot_dest = (int*)(ws + 6 * MiB + 512 * 1024); int* row_tok = (int*)(ws + 6 * MiB + 768 * 1024);
    int* chunk_e = (int*)(ws + 7 * MiB); int* nchunks = chunk_e + 256;
    float* h = (float*)(ws + 8 * MiB);
    float* ys = (float*)(ws + 72 * MiB);
    float* proj = (float*)(ws + 208 * MiB);
    float* att = (float*)(ws + 352 * MiB);
    float* Oc = (float*)(ws + 416 * MiB);
    float* hmid = (float*)(ws + 208 * MiB);

    hipMemcpyAsync(x, x_in, (size_t)NTOK * DM * 4, hipMemcpyDeviceToDevice, stream);
    ora_mod<<<(DEPTH * NMOD * DM + 255) / 256, 256, 0, stream>>>(c, ada_w, ada_b, mod);
    RopeFreq rf; memset(&rf, 0, sizeof(rf)); for (int i = 0; i < 32; ++i) rf.inv[i] = (float)(1.0 / pow(10000.0, (double)((float)(2 * i) / 64.0f)));
    ora_rope_tab<<<NTOK * 32 / 256, 256, 0, stream>>>(positions, rf, rc, rs);
    const int MB = NMOD * DM;
    for (int l = 0; l < DEPTH; ++l) {
        const float* ml = mod + (size_t)l * 2 * MB;
        const float lambda_init = (float)(0.8 - 0.6 * exp(-0.3 * (double)l));
        ora_norm_mod<<<NTOK / 4, 256, 0, stream>>>(x, norm_mix_g + l * DM, ml + 0 * DM, ml + 1 * DM, MB, h);
        { OGemm g; memset(&g, 0, sizeof(g)); g.A = h; g.lda = DM; g.B0 = w_in + (size_t)l * DM * INC; g.B1 = nullptr; g.ldb = INC; g.C = proj; g.ldc = INC; g.K = DM;
          ora_gemm<0><<<dim3(INC / 64, NTOK / 64), 256, 0, stream>>>(g); }
        ora_rope<<<NTOK * 26 * 32 / 256, 256, 0, stream>>>(proj, rc, rs);
        ora_win_attn<<<dim3(SEQ / 256, 16), 256, 0, stream>>>(proj, sink + l * 8, att);
        ora_diff_attn<<<dim3(SEQ / 128, 16), 256, 0, stream>>>(proj, Oc);
        ora_diff_combine<<<NTOK, 256, 0, stream>>>(Oc, lq1 + l * 64, lk1 + l * 64, lq2 + l * 64, lk2 + l * 64, subln_g + l * 128, lambda_init, att);
        { OGemm g; memset(&g, 0, sizeof(g)); g.A = att; g.lda = DM; g.B0 = w_out + (size_t)l * DM * DM; g.ldb = DM; g.C = x; g.ldc = DM; g.K = DM; g.gate = ml + 2 * DM; g.gate_bstride = MB;
          ora_gemm<1><<<dim3(DM / 64, NTOK / 64), 256, 0, stream>>>(g); }
        ora_norm_mod<<<NTOK / 4, 256, 0, stream>>>(x, norm_ffn_g + l * DM, ml + 3 * DM, ml + 4 * DM, MB, h);
        const int i2 = l / 2;
        if ((l & 1) == 0) {
            { OGemm g; memset(&g, 0, sizeof(g)); g.A = h; g.lda = DM; g.B0 = ffn_wg + (size_t)i2 * DM * FF; g.B1 = ffn_wu + (size_t)i2 * DM * FF; g.ldb = FF; g.C = hmid; g.ldc = FF; g.K = DM;
              ora_gemm<2><<<dim3(FF / 64, NTOK / 64), 256, 0, stream>>>(g); }
            { OGemm g; memset(&g, 0, sizeof(g)); g.A = hmid; g.lda = FF; g.B0 = ffn_wd + (size_t)i2 * FF * DM; g.ldb = DM; g.C = x; g.ldc = DM; g.K = FF; g.gate = ml + 5 * DM; g.gate_bstride = MB;
              ora_gemm<1><<<dim3(DM / 64, NTOK / 64), 256, 0, stream>>>(g); }
        } else {
            ora_router<<<NTOK / 4, 256, 0, stream>>>(h, router_w + (size_t)i2 * DM * NE, top_e, top_w);
            ora_moe_plan<<<1, 1024, 0, stream>>>(top_e, row_tok, slot_dest, chunk_e, nchunks);
            { OGemm g; memset(&g, 0, sizeof(g)); g.A = h; g.lda = DM; g.B0 = moe_wg + (size_t)i2 * NE * DM * FF; g.B1 = moe_wu + (size_t)i2 * NE * DM * FF; g.ldb = FF; g.C = hmid; g.ldc = FF; g.K = DM;
              g.row_tok = row_tok; g.chunk_e = chunk_e; g.nchunks = nchunks; g.estride = (size_t)DM * FF;
              ora_gemm<2><<<dim3(FF / 64, PMAX / 64), 256, 0, stream>>>(g); }
            { OGemm g; memset(&g, 0, sizeof(g)); g.A = hmid; g.lda = FF; g.B0 = moe_wd + (size_t)i2 * NE * FF * DM; g.ldb = DM; g.C = ys; g.ldc = DM; g.K = FF;
              g.chunk_e = chunk_e; g.nchunks = nchunks; g.estride = (size_t)FF * DM;
              ora_gemm<0><<<dim3(DM / 64, PMAX / 64), 256, 0, stream>>>(g); }
            ora_moe_combine<<<NTOK * 256 / 256, 256, 0, stream>>>(x, ys, slot_dest, top_w, ml + 5 * DM, MB);
        }
    }
    ora_norm_mod<<<NTOK / 4, 256, 0, stream>>>(x, final_g, nullptr, nullptr, 0, x);
}
```

```cpp
#include <hip/hip_runtime.h>
#ifndef PROBE
#define PROBE 0
#endif
#ifndef RESC_NOPS
#define RESC_NOPS 10
#endif
#ifndef LEAD_WAVES
#define LEAD_WAVES 4
#endif
#include <hip/hip_bf16.h>
#include <cstdio>
#include <cstdint>
#include <cmath>
#include <cstring>

constexpr int BATCH = 2, SEQ = 8192, DM = 1024, NTOK = BATCH * SEQ, DEPTH = 4;
constexpr int INC = 2304, FF = 3584, NE = 8, NMOD = 6;
constexpr int COL_QA = 0, COL_KA = 512, COL_VA = 640, COL_QD = 768, COL_KD = 1280, COL_VD = 1792;
constexpr int PMAX = NTOK * 2 + NE * 256;
constexpr int NCHUNK_MAX = PMAX / 256;
constexpr float EPS = 1e-6f;
constexpr float QK_C2 = 0.125f * 1.4426950408889634f;
constexpr int MODB = NMOD * DM;

namespace pg8 {
#define PG8_LAS __attribute__((address_space(3)))
typedef unsigned short bf16_t;
typedef short bf16x8 __attribute__((ext_vector_type(8)));
typedef float f32x4 __attribute__((ext_vector_type(4)));
typedef unsigned u32x4 __attribute__((ext_vector_type(4)));
constexpr int BM = 256, BK = 64, HALF = 128, HTB = HALF * BK * 2  , STAGE_BYTES = 8 * HTB, NXCD = 8, WGM = 8;

__host__ __device__ __forceinline__ int lds_byte(int r, int c) { const int st = (r >> 4) * 2 + (c >> 5), rr = r & 15, cc = c & 31, ob = rr * 64 + cc * 2; return st * 1024 + (ob ^ (((ob >> 9) & 1) << 5)); }
__host__ __device__ __forceinline__ void stage_rc(int b, int& R, int& C) { const int st = b / 1024, sb = b % 1024, swz = sb ^ (((sb >> 9) & 1) << 5); R = (st >> 1) * 16 + swz / 64; C = (st & 1) * 32 + (swz % 64) / 2; }
__host__ __device__ __forceinline__ int perm32(int rho) { const int n = rho >> 4, i = rho & 15; return 8 * (i >> 2) + 4 * n + (i & 3); }

struct Unit { int pm, pn, pnb; int koff, nt, ks; };
struct Gemm { const bf16_t* A; const bf16_t* Bt; int M, N, K; };

struct StaticOrder {
    static constexpr bool VARK = false;
    int nM, nN, nwg, G, c; const int* chunk_e;
    __device__ __forceinline__ void init(int M, int N, int G_, int c_, const int* ce = nullptr) { nM = M / BM; nN = N / BM; nwg = nM * nN; G = G_; c = c_; chunk_e = ce; }
    __device__ __forceinline__ bool next(int i, Unit& u) const {
        const long L = (long)i * G + c; if (L >= nwg) return false;
        int wgid = (int)L; { const int q = nwg / NXCD, r = nwg % NXCD, xcd = wgid % NXCD, off = wgid / NXCD; wgid = (xcd < r ? xcd * (q + 1) : r * (q + 1) + (xcd - r) * q) + off; }
        const int nig = WGM * nN, gid = wgid / nig, fm = gid * WGM, gsz = (nM - fm) < WGM ? (nM - fm) : WGM;
        u.pm = fm + ((wgid % nig) % gsz); u.pn = (wgid % nig) / gsz; u.pnb = chunk_e ? chunk_e[u.pm] * nN + u.pn : u.pn; return true;
    }
    __device__ __forceinline__ void a_ready(const Unit&) const {}
    __device__ __forceinline__ void done(const Unit&) const {}
};
__host__ __device__ __forceinline__ void tail_params(int nch, int nN, int nt_all, int G, int& MC, int& s) {
    MC = ((nch * nN) / G) * G / nN; const int T = nch - MC;
    s = (T * nN * 7 <= G && nt_all % 14 == 0) ? 7 : (T * nN * 4 <= G && nt_all % 8 == 0) ? 4 : (T * nN * 2 <= G && nt_all % 4 == 0) ? 2 : 1;
}
struct TailOrder {
    static constexpr bool VARK = true;
    StaticOrder main; int G, vcu, nmine, npieces, s, kt, pm0, nN; const int* chunk_e;
    __device__ __forceinline__ void init(int nch, int N, int K, int G_, int c_, int vcu_, const int* ce) {
        nN = N / BM; G = G_; vcu = vcu_; chunk_e = ce; int MC; tail_params(nch, nN, K / BK, G, MC, s);
        main.init(MC * BM, N, G, c_, ce); const int nmain = MC * nN; nmine = c_ < nmain ? (nmain - c_ + G - 1) / G : 0;
        pm0 = MC; kt = (K / BK) / s; npieces = (nch - MC) * nN * s;
    }
    __device__ __forceinline__ bool next(int i, Unit& u) const {
        if (i < nmine) { main.next(i, u); u.koff = 0; u.nt = kt * s; u.ks = 0; return true; }
        const int q = (i - nmine) * G + vcu; if (q >= npieces) return false;
        const int pn = q % nN, r = q / nN, ks = r % s, ch = r / s;
        u.pm = pm0 + ch; u.pn = pn; u.pnb = chunk_e[u.pm] * nN + pn; u.koff = ks * kt * BK * 2; u.nt = kt; u.ks = ks; return true;
    }
    __device__ __forceinline__ void a_ready(const Unit&) const {}
    __device__ __forceinline__ void done(const Unit&) const {}
};
constexpr int TAILROWS = 8 * 256;

#ifndef F8CFG
#define F8CFG 62
#endif
constexpr bool F8_D1 = (F8CFG & 1) != 0, F8_D2 = (F8CFG & 2) != 0, F8_M1 = (F8CFG & 4) != 0, F8_M2 = (F8CFG & 8) != 0, F8_IN = (F8CFG & 16) != 0, F8_ATT = (F8CFG & 32) != 0;
constexpr float F8_SA = 8.f, F8_SW1 = 128.f, F8_SH = 4.f, F8_SW2 = 256.f;
constexpr float F8_INV1 = 1.f / (F8_SA * F8_SW1), F8_INV2 = 1.f / (F8_SH * F8_SW2);
__device__ __forceinline__ unsigned pack4_fp8(float a, float b, float c, float d) {
    a = __builtin_amdgcn_fmed3f(a, -448.f, 448.f); b = __builtin_amdgcn_fmed3f(b, -448.f, 448.f); c = __builtin_amdgcn_fmed3f(c, -448.f, 448.f); d = __builtin_amdgcn_fmed3f(d, -448.f, 448.f);
    unsigned r = 0u; r = (unsigned)__builtin_amdgcn_cvt_pk_fp8_f32(a, b, (int)r, false); r = (unsigned)__builtin_amdgcn_cvt_pk_fp8_f32(c, d, (int)r, true); return r; }
__device__ __forceinline__ unsigned cvt_pk_bf16(float lo, float hi) { unsigned r; asm volatile("v_cvt_pk_bf16_f32 %0, %1, %2" : "=v"(r) : "v"(lo), "v"(hi)); return r; }

struct EpiBf16 {
    static constexpr bool PERM = true, AFTER_DRAIN = false;
    bf16_t* O; int ldc; float ascale = 1.f;
    __device__ __forceinline__ void operator()(const f32x4 (&acc)[2][2][4][2], const Unit& u, int wr, int wc, int fr, int fq) const {
        const int row0 = u.pm * BM + wr * 64 + fr, col0 = u.pn * BM + wc * 32 + 8 * fq;
#pragma unroll
        for (int ai = 0; ai < 2; ++ai)
#pragma unroll
            for (int m = 0; m < 4; ++m) { bf16_t* rowp = O + (size_t)(row0 + ai * HALF + m * 16) * ldc + col0;
#pragma unroll
                for (int bj = 0; bj < 2; ++bj) { const f32x4 v0 = acc[ai][bj][m][0] * ascale, v1 = acc[ai][bj][m][1] * ascale;
                    u32x4 w; w.x = cvt_pk_bf16(v0[0], v0[1]); w.y = cvt_pk_bf16(v0[2], v0[3]); w.z = cvt_pk_bf16(v1[0], v1[1]); w.w = cvt_pk_bf16(v1[2], v1[3]);
                    *(u32x4*)(rowp + bj * HALF) = w; } }
    }
};
struct EpiBf16T {
    static constexpr bool PERM = true, AFTER_DRAIN = false;
    bf16_t* O; int ldc; bf16_t* P; int pm0; float ascale = 1.f;
    __device__ __forceinline__ void operator()(const f32x4 (&acc)[2][2][4][2], const Unit& u, int wr, int wc, int fr, int fq) const {
        bf16_t* base = O; int rowb = u.pm * BM;
        if (u.ks != 0) { base = P + (size_t)(u.ks - 1) * TAILROWS * ldc; rowb = (u.pm - pm0) * BM; }
        const int row0 = rowb + wr * 64 + fr, col0 = u.pn * BM + wc * 32 + 8 * fq;
#pragma unroll
        for (int ai = 0; ai < 2; ++ai)
#pragma unroll
            for (int m = 0; m < 4; ++m) { bf16_t* rowp = base + (size_t)(row0 + ai * HALF + m * 16) * ldc + col0;
#pragma unroll
                for (int bj = 0; bj < 2; ++bj) { const f32x4 v0 = acc[ai][bj][m][0] * ascale, v1 = acc[ai][bj][m][1] * ascale;
                    u32x4 w; w.x = cvt_pk_bf16(v0[0], v0[1]); w.y = cvt_pk_bf16(v0[2], v0[3]); w.z = cvt_pk_bf16(v1[0], v1[1]); w.w = cvt_pk_bf16(v1[2], v1[3]);
                    *(u32x4*)(rowp + bj * HALF) = w; } }
    }
};
struct EpiRope {
    static constexpr bool PERM = true, AFTER_DRAIN = false;
    bf16_t* O; const float* rc; const float* rs; float ascale = 1.f; unsigned char* O8 = nullptr;
    __device__ __forceinline__ void operator()(const f32x4 (&acc)[2][2][4][2], const Unit& u, int wr, int wc, int fr, int fq) const {
        const int row0 = u.pm * BM + wr * 64 + fr;
#pragma unroll
        for (int bj = 0; bj < 2; ++bj) {
            const int cbase = u.pn * BM + bj * HALF;
            const bool rope = (cbase < COL_VA) || (cbase >= COL_QD && cbase < COL_VD);
            const bool f8o = O8 != nullptr && cbase >= COL_QD;
            const float sc = (((cbase < COL_KA) || (cbase >= COL_QD && cbase < COL_KD)) ? QK_C2 : 1.0f) * ascale * (f8o ? (cbase < COL_KD ? 8.f : (cbase < COL_VD ? 0.125f : 1.f)) : 1.f);
            const int col0 = cbase + wc * 32 + 8 * fq, i0 = (col0 & 63) >> 1;
#pragma unroll
            for (int ai = 0; ai < 2; ++ai)
#pragma unroll
                for (int m = 0; m < 4; ++m) {
                    const int row = row0 + ai * HALF + m * 16;
                    f32x4 v0 = acc[ai][bj][m][0], v1 = acc[ai][bj][m][1];
                    if (rope) {
                        const f32x4 c4 = *(const f32x4*)(rc + (size_t)row * 32 + i0), s4 = *(const f32x4*)(rs + (size_t)row * 32 + i0);
                        const f32x4 a0 = v0, a1 = v1;
                        v0[0] = a0[0] * c4[0] - a0[1] * s4[0]; v0[1] = a0[1] * c4[0] + a0[0] * s4[0];
                        v0[2] = a0[2] * c4[1] - a0[3] * s4[1]; v0[3] = a0[3] * c4[1] + a0[2] * s4[1];
                        v1[0] = a1[0] * c4[2] - a1[1] * s4[2]; v1[1] = a1[1] * c4[2] + a1[0] * s4[2];
                        v1[2] = a1[2] * c4[3] - a1[3] * s4[3]; v1[3] = a1[3] * c4[3] + a1[2] * s4[3];
                    }
                    v0 = v0 * sc; v1 = v1 * sc;
                    if (f8o) { *(unsigned long long*)(O8 + (size_t)row * (INC - COL_QD) + (col0 - COL_QD)) = (unsigned long long)pack4_fp8(v0[0], v0[1], v0[2], v0[3]) | ((unsigned long long)pack4_fp8(v1[0], v1[1], v1[2], v1[3]) << 32); }
                    else { u32x4 w; w.x = cvt_pk_bf16(v0[0], v0[1]); w.y = cvt_pk_bf16(v0[2], v0[3]); w.z = cvt_pk_bf16(v1[0], v1[1]); w.w = cvt_pk_bf16(v1[2], v1[3]);
                        *(u32x4*)(O + (size_t)row * INC + col0) = w; }
                }
        }
    }
};
struct EpiSwiglu {
    static constexpr bool PERM = true, AFTER_DRAIN = false;
    bf16_t* O; int ldc; float ain = 1.f;
    __device__ __forceinline__ static float silu_mul(float g, float u) { return g * u * __builtin_amdgcn_rcpf(1.0f + __builtin_amdgcn_exp2f(-1.4426950408889634f * g)); }
    __device__ __forceinline__ void operator()(const f32x4 (&acc)[2][2][4][2], const Unit& u, int wr, int wc, int fr, int fq) const {
        const int row0 = u.pm * BM + wr * 64 + fr, col0 = u.pn * HALF + wc * 32 + 8 * fq;
#pragma unroll
        for (int ai = 0; ai < 2; ++ai)
#pragma unroll
            for (int m = 0; m < 4; ++m) {
                const f32x4 g0 = acc[ai][0][m][0] * ain, g1 = acc[ai][0][m][1] * ain, u0 = acc[ai][1][m][0] * ain, u1 = acc[ai][1][m][1] * ain;
                u32x4 w; w.x = cvt_pk_bf16(silu_mul(g0[0], u0[0]), silu_mul(g0[1], u0[1])); w.y = cvt_pk_bf16(silu_mul(g0[2], u0[2]), silu_mul(g0[3], u0[3]));
                w.z = cvt_pk_bf16(silu_mul(g1[0], u1[0]), silu_mul(g1[1], u1[1])); w.w = cvt_pk_bf16(silu_mul(g1[2], u1[2]), silu_mul(g1[3], u1[3]));
                *(u32x4*)(O + (size_t)(row0 + ai * HALF + m * 16) * ldc + col0) = w;
            }
    }
};
struct EpiSwigluF8 {
    static constexpr bool PERM = true, AFTER_DRAIN = false;
    unsigned char* O; int ldc; float ain, oscale;
    __device__ __forceinline__ void operator()(const f32x4 (&acc)[2][2][4][2], const Unit& u, int wr, int wc, int fr, int fq) const {
        const int row0 = u.pm * BM + wr * 64 + fr, col0 = u.pn * HALF + wc * 32 + 8 * fq;
#pragma unroll
        for (int ai = 0; ai < 2; ++ai)
#pragma unroll
            for (int m = 0; m < 4; ++m) {
                const f32x4 g0 = acc[ai][0][m][0] * ain, g1 = acc[ai][0][m][1] * ain, u0 = acc[ai][1][m][0] * (ain * oscale), u1 = acc[ai][1][m][1] * (ain * oscale);
                unsigned long long w = (unsigned long long)pack4_fp8(EpiSwiglu::silu_mul(g0[0], u0[0]), EpiSwiglu::silu_mul(g0[1], u0[1]), EpiSwiglu::silu_mul(g0[2], u0[2]), EpiSwiglu::silu_mul(g0[3], u0[3]))
                    | ((unsigned long long)pack4_fp8(EpiSwiglu::silu_mul(g1[0], u1[0]), EpiSwiglu::silu_mul(g1[1], u1[1]), EpiSwiglu::silu_mul(g1[2], u1[2]), EpiSwiglu::silu_mul(g1[3], u1[3])) << 32);
                *(unsigned long long*)(O + (size_t)(row0 + ai * HALF + m * 16) * ldc + col0) = w;
            }
    }
};
struct EpiResGate {
    static constexpr bool PERM = false, AFTER_DRAIN = false;
    const float* base; float* out; const float* gate;
    __device__ __forceinline__ void operator()(const f32x4 (&acc)[2][2][4][2], const Unit& u, int wr, int wc, int fr, int fq) const {
        const int row0 = u.pm * BM + wr * 64 + fr, col0 = u.pn * BM + wc * 32 + 4 * fq;
        const float* gp = gate + (size_t)((u.pm * BM) / SEQ) * MODB + col0;
        f32x4 gv[2][2];
#pragma unroll
        for (int bj = 0; bj < 2; ++bj)
#pragma unroll
            for (int n = 0; n < 2; ++n) gv[bj][n] = *(const f32x4*)(gp + bj * HALF + n * 16);
#pragma unroll
        for (int ai = 0; ai < 2; ++ai)
#pragma unroll
            for (int m = 0; m < 4; ++m) { const size_t off = (size_t)(row0 + ai * HALF + m * 16) * DM + col0;
#pragma unroll
                for (int bj = 0; bj < 2; ++bj)
#pragma unroll
                    for (int n = 0; n < 2; ++n) { const f32x4 bs = *(const f32x4*)(base + off + bj * HALF + n * 16); *(f32x4*)(out + off + bj * HALF + n * 16) = bs + gv[bj][n] * acc[ai][bj][m][n]; } }
    }
};

template <bool BASE_F32>
struct EpiResGateB {
    static constexpr bool PERM = true, AFTER_DRAIN = false;
    const void* base; bf16_t* out; const float* gate; float ascale = 1.f;
    __device__ __forceinline__ void operator()(const f32x4 (&acc)[2][2][4][2], const Unit& u, int wr, int wc, int fr, int fq) const {
        const int row0 = u.pm * BM + wr * 64 + fr, col0 = u.pn * BM + wc * 32 + 8 * fq;
        const float* gp = gate + (size_t)((u.pm * BM) / SEQ) * MODB + col0;
        f32x4 gv[2][2];
#pragma unroll
        for (int bj = 0; bj < 2; ++bj)
#pragma unroll
            for (int n = 0; n < 2; ++n) gv[bj][n] = *(const f32x4*)(gp + bj * HALF + n * 4) * ascale;
#pragma unroll
        for (int ai = 0; ai < 2; ++ai)
#pragma unroll
            for (int m = 0; m < 4; ++m) { const size_t off = (size_t)(row0 + ai * HALF + m * 16) * DM + col0;
#pragma unroll
                for (int bj = 0; bj < 2; ++bj) { f32x4 b0, b1;
                    if (BASE_F32) { b0 = *(const f32x4*)((const float*)base + off + bj * HALF); b1 = *(const f32x4*)((const float*)base + off + bj * HALF + 4); }
                    else { const u32x4 w = *(const u32x4*)((const bf16_t*)base + off + bj * HALF);
                        b0 = (f32x4){__uint_as_float(w.x << 16), __uint_as_float(w.x & 0xffff0000u), __uint_as_float(w.y << 16), __uint_as_float(w.y & 0xffff0000u)};
                        b1 = (f32x4){__uint_as_float(w.z << 16), __uint_as_float(w.z & 0xffff0000u), __uint_as_float(w.w << 16), __uint_as_float(w.w & 0xffff0000u)}; }
                    const f32x4 v0 = b0 + gv[bj][0] * acc[ai][bj][m][0], v1 = b1 + gv[bj][1] * acc[ai][bj][m][1];
                    u32x4 o; o.x = cvt_pk_bf16(v0[0], v0[1]); o.y = cvt_pk_bf16(v0[2], v0[3]); o.z = cvt_pk_bf16(v1[0], v1[1]); o.w = cvt_pk_bf16(v1[2], v1[3]);
                    *(u32x4*)(out + off + bj * HALF) = o; } }
    }
};

struct NoGather { static constexpr bool ON = false; __device__ __forceinline__ int tok(int, int) const { return 0; } };
struct LdsGather { static constexpr bool ON = true; const PG8_LAS int* idx; __device__ __forceinline__ int tok(int ui, int r) const { return idx[ui * 256 + r]; } };
typedef int v4i_t __attribute__((ext_vector_type(4)));
typedef int v8i_t __attribute__((ext_vector_type(8)));
template <class Epi, class Sched, bool ALIGN_EPI = false, bool SP2 = false, class Gath = NoGather, bool F8 = false>
__device__ __forceinline__ void gemm_phase(PG8_LAS unsigned char* lds, const Gemm g, const Sched& S, const Epi& E, const Gath GA = Gath()) {
    static_assert(!Gath::ON || SP2, "the row gather is written for the SP2 loop");
    int tid_ = threadIdx.x; asm volatile("" : "+v"(tid_));
    const int tid = tid_, wid = __builtin_amdgcn_readfirstlane(tid >> 6), lane = tid & 63, wr = wid >> 2, wc = wid & 3, fr = lane & 15, fq = lane >> 4;
    const int K = g.K, RB = F8 ? K : 2 * K  , nt = RB / (2 * BK);
    unsigned voffA[2], voffB[2];
#pragma unroll
    for (int i = 0; i < 2; ++i) { int R, C; stage_rc(tid * 16 + i * 8192, R, C); const int Rb = Epi::PERM ? ((R & ~31) + perm32(R & 31)) : R;
        voffA[i] = (unsigned)(R * RB + C * 2); voffB[i] = (unsigned)(Rb * RB + C * 2); }
    unsigned voffG[2][2], voffN[2][2];
#define PG8_GOFF(dst, uidx) do { _Pragma("unroll") for (int i_ = 0; i_ < 2; ++i_) { int R_, C_; stage_rc(tid * 16 + i_ * 8192, R_, C_); _Pragma("unroll") for (int h_ = 0; h_ < 2; ++h_) dst[h_][i_] = (unsigned)(GA.tok(uidx, h_ * HALF + R_) * RB + C_ * 2); } } while (0)
#define PG8_STAGE_A(bufoff, gbase, h, NX) do { if constexpr (Gath::ON) { PG8_STAGE(bufoff, gbase, ((NX) ? voffN : voffG)[h]); } else { PG8_STAGE(bufoff, (gbase) + (h) * hstep, voffA); } } while (0)
    const size_t kstep = (size_t)(BK * 2);
    const size_t hstep = (size_t)HALF * RB;
    const size_t tstep = 2 * hstep;
    const unsigned ldsw = (unsigned)wid * 1024u;
    const int aoff = lds_byte(wr * 64 + fr, fq * 8), boff = lds_byte(wc * 32 + fr, fq * 8);
#define PG8_SA(b, h) (((b) * 2 + (h)) * HTB)
#define PG8_SB(b, h) ((4 + (b) * 2 + (h)) * HTB)
#define PG8_STAGE(bufoff, gbase, voff) do { _Pragma("unroll") for (int _i = 0; _i < 2; ++_i) \
        __builtin_amdgcn_global_load_lds((const unsigned*)((const char*)(gbase) + (voff)[_i]), (PG8_LAS unsigned*)(lds + (bufoff) + ldsw + _i * 8192), 16, 0, 0); } while (0)
#define PG8_LDA(dst, b, h) do { _Pragma("unroll") for (int m = 0; m < 4; ++m) _Pragma("unroll") for (int k = 0; k < 2; ++k) dst[m][k] = *(const PG8_LAS bf16x8*)(lds + PG8_SA(b, h) + aoff + m * 2048 + k * 1024); } while (0)
#define PG8_LDB(dst, b, h) do { _Pragma("unroll") for (int n = 0; n < 2; ++n) _Pragma("unroll") for (int k = 0; k < 2; ++k) dst[n][k] = *(const PG8_LAS bf16x8*)(lds + PG8_SB(b, h) + boff + n * 2048 + k * 1024); } while (0)
#define PG8_CAT8(x) __builtin_shufflevector(__builtin_bit_cast(v4i_t, (x)[0]), __builtin_bit_cast(v4i_t, (x)[1]), 0, 1, 2, 3, 4, 5, 6, 7)
#define PG8_MMA(ai, bj, At, Bt) do { __builtin_amdgcn_s_setprio(1); if constexpr (F8) { _Pragma("unroll") for (int m = 0; m < 4; ++m) _Pragma("unroll") for (int n = 0; n < 2; ++n) \
        asm("v_mfma_f32_16x16x128_f8f6f4 %0, %1, %2, %0" : "+v"(acc[ai][bj][m][n]) : "v"(PG8_CAT8(Bt[n])), "v"(PG8_CAT8(At[m]))); } else { \
        _Pragma("unroll") for (int m = 0; m < 4; ++m) _Pragma("unroll") for (int n = 0; n < 2; ++n) _Pragma("unroll") for (int k = 0; k < 2; ++k) \
        acc[ai][bj][m][n] = __builtin_amdgcn_mfma_f32_16x16x32_bf16(Bt[n][k], At[m][k], acc[ai][bj][m][n], 0, 0, 0); } __builtin_amdgcn_s_setprio(0); } while (0)
#define PG8_WAIT_V(n) asm volatile("s_waitcnt vmcnt(" #n ")" ::: "memory")
#define PG8_WAIT_L(n) asm volatile("s_waitcnt lgkmcnt(" #n ")" ::: "memory")
#define PG8_BAR __builtin_amdgcn_s_barrier()
#define PG8_SCHED __builtin_amdgcn_sched_barrier(0)
    Unit cur, nxt; int ui = 0;
    if (!S.next(0, cur)) return;
    float zf_ = 0.f; asm volatile("" : "+v"(zf_));
    f32x4 acc[2][2][4][2];
#pragma unroll
    for (int a = 0; a < 2; ++a)
#pragma unroll
        for (int b = 0; b < 2; ++b)
#pragma unroll
            for (int m = 0; m < 4; ++m)
#pragma unroll
                for (int n = 0; n < 2; ++n) acc[a][b][m][n] = (f32x4){zf_, zf_, zf_, zf_};
    bf16x8 At[4][2], B0[2][2], B1[2][2];
    const char* cA = (const char*)g.A + (Gath::ON ? (size_t)0 : (size_t)cur.pm * tstep) + (Sched::VARK ? cur.koff : 0); const char* cB = (const char*)g.Bt + (size_t)cur.pnb * tstep + (Sched::VARK ? cur.koff : 0);
    if constexpr (Gath::ON) { PG8_GOFF(voffG, 0); }
    S.a_ready(cur);
    if constexpr (SP2) {
        PG8_STAGE(PG8_SB(0, 0), cB, voffB); PG8_STAGE(PG8_SB(0, 1), cB + hstep, voffB); PG8_STAGE_A(PG8_SA(0, 0), cA, 0, false); PG8_STAGE_A(PG8_SA(0, 1), cA, 1, false);
        if (wr == 1) PG8_BAR;
        PG8_WAIT_V(2); PG8_BAR;
        PG8_STAGE(PG8_SB(1, 0), cB + kstep, voffB); PG8_STAGE_A(PG8_SA(1, 0), cA + kstep, 0, false); PG8_STAGE(PG8_SB(1, 1), cB + hstep + kstep, voffB);
        PG8_WAIT_V(6); PG8_BAR;
    } else {
        PG8_STAGE(PG8_SB(0, 0), cB, voffB); PG8_STAGE(PG8_SA(0, 0), cA, voffA); PG8_STAGE(PG8_SB(0, 1), cB + hstep, voffB); PG8_STAGE(PG8_SA(0, 1), cA + hstep, voffA);
        if (wr == 1) PG8_BAR;
        PG8_WAIT_V(4); PG8_BAR;
        PG8_STAGE(PG8_SB(1, 0), cB + kstep, voffB); PG8_STAGE(PG8_SA(1, 0), cA + kstep, voffA); PG8_STAGE(PG8_SB(1, 1), cB + hstep + kstep, voffB);
        PG8_WAIT_V(6); PG8_BAR;
    }
    for (;;) {
        const bool has_next = S.next(ui + 1, nxt);
        const char* nA = (has_next && !Gath::ON) ? (const char*)g.A + (size_t)nxt.pm * tstep + (Sched::VARK ? nxt.koff : 0) : cA; const char* nB = has_next ? (const char*)g.Bt + (size_t)nxt.pnb * tstep + (Sched::VARK ? nxt.koff : 0) : cB;
        const int ntu = Sched::VARK ? cur.nt : nt;
        for (int t = 0; t < ntu; t += 2) {
            const bool last = (t == ntu - 2);
            const char* a1 = cA + (size_t)(t + 1) * kstep;
            const char* a2 = last ? nA : cA + (size_t)(t + 2) * kstep; const char* b2 = last ? nB : cB + (size_t)(t + 2) * kstep;
            const char* a3 = a2 + kstep; const char* b3 = b2 + kstep;
            if (last && has_next) S.a_ready(nxt);
            if constexpr (Gath::ON) { if (last) { PG8_GOFF(voffN, has_next ? ui + 1 : ui); } }
            if constexpr (SP2) {
            PG8_LDB(B0, 0, 0); PG8_LDB(B1, 0, 1); PG8_SCHED; PG8_LDA(At, 0, 0); PG8_STAGE_A(PG8_SA(1, 1), a1, 1, false);
            PG8_WAIT_V(8); PG8_WAIT_L(0); PG8_BAR; PG8_MMA(0, 0, At, B0); PG8_MMA(0, 1, At, B1); PG8_BAR; PG8_SCHED;
            PG8_LDA(At, 0, 1); PG8_STAGE(PG8_SB(0, 0), b2, voffB); PG8_STAGE(PG8_SB(0, 1), b2 + hstep, voffB); PG8_STAGE_A(PG8_SA(0, 0), a2, 0, last);
            PG8_WAIT_V(8); PG8_WAIT_L(0); PG8_BAR; PG8_MMA(1, 0, At, B0); PG8_MMA(1, 1, At, B1); PG8_BAR; PG8_SCHED;
            PG8_LDB(B0, 1, 0); PG8_LDB(B1, 1, 1); PG8_SCHED; PG8_LDA(At, 1, 0); PG8_STAGE_A(PG8_SA(0, 1), a2, 1, last);
            PG8_WAIT_V(8); PG8_WAIT_L(0); PG8_BAR; PG8_MMA(0, 0, At, B0); PG8_MMA(0, 1, At, B1); PG8_BAR; PG8_SCHED;
            PG8_LDA(At, 1, 1); PG8_STAGE(PG8_SB(1, 0), b3, voffB); PG8_STAGE(PG8_SB(1, 1), b3 + hstep, voffB); PG8_STAGE_A(PG8_SA(1, 0), a3, 0, last);
            PG8_WAIT_V(8); PG8_WAIT_L(0); PG8_BAR; PG8_MMA(1, 0, At, B0); PG8_MMA(1, 1, At, B1); PG8_BAR; PG8_SCHED;
            } else {
            PG8_LDB(B0, 0, 0); PG8_SCHED; PG8_LDA(At, 0, 0); PG8_STAGE(PG8_SA(1, 1), a1 + hstep, voffA);
            PG8_WAIT_L(8); PG8_BAR; PG8_WAIT_L(0); PG8_MMA(0, 0, At, B0); PG8_BAR; PG8_SCHED;
            PG8_LDB(B1, 0, 1); PG8_STAGE(PG8_SB(0, 0), b2, voffB);
            PG8_BAR; PG8_WAIT_L(0); PG8_MMA(0, 1, At, B1); PG8_BAR;
            PG8_LDA(At, 0, 1); PG8_STAGE(PG8_SA(0, 0), a2, voffA);
            PG8_BAR; PG8_WAIT_L(0); PG8_MMA(1, 0, At, B0); PG8_BAR; PG8_SCHED;
            PG8_STAGE(PG8_SB(0, 1), b2 + hstep, voffB);
            PG8_WAIT_V(6); PG8_BAR; PG8_MMA(1, 1, At, B1); PG8_BAR;
            PG8_LDB(B0, 1, 0); PG8_SCHED; PG8_LDA(At, 1, 0); PG8_STAGE(PG8_SA(0, 1), a2 + hstep, voffA);
            PG8_WAIT_L(8); PG8_BAR; PG8_WAIT_L(0); PG8_MMA(0, 0, At, B0); PG8_BAR; PG8_SCHED;
            PG8_LDB(B1, 1, 1); PG8_STAGE(PG8_SB(1, 0), b3, voffB);
            PG8_BAR; PG8_WAIT_L(0); PG8_MMA(0, 1, At, B1); PG8_BAR;
            PG8_LDA(At, 1, 1); PG8_STAGE(PG8_SA(1, 0), a3, voffA);
            PG8_BAR; PG8_WAIT_L(0); PG8_MMA(1, 0, At, B0); PG8_BAR; PG8_SCHED;
            PG8_STAGE(PG8_SB(1, 1), b3 + hstep, voffB);
            PG8_WAIT_V(6); PG8_BAR; PG8_MMA(1, 1, At, B1); PG8_BAR;
            }
        }
        if constexpr (F8) { asm volatile("s_nop 15\n\ts_nop 15" ::: "memory"); PG8_SCHED; }
        if constexpr (ALIGN_EPI) { if (wr == 0) PG8_BAR; }
        if constexpr (!Epi::AFTER_DRAIN) { E(acc, cur, wr, wc, fr, fq); S.done(cur); }
        if (!has_next) break;
#pragma unroll
        for (int a = 0; a < 2; ++a)
#pragma unroll
            for (int b = 0; b < 2; ++b)
#pragma unroll
                for (int m = 0; m < 4; ++m)
#pragma unroll
                    for (int n = 0; n < 2; ++n) acc[a][b][m][n] = (f32x4){zf_, zf_, zf_, zf_};
        cur = nxt; cA = nA; cB = nB; ++ui;
        if constexpr (Gath::ON) { _Pragma("unroll") for (int h_ = 0; h_ < 2; ++h_) _Pragma("unroll") for (int i_ = 0; i_ < 2; ++i_) voffG[h_][i_] = voffN[h_][i_]; }
        if constexpr (ALIGN_EPI) { if (wr == 1) PG8_BAR; }
    }
    PG8_WAIT_V(0);
    if constexpr (!ALIGN_EPI) { if (wr == 0) PG8_BAR; }
    PG8_BAR;
    if constexpr (Epi::AFTER_DRAIN) { E.fused(acc, cur, wr, wc, fr, fq, lds, wid, lane); S.done(cur); }
#undef PG8_SA
#undef PG8_SB
#undef PG8_STAGE
#undef PG8_STAGE_A
#undef PG8_GOFF
#undef PG8_LDA
#undef PG8_LDB
#undef PG8_MMA
#undef PG8_CAT8
#undef PG8_WAIT_V
#undef PG8_WAIT_L
#undef PG8_BAR
#undef PG8_SCHED
}
}

#include <hip/hip_bf16.h>
#include <cmath>
namespace attn_body {
using bf16=__hip_bfloat16;
using bf16x8=__attribute__((ext_vector_type(8)))short;
using s16x4=__attribute__((ext_vector_type(4)))short;
using f32x16=__attribute__((ext_vector_type(16)))float;
using u32x4=__attribute__((ext_vector_type(4)))unsigned;
constexpr int SEQ=8192,D=64,PITCH=2304;
constexpr int NW=8,QBLK=32,QB=QBLK*NW,KVBLK=64,NQB=SEQ/QB;
constexpr int ATTN_UNIT_ROWS=QB;
__device__ __forceinline__ int crow(int r,int hi){return (r&3)+8*(r>>2)+4*hi;}
#define SBAR() __builtin_amdgcn_sched_barrier(0)
__device__ __forceinline__ void bmask(f32x16&p0,f32x16&p1,int T,int qw,int qabs,int hi){
  if(64*T+63-qw<=128 && qw+31-64*T<=128) return;
  const float NEG=-INFINITY; const int kb=64*T+4*hi-qabs;
  #pragma unroll
  for(int r=0;r<16;++r){const int d=kb+(r&3)+8*(r>>2); if(d>128||d<-128)p0[r]=NEG; if(d+32>128||d+32<-128)p1[r]=NEG;}
}
__device__ __forceinline__ void cmask(f32x16&p0,f32x16&p1,int jb,int qrel,int hi){
  const float NEG=-INFINITY; int kb=64*jb+4*hi;
  #pragma unroll
  for(int r=0;r<16;++r){int kv=kb+(r&3)+8*(r>>2); if(kv>qrel)p0[r]=NEG; if(kv+32>qrel)p1[r]=NEG;}
}

constexpr int NSLOT=3, SLOTB=8192;
constexpr int LDS_K=0, LDS_V=NSLOT*SLOTB, LDS_WS=2*NSLOT*SLOTB, LDS_OST=LDS_WS+NW*64*4, LDS_BYTES=LDS_OST+NW*4096;
constexpr float C2=0.125f*1.4426950408889634f;
__device__ __forceinline__ void glds16(const void*gsrc,unsigned lds_dst){unsigned keep;
  asm volatile("s_mov_b32 %0, m0\n\ts_mov_b32 m0, %2\n\ts_nop 0\n\tglobal_load_lds_dwordx4 %1, off\n\ts_mov_b32 m0, %0":"=&s"(keep):"v"(gsrc),"s"(lds_dst):"memory");}
__device__ __forceinline__ void glds16s(const void*sbase,unsigned voff,unsigned lds_dst){unsigned keep;
  asm volatile("s_mov_b32 %0, m0\n\ts_mov_b32 m0, %3\n\ts_nop 0\n\tglobal_load_lds_dwordx4 %1, %2\n\ts_mov_b32 m0, %0":"=&s"(keep):"v"(voff),"s"(sbase),"s"(lds_dst):"memory");}
__device__ __forceinline__ float max3f(float a,float b,float c){float r;asm("v_max3_f32 %0, %1, %2, %3":"=v"(r):"v"(a),"v"(b),"v"(c));return r;}
__device__ __forceinline__ float max2f(float a,float b){float r;asm("v_max_f32_e32 %0, %1, %2":"=v"(r):"v"(a),"v"(b));return r;}
__device__ __forceinline__ float fadd_s(float a,float b){float r;asm("v_add_f32_e32 %0, %1, %2":"=v"(r):"v"(a),"v"(b));return r;}
__device__ __forceinline__ float fsub_s(float a,float b){float r;asm("v_sub_f32_e32 %0, %1, %2":"=v"(r):"v"(a),"v"(b));return r;}
typedef float f32x2_t __attribute__((ext_vector_type(2))); typedef __bf16 bf16x2_t __attribute__((ext_vector_type(2)));
__device__ __forceinline__ unsigned cvtpk_s(float lo,float hi){f32x2_t v={lo,hi};bf16x2_t b=__builtin_convertvector(v,bf16x2_t);return __builtin_bit_cast(unsigned,b);}
#define WAIT_BAR(N) asm volatile("s_waitcnt vmcnt(" #N ") lgkmcnt(0)\n\ts_barrier":::"memory")

__device__ __forceinline__ void qkt(f32x16&p0,f32x16&p1,const char*Kslot,const bf16x8*qr,const f32x16&negm,int r32,int hi){
  const char*kb=Kslot+hi*1024+r32*16;
  #pragma unroll
  for(int d0=0;d0<4;++d0){
    const bf16x8 b0=*reinterpret_cast<const bf16x8*>(kb+d0*2048);
    const bf16x8 b1=*reinterpret_cast<const bf16x8*>(kb+d0*2048+512);
    if(d0==0){p0=__builtin_amdgcn_mfma_f32_32x32x16_bf16(b0,qr[0],negm,0,0,0);p1=__builtin_amdgcn_mfma_f32_32x32x16_bf16(b1,qr[0],negm,0,0,0);}
    else{p0=__builtin_amdgcn_mfma_f32_32x32x16_bf16(b0,qr[d0],p0,0,0,0);p1=__builtin_amdgcn_mfma_f32_32x32x16_bf16(b1,qr[d0],p1,0,0,0);}}
}
typedef __attribute__((address_space(3))) const char* lds_cptr;
typedef short v4i16_t __attribute__((ext_vector_type(4)));
__device__ __forceinline__ void kload8(bf16x8*kf,lds_cptr kp){
  kf[0]=*(const __attribute__((address_space(3))) bf16x8*)(kp);      kf[1]=*(const __attribute__((address_space(3))) bf16x8*)(kp+512);
  kf[2]=*(const __attribute__((address_space(3))) bf16x8*)(kp+2048); kf[3]=*(const __attribute__((address_space(3))) bf16x8*)(kp+2560);
  kf[4]=*(const __attribute__((address_space(3))) bf16x8*)(kp+4096); kf[5]=*(const __attribute__((address_space(3))) bf16x8*)(kp+4608);
  kf[6]=*(const __attribute__((address_space(3))) bf16x8*)(kp+6144); kf[7]=*(const __attribute__((address_space(3))) bf16x8*)(kp+6656);
}
__device__ __forceinline__ void kload2(bf16x8*kf,lds_cptr kp,int j){ kf[2*j]=*(const __attribute__((address_space(3))) bf16x8*)(kp+j*2048); kf[2*j+1]=*(const __attribute__((address_space(3))) bf16x8*)(kp+j*2048+512); }
__device__ __forceinline__ s16x4 vtr(lds_cptr p){ return __builtin_bit_cast(s16x4,__builtin_amdgcn_ds_read_tr16_b64_v4i16((__attribute__((address_space(3))) v4i16_t*)p)); }
__device__ __forceinline__ float rowmax(const f32x16&p0,const f32x16&p1){
  float a=max3f(p0[0],p0[1],p1[0]),b=max3f(p0[2],p0[3],p1[1]);a=max3f(a,p1[2],p1[3]);
  #pragma unroll
  for(int r=4;r<16;r+=4){a=max3f(a,p0[r],p0[r+1]);b=max3f(b,p0[r+2],p0[r+3]);a=max3f(a,p1[r],p1[r+1]);b=max3f(b,p1[r+2],p1[r+3]);}
  const float m=max2f(a,b);
  auto rr=__builtin_amdgcn_permlane32_swap(__float_as_uint(m),__float_as_uint(m),false,false);
  return max2f(__uint_as_float(rr[0]),__uint_as_float(rr[1]));
}
__device__ __forceinline__ void pv(f32x16*o,int vb,bf16x8 pa0,bf16x8 pa1,bf16x8 pa2,bf16x8 pa3){
  #pragma unroll
  for(int d0=0;d0<2;++d0){s16x4 lo[4],hi[4];
    #pragma unroll
    for(int ks=0;ks<4;++ks){
      asm volatile("ds_read_b64_tr_b16 %0,%1 offset:%c2":"=&v"(lo[ks]):"v"(vb),"i"(d0*4096+ks*1024):"memory");
      asm volatile("ds_read_b64_tr_b16 %0,%1 offset:%c2":"=&v"(hi[ks]):"v"(vb),"i"(d0*4096+ks*1024+512):"memory");}
    asm volatile("s_waitcnt lgkmcnt(0)":::"memory");SBAR();
    #define PK(k) (bf16x8){lo[k][0],lo[k][1],lo[k][2],lo[k][3],hi[k][0],hi[k][1],hi[k][2],hi[k][3]}
    o[d0]=__builtin_amdgcn_mfma_f32_32x32x16_bf16(pa0,PK(0),o[d0],0,0,0);
    o[d0]=__builtin_amdgcn_mfma_f32_32x32x16_bf16(pa1,PK(1),o[d0],0,0,0);
    o[d0]=__builtin_amdgcn_mfma_f32_32x32x16_bf16(pa2,PK(2),o[d0],0,0,0);
    o[d0]=__builtin_amdgcn_mfma_f32_32x32x16_bf16(pa3,PK(3),o[d0],0,0,0);
    #undef PK
  }
}

#ifndef ATTN_STORE16
#define ATTN_STORE16(p,v) (*(u32x4*)(p)=(v))
#endif
template<int THRL,bool WIN> __device__ __forceinline__ void attn_unit(const bf16*Qb,const bf16*__restrict__ Kb,const bf16*__restrict__ Vb,bf16*Ob,int opitch,int q0,float sink_l2,char*shm){
  int tid_=threadIdx.x; asm volatile("":"+v"(tid_)); const int tid=tid_,lane=tid&63,r32=lane&31,hi=lane>>5; const int wid=__builtin_amdgcn_readfirstlane(tid>>6);
  const bf16*Qw=Qb+(long)(q0+wid*QBLK)*PITCH;
  const int tq=q0/KVBLK; const int ta=WIN?(tq-2<0?0:tq-2):0; const int tb=WIN?(tq+6>SEQ/KVBLK?SEQ/KVBLK:tq+6):SEQ/KVBLK;
  const int NT=tb-ta; const int s0=WIN?(tq+1-ta):0;
  #define TMAP(t) (WIN?(ta+(((t)+s0>=NT)?(t)+s0-NT:(t)+s0)):(t))
  const unsigned lds0=(unsigned)(uintptr_t)shm;
  float*wsf=(float*)(shm+LDS_WS)+wid*64;
  const bf16*ksrc=Kb+(long)lane*PITCH+wid*8;
  const bf16*vsrc=Vb+(long)(16*(wid&3)+(lane>>2))*PITCH+(wid>>2)*32+(lane&3)*8;
  const unsigned kdst=lds0+LDS_K+wid*1024, vdst=lds0+LDS_V+wid*1024;
  #define DMA_K(t,slot) glds16(ksrc+(long)TMAP(t)*KVBLK*PITCH,(unsigned)__builtin_amdgcn_readfirstlane(kdst+(slot)))
  #define DMA_V(t,slot) glds16(vsrc+(long)TMAP(t)*KVBLK*PITCH,(unsigned)__builtin_amdgcn_readfirstlane(vdst+(slot)))
  const int vb0=(int)(lds0+LDS_V)+((lane>>4)&1)*32+(lane&3)*8+(4*hi+((lane&15)>>2))*64;
  const char*Kbase=shm+LDS_K; bf16x8 kf[8];
  const lds_cptr shm3=(lds_cptr)shm; const lds_cptr kp0=shm3+LDS_K+hi*1024+r32*16; const lds_cptr vp0=shm3+LDS_V+((lane>>4)&1)*32+(lane&3)*8+(4*hi+((lane&15)>>2))*64;
  DMA_K(0,0);DMA_V(0,0);DMA_K(1,SLOTB);
  bf16x8 qr[4];
  #pragma unroll
  for(int d0=0;d0<4;++d0)qr[d0]=*reinterpret_cast<const bf16x8*>(&Qw[(long)r32*PITCH+d0*16+hi*8]);
  float zf_=0.f; asm volatile("":"+v"(zf_)); f32x16 zz_; _Pragma("unroll") for(int r=0;r<16;++r)zz_[r]=zf_;
  float mhat=0.f,l_reg=0.f;f32x16 o[2];o[0]=zz_;o[1]=zz_;f32x16 negm=zz_;asm volatile("":"+v"(negm));
  const int qw=q0+wid*QBLK, qabs=qw+r32;
  #define CMASK(P0,P1,t) do{ if constexpr(WIN) bmask(P0,P1,TMAP(t),qw,qabs,hi); }while(0)
  bool resc=false;
  #define START(P0,P1) do{ const float rm=rowmax(P0,P1); resc=false; \
    { const float dl=rm; mhat=fadd_s(mhat,dl); \
      _Pragma("unroll") for(int r=0;r<16;++r){P0[r]=fsub_s(P0[r],dl);P1[r]=fsub_s(P1[r],dl);} \
      _Pragma("unroll") for(int r=0;r<16;++r)negm[r]=-mhat; asm volatile("":"+v"(negm)); } \
    _Pragma("unroll") for(int r=0;r<16;++r)P0[r]=__builtin_amdgcn_exp2f(P0[r]); }while(0)
  #define RESC() do{ if(resc){ asm volatile("s_waitcnt lgkmcnt(0)":::"memory"); \
      _Pragma("unroll") for(int d_=0;d_<2;++d_) _Pragma("unroll") for(int r=0;r<16;++r)o[d_][r]*=wsf[crow(r,hi)]; } }while(0)
  f32x16 pA0,pA1,pB0,pB1;
  int sl_prev=0,sl_cur=0,sl_next=SLOTB;
  #define ROT() do{sl_prev=sl_cur;sl_cur=sl_next;sl_next=(sl_next==(NSLOT-1)*SLOTB)?0:sl_next+SLOTB;}while(0)
  DMA_K(2,2*SLOTB);
  WAIT_BAR(3);
  qkt(pA0,pA1,Kbase,qr,negm,r32,hi);asm volatile("s_nop 15\n\ts_nop 7":"+v"(pA0),"+v"(pA1));CMASK(pA0,pA1,0);
  START(pA0,pA1);
  _Pragma("unroll") for(int r=0;r<16;++r)pA1[r]=__builtin_amdgcn_exp2f(pA1[r]);
  WAIT_BAR(0);
  DMA_K(3,0);DMA_V(1,SLOTB);
  ROT();
  kload8(kf,kp0+sl_cur);
  WAIT_BAR(2);
  u32x4 pw0,pw1,pw2,pw3; { const unsigned zu_=__float_as_uint(zf_); pw0=(u32x4){zu_,zu_,zu_,zu_}; pw1=pw0; pw2=pw0; pw3=pw0; }
  #define PKW(P,B) cvtpk_s(P[B],P[B+1])
  #define PAF(k) __builtin_bit_cast(bf16x8,pw##k)
  #define VFR(i) (bf16x8){vlo[i][0],vlo[i][1],vlo[i][2],vlo[i][3],vhi[i][0],vhi[i][1],vhi[i][2],vhi[i][3]}
  #define PIN(x) asm volatile("":"+v"(x))
  #define MX3(a,b,c) __builtin_fmaxf(__builtin_fmaxf((a),(b)),(c))
  #define GAPA(MF,A0,A1,A2,A3,W0,W1,PW) do{ MF; sacc+=A0; sacc+=A1; sacc+=A2; sacc+=A3; PIN(sacc); W0; W1; PIN(PW); SBAR(); }while(0)
  #define EX(v) __builtin_amdgcn_exp2f(v)
  #define GAPB(MF,X,B) do{ MF; X[B]=EX(X[B]); X[B+1]=EX(X[B+1]); X[B+2]=EX(X[B+2]); X[B+3]=EX(X[B+3]); PIN(X); SBAR(); }while(0)
  #define VRD(i) do{ vlo[i]=vtr(vp_+(((i)>>2)*4096+((i)&3)*1024)); vhi[i]=vtr(vp_+(((i)>>2)*4096+((i)&3)*1024+512)); }while(0)
  #define KRD(G,j) do{ if(G){ kload2(kf,kp0+sl_next,j); SBAR(); } }while(0)
  #define STEP(C0,C1,P0,P1,t,GK,GV,GL) do{ SBAR(); s16x4 vlo[8],vhi[8]; \
    const lds_cptr vp_=vp0+sl_prev; \
    VRD(0); SBAR(); float sacc=(P0[0]+P0[1]); \
    GAPA(C0=__builtin_amdgcn_mfma_f32_32x32x16_bf16(kf[0],qr[0],negm,0,0,0), P0[2],P0[3],P0[4],P0[5],     pw0[0]=PKW(P0,0), pw0[1]=PKW(P0,2), pw0); \
    VRD(4); SBAR(); GAPA(C1=__builtin_amdgcn_mfma_f32_32x32x16_bf16(kf[1],qr[0],negm,0,0,0), P0[6],P0[7],P0[8],P0[9],     pw0[2]=PKW(P0,4), pw0[3]=PKW(P0,6), pw0); \
    VRD(1); SBAR(); GAPA(C0=__builtin_amdgcn_mfma_f32_32x32x16_bf16(kf[2],qr[1],C0,0,0,0),   P0[10],P0[11],P0[12],P0[13], pw1[0]=PKW(P0,8), pw1[1]=PKW(P0,10), pw1); \
    VRD(5); SBAR(); GAPA(C1=__builtin_amdgcn_mfma_f32_32x32x16_bf16(kf[3],qr[1],C1,0,0,0),   P0[14],P0[15],P1[0],P1[1],   pw1[2]=PKW(P0,12),pw1[3]=PKW(P0,14), pw1); \
    VRD(2); SBAR(); GAPA(C0=__builtin_amdgcn_mfma_f32_32x32x16_bf16(kf[4],qr[2],C0,0,0,0),   P1[2],P1[3],P1[4],P1[5],     pw2[0]=PKW(P1,0), pw2[1]=PKW(P1,2), pw2); \
    VRD(6); SBAR(); GAPA(C1=__builtin_amdgcn_mfma_f32_32x32x16_bf16(kf[5],qr[2],C1,0,0,0),   P1[6],P1[7],P1[8],P1[9],     pw2[2]=PKW(P1,4), pw2[3]=PKW(P1,6), pw2); \
    VRD(3); SBAR(); GAPA(C0=__builtin_amdgcn_mfma_f32_32x32x16_bf16(kf[6],qr[3],C0,0,0,0),   P1[10],P1[11],P1[12],P1[13], pw3[0]=PKW(P1,8), pw3[1]=PKW(P1,10), pw3); \
    VRD(7); SBAR(); GAPA(C1=__builtin_amdgcn_mfma_f32_32x32x16_bf16(kf[7],qr[3],C1,0,0,0),   P1[14],P1[15],0.f,0.f,       pw3[2]=PKW(P1,12),pw3[3]=PKW(P1,14), pw3); \
    l_reg+=sacc; \
    if(GK){DMA_K((t)+3,sl_cur);} if(GV){DMA_V((t)+1,sl_next);} \
    CMASK(C0,C1,t); \
    { float a=MX3(C0[0],C0[1],C1[0]),b=MX3(C0[2],C0[3],C1[1]); a=MX3(a,C1[2],C1[3]); \
      _Pragma("unroll") for(int r=4;r<16;r+=4){a=MX3(a,C0[r],C0[r+1]);b=MX3(b,C0[r+2],C0[r+3]);a=MX3(a,C1[r],C1[r+1]);b=MX3(b,C1[r+2],C1[r+3]);} \
      float rm=__builtin_fmaxf(a,b); { auto rr=__builtin_amdgcn_permlane32_swap(__float_as_uint(rm),__float_as_uint(rm),false,false); rm=__builtin_fmaxf(__uint_as_float(rr[0]),__uint_as_float(rr[1])); } \
      resc=false; \
      if(__builtin_expect(__any(rm>(float)THRL),0)){ const float dl=__builtin_fmaxf(rm,0.f); mhat+=dl; \
        _Pragma("unroll") for(int r=0;r<16;++r){C0[r]-=dl;C1[r]-=dl;} \
        _Pragma("unroll") for(int r=0;r<16;++r)negm[r]=-mhat; asm volatile("":"+v"(negm)); \
        const float f=__builtin_amdgcn_exp2f(-dl); l_reg*=f; if(hi==0)wsf[r32]=f; resc=true; } } \
    SBAR(); \
    GAPB(o[0]=__builtin_amdgcn_mfma_f32_32x32x16_bf16(PAF(0),VFR(0),o[0],0,0,0), C0,0); \
    GAPB(o[1]=__builtin_amdgcn_mfma_f32_32x32x16_bf16(PAF(0),VFR(4),o[1],0,0,0), C0,4); \
    KRD(GL,0); GAPB(o[0]=__builtin_amdgcn_mfma_f32_32x32x16_bf16(PAF(1),VFR(1),o[0],0,0,0), C0,8); \
    KRD(GL,1); GAPB(o[1]=__builtin_amdgcn_mfma_f32_32x32x16_bf16(PAF(1),VFR(5),o[1],0,0,0), C0,12); \
    KRD(GL,2); GAPB(o[0]=__builtin_amdgcn_mfma_f32_32x32x16_bf16(PAF(2),VFR(2),o[0],0,0,0), C1,0); \
    KRD(GL,3); GAPB(o[1]=__builtin_amdgcn_mfma_f32_32x32x16_bf16(PAF(2),VFR(6),o[1],0,0,0), C1,4); \
    GAPB(o[0]=__builtin_amdgcn_mfma_f32_32x32x16_bf16(PAF(3),VFR(3),o[0],0,0,0), C1,8); \
    GAPB(o[1]=__builtin_amdgcn_mfma_f32_32x32x16_bf16(PAF(3),VFR(7),o[1],0,0,0), C1,12); \
    }while(0)
  int t=1;
  for(;t+5<NT;t+=2){
    STEP(pB0,pB1,pA0,pA1,t,true,true,true);     WAIT_BAR(2); RESC(); ROT();
    STEP(pA0,pA1,pB0,pB1,t+1,true,true,true);   WAIT_BAR(2); RESC(); ROT();
  }
  #define ENDW(tt) do{ if((tt)+3<NT){WAIT_BAR(2);} else if((tt)+2<NT){WAIT_BAR(1);} else {WAIT_BAR(0);} }while(0)
  for(;t+1<NT;t+=2){
    STEP(pB0,pB1,pA0,pA1,t,(t+3<NT),(t+1<NT),(t+1<NT));       ENDW(t);   RESC(); ROT();
    STEP(pA0,pA1,pB0,pB1,t+1,(t+4<NT),(t+2<NT),(t+2<NT));     ENDW(t+1); RESC(); ROT();
  }
  STEP(pB0,pB1,pA0,pA1,NT-1,false,false,false); RESC();
  { float sacc=pB0[0]+pB0[1]; _Pragma("unroll") for(int r=2;r<16;++r)sacc+=pB0[r]; _Pragma("unroll") for(int r=0;r<16;++r)sacc+=pB1[r]; l_reg+=sacc;
    pw0=(u32x4){PKW(pB0,0),PKW(pB0,2),PKW(pB0,4),PKW(pB0,6)};pw1=(u32x4){PKW(pB0,8),PKW(pB0,10),PKW(pB0,12),PKW(pB0,14)};pw2=(u32x4){PKW(pB1,0),PKW(pB1,2),PKW(pB1,4),PKW(pB1,6)};pw3=(u32x4){PKW(pB1,8),PKW(pB1,10),PKW(pB1,12),PKW(pB1,14)};
    SBAR(); pv(o,vb0+sl_cur,PAF(0),PAF(1),PAF(2),PAF(3)); }
  #undef PKW
  #undef PAF
  #undef VFR
  #undef PIN
  #undef MX3
  #undef GAPA
  #undef GAPB
  #undef EX
  #undef VRD
  #undef KRD
  #undef STEP
  #undef ENDW
  {auto rr=__builtin_amdgcn_permlane32_swap(__float_as_uint(l_reg),__float_as_uint(l_reg),false,false);l_reg=__uint_as_float(rr[0])+__uint_as_float(rr[1]);}
  if constexpr(WIN) l_reg+=__builtin_amdgcn_exp2f(sink_l2-mhat);
  if(hi==0)wsf[32+r32]=l_reg;asm volatile("s_waitcnt lgkmcnt(0)":::"memory");
  float rli[16];
  #pragma unroll
  for(int r=0;r<16;++r)rli[r]=__builtin_amdgcn_rcpf(wsf[32+crow(r,hi)]);
  bf16*Ow=Ob+(long)(q0+wid*QBLK)*opitch;
  { bf16*stg=(bf16*)(shm+LDS_OST)+wid*2048;
    #pragma unroll
    for(int r=0;r<16;++r){const int orow=crow(r,hi);
      #pragma unroll
      for(int d0=0;d0<2;++d0)stg[orow*64+d0*32+r32]=__float2bfloat16(o[d0][r]*rli[r]);}
    asm volatile("s_waitcnt lgkmcnt(0)":::"memory");
    #pragma unroll
    for(int i=0;i<4;++i){const int row=i*8+(lane>>3),ch=lane&7; const u32x4 v=*(const u32x4*)(stg+row*64+ch*8); ATTN_STORE16(Ow+(long)row*opitch+ch*8,v);} }
  asm volatile("s_waitcnt lgkmcnt(0)\n\ts_barrier":::"memory");
  #undef DMA_K
  #undef TMAP
  #undef DMA_V
  #undef CMASK
  #undef START
  #undef RESC
  #undef ROT
}
constexpr int DSLOT=16384, D_LDS_K=0, D_LDS_V=3*DSLOT, D_LDS_WS=6*DSLOT, D_LDS_Q=D_LDS_WS+NW*256, D_LDS_BYTES=D_LDS_Q+NW*4096;
typedef __attribute__((address_space(3))) char* lds_ptr;
__device__ __forceinline__ void pv4(f32x16*o,int vb,bf16x8 pa0,bf16x8 pa1,bf16x8 pa2,bf16x8 pa3){
  #pragma unroll
  for(int d0=0;d0<4;++d0){s16x4 lo[4],hi[4];
    #pragma unroll
    for(int ks=0;ks<4;++ks){
      asm volatile("ds_read_b64_tr_b16 %0,%1 offset:%c2":"=&v"(lo[ks]):"v"(vb),"i"(d0*4096+ks*1024):"memory");
      asm volatile("ds_read_b64_tr_b16 %0,%1 offset:%c2":"=&v"(hi[ks]):"v"(vb),"i"(d0*4096+ks*1024+512):"memory");}
    asm volatile("s_waitcnt lgkmcnt(0)":::"memory");SBAR();
    #define PK(k) (bf16x8){lo[k][0],lo[k][1],lo[k][2],lo[k][3],hi[k][0],hi[k][1],hi[k][2],hi[k][3]}
    o[d0]=__builtin_amdgcn_mfma_f32_32x32x16_bf16(pa0,PK(0),o[d0],0,0,0);
    o[d0]=__builtin_amdgcn_mfma_f32_32x32x16_bf16(pa1,PK(1),o[d0],0,0,0);
    o[d0]=__builtin_amdgcn_mfma_f32_32x32x16_bf16(pa2,PK(2),o[d0],0,0,0);
    o[d0]=__builtin_amdgcn_mfma_f32_32x32x16_bf16(pa3,PK(3),o[d0],0,0,0);
    #undef PK
  }
}
__device__ __forceinline__ float half_sum(float v){
  #define HS_DPP(ctrl) v+=__builtin_bit_cast(float,__builtin_amdgcn_update_dpp(0,__builtin_bit_cast(int,v),ctrl,0xF,0xF,true))
  HS_DPP(0xB1); HS_DPP(0x4E); HS_DPP(0x141); HS_DPP(0x140);
  #undef HS_DPP
  v+=__builtin_bit_cast(float,__builtin_amdgcn_ds_swizzle(__builtin_bit_cast(int,v),0x401F));
  return v;
}
template<int THRL> __device__ __forceinline__ void dattn_unit(const bf16*Qb,const bf16*__restrict__ Kb,const bf16*__restrict__ Vb,bf16*Ob,int q0,float lam,float omli,const float*subg,char*shm){
  constexpr int OPITCH=1024; constexpr float DEPS=1e-6f;
  int tid_=threadIdx.x; asm volatile("":"+v"(tid_)); const int tid=tid_,lane=tid&63,r32=lane&31,hi=lane>>5; const int wid=__builtin_amdgcn_readfirstlane(tid>>6);
  const int qg=wid>>1,c=wid&1;
  const bf16*Qw=Qb+(long)(q0+qg*QBLK)*PITCH+c*64;
  constexpr int NT=SEQ/KVBLK;
  const unsigned lds0=(unsigned)(uintptr_t)shm;
  float*wsf=(float*)(shm+D_LDS_WS)+wid*64;
  const unsigned ksoff=(unsigned)(lane*PITCH+wid*8)*2u;
  const unsigned vsoff=(unsigned)((16*(wid&3)+(lane>>2))*PITCH+(wid>>2)*32+(lane&3)*8)*2u;
  const unsigned kdst=lds0+D_LDS_K+wid*1024, vdst=lds0+D_LDS_V+wid*1024;
  #define WB(a,b) do{ if(PROBE==20){WAIT_BAR(b);}else{WAIT_BAR(a);} if(PROBE==22){asm volatile("s_barrier":::"memory");} }while(0)
  #define RFL(x) ((unsigned)__builtin_amdgcn_readfirstlane(x))
  #define DMA_K1(t,slot) do{ glds16s(Kb+(long)(t)*KVBLK*PITCH,ksoff,RFL(kdst+(slot))); glds16s(Kb+64+(long)(t)*KVBLK*PITCH,ksoff,RFL(kdst+8192+(slot))); }while(0)
  #define DMA_K(t,slot) do{ DMA_K1(t,slot); if(PROBE==20){DMA_K1(t,slot);} }while(0)
  #define DMA_KA(t,slot) glds16s(Kb+(long)(t)*KVBLK*PITCH,ksoff,RFL(kdst+(slot)))
  #define DMA_KB(t,slot) glds16s(Kb+64+(long)(t)*KVBLK*PITCH,ksoff,RFL(kdst+8192+(slot)))
  #define DMA_VA(t,slot) glds16s(Vb+(long)(t)*KVBLK*PITCH,vsoff,RFL(vdst+(slot)))
  #define DMA_VB(t,slot) glds16s(Vb+64+(long)(t)*KVBLK*PITCH,vsoff,RFL(vdst+8192+(slot)))
  #define DMA_V1(t,slot) do{ glds16s(Vb+(long)(t)*KVBLK*PITCH,vsoff,RFL(vdst+(slot))); glds16s(Vb+64+(long)(t)*KVBLK*PITCH,vsoff,RFL(vdst+8192+(slot))); }while(0)
  #define DMA_V(t,slot) do{ DMA_V1(t,slot); if(PROBE==20){DMA_V1(t,slot);} }while(0)
  const int vb0=(int)(lds0+D_LDS_V)+((lane>>4)&1)*32+(lane&3)*8+(4*hi+((lane&15)>>2))*64;
  const char*Kbase=shm+D_LDS_K+c*8192; bf16x8 kf[8];
  const lds_cptr shm3=(lds_cptr)shm; const lds_cptr kp0=shm3+D_LDS_K+c*8192+hi*1024+r32*16; const lds_cptr vp0=shm3+D_LDS_V+((lane>>4)&1)*32+(lane&3)*8+(4*hi+((lane&15)>>2))*64;
  DMA_K(0,0);DMA_V(0,0);DMA_K(1,DSLOT);
  const __attribute__((address_space(3))) bf16x8*qsp=(const __attribute__((address_space(3))) bf16x8*)((lds_ptr)shm+D_LDS_Q+wid*4096)+lane;
  { bf16x8 qr[4];
    #pragma unroll
    for(int d0=0;d0<4;++d0)qr[d0]=*reinterpret_cast<const bf16x8*>(&Qw[(long)r32*PITCH+d0*16+hi*8]);
    #pragma unroll
    for(int d0=0;d0<4;++d0)((__attribute__((address_space(3))) bf16x8*)qsp)[64*d0]=qr[d0];
    asm volatile("s_waitcnt lgkmcnt(0)":::"memory"); }
  #define QF(d0) (qsp[64*(d0)])
  float zf_=0.f; asm volatile("":"+v"(zf_)); f32x16 zz_; _Pragma("unroll") for(int r=0;r<16;++r)zz_[r]=zf_;
  float mhat=0.f,l_reg=0.f;f32x16 o[4];o[0]=zz_;o[1]=zz_;o[2]=zz_;o[3]=zz_;f32x16 negm=zz_;asm volatile("":"+v"(negm));
  bool resc=false;
  #define START(P0,P1) do{ const float rm=rowmax(P0,P1); resc=false; \
    { const float dl=rm; mhat=fadd_s(mhat,dl); \
      _Pragma("unroll") for(int r=0;r<16;++r){P0[r]=fsub_s(P0[r],dl);P1[r]=fsub_s(P1[r],dl);} \
      _Pragma("unroll") for(int r=0;r<16;++r)negm[r]=-mhat; asm volatile("":"+v"(negm)); } \
    _Pragma("unroll") for(int r=0;r<16;++r)P0[r]=__builtin_amdgcn_exp2f(P0[r]); }while(0)
  #define RESC() do{ if(resc){ asm volatile("s_waitcnt lgkmcnt(0)":::"memory"); \
      _Pragma("unroll") for(int d_=0;d_<4;++d_) _Pragma("unroll") for(int r=0;r<16;++r)o[d_][r]*=wsf[crow(r,hi)]; } }while(0)
  f32x16 pA0,pA1,pB0,pB1;
  int sl_prev=0,sl_cur=0,sl_next=DSLOT;
  #define ROT() do{sl_prev=sl_cur;sl_cur=sl_next;sl_next=(sl_next==2*DSLOT)?0:sl_next+DSLOT;}while(0)
  DMA_K(2,2*DSLOT);
  WB(6,12);
  { bf16x8 qr[4]; _Pragma("unroll") for(int d0=0;d0<4;++d0)qr[d0]=QF(d0); qkt(pA0,pA1,Kbase,qr,negm,r32,hi); }asm volatile("s_nop 15\n\ts_nop 7":"+v"(pA0),"+v"(pA1));
  START(pA0,pA1);
  _Pragma("unroll") for(int r=0;r<16;++r)pA1[r]=__builtin_amdgcn_exp2f(pA1[r]);
  WAIT_BAR(0);
  DMA_K(3,0);DMA_V(1,DSLOT);
  ROT();
  kload8(kf,kp0+sl_cur);
  WB(4,8);
  u32x4 pw0,pw1,pw2,pw3; { const unsigned zu_=__float_as_uint(zf_); pw0=(u32x4){zu_,zu_,zu_,zu_}; pw1=pw0; pw2=pw0; pw3=pw0; }
  #define PKW(P,B) cvtpk_s(P[B],P[B+1])
  #define PAF(k) __builtin_bit_cast(bf16x8,pw##k)
  #define VFR(i) (bf16x8){vlo[i][0],vlo[i][1],vlo[i][2],vlo[i][3],vhi[i][0],vhi[i][1],vhi[i][2],vhi[i][3]}
  #define PIN(x) asm volatile("":"+v"(x))
  #define MX3(a,b,c) __builtin_fmaxf(__builtin_fmaxf((a),(b)),(c))
  #define GAPA(MF,A0,A1,A2,A3,W0,W1,PW) do{ MF; sacc+=A0; sacc+=A1; sacc+=A2; sacc+=A3; PIN(sacc); if(PROBE==23){float d0_; asm volatile("v_add_f32 %0, %1, %1\n\tv_add_f32 %0, %1, %1\n\tv_add_f32 %0, %1, %1\n\tv_add_f32 %0, %1, %1":"=&v"(d0_):"v"(sacc));} W0; W1; PIN(PW); SBAR(); }while(0)
  #define EX(v) __builtin_amdgcn_exp2f(v)
  #define GAPB(MF,X,B) do{ MF; X[B]=EX(X[B]); X[B+1]=EX(X[B+1]); if(PROBE==21){float d0_,d1_; asm volatile("v_exp_f32 %0, %2\n\tv_exp_f32 %1, %3":"=&v"(d0_),"=&v"(d1_):"v"(X[B]),"v"(X[B+1]));} PIN(X); SBAR(); }while(0)
  #define GAPM(MF,OPS) do{ MF; OPS; SBAR(); }while(0)
  #define MXG(X0,X1,r) mxa=MX3(mxa,X0[r],X0[(r)+1]); mxb=MX3(mxb,X0[(r)+2],X0[(r)+3]); mxa=MX3(mxa,X1[r],X1[(r)+1]); mxb=MX3(mxb,X1[(r)+2],X1[(r)+3]); PIN(mxa); PIN(mxb)
  #define GAPE2(MF,X,i0,i1) do{ MF; X[i0]=EX(X[i0]); X[i1]=EX(X[i1]); PIN(X); SBAR(); }while(0)
  #define GAPE3(MF,X,i0,i1,i2) do{ MF; X[i0]=EX(X[i0]); X[i1]=EX(X[i1]); X[i2]=EX(X[i2]); PIN(X); SBAR(); }while(0)
  #define VRD(i) do{ vlo[i]=vtr(vp_+(((i)>>2)*4096+((i)&3)*1024)); vhi[i]=vtr(vp_+(((i)>>2)*4096+((i)&3)*1024+512)); }while(0)
  #define VRD2(i) do{ vlo[i]=vtr(vp_+(((i)>>2)*4096+8192+((i)&3)*1024)); vhi[i]=vtr(vp_+(((i)>>2)*4096+8192+((i)&3)*1024+512)); SBAR(); }while(0)
  #define KRD(G,j) do{ if(G){ kload2(kf,kp0+sl_next,j); SBAR(); } }while(0)
  #define MF32(a,b,cc) __builtin_amdgcn_mfma_f32_32x32x16_bf16(a,b,cc,0,0,0)
  #define STEP(C0,C1,P0,P1,t,GK,GV,GL) do{ SBAR(); s16x4 vlo[8],vhi[8]; \
    const lds_cptr vp_=vp0+sl_prev; \
    VRD(0); SBAR(); float sacc=(P0[0]+P0[1]); \
    GAPA(C0=MF32(kf[0],qa,negm), P0[2],P0[3],P0[4],P0[5],     pw0[0]=PKW(P0,0), pw0[1]=PKW(P0,2), pw0); \
    VRD(4); SBAR(); GAPA(C1=MF32(kf[1],qa,negm), P0[6],P0[7],P0[8],P0[9],     pw0[2]=PKW(P0,4), pw0[3]=PKW(P0,6), pw0); \
    VRD(1); qa=QF(2); SBAR(); GAPA(C0=MF32(kf[2],qb,C0),   P0[10],P0[11],P0[12],P0[13], pw1[0]=PKW(P0,8), pw1[1]=PKW(P0,10), pw1); \
    VRD(5); SBAR(); GAPA(C1=MF32(kf[3],qb,C1),   P0[14],P0[15],P1[0],P1[1],   pw1[2]=PKW(P0,12),pw1[3]=PKW(P0,14), pw1); \
    VRD(2); qb=QF(3); SBAR(); GAPA(C0=MF32(kf[4],qa,C0),   P1[2],P1[3],P1[4],P1[5],     pw2[0]=PKW(P1,0), pw2[1]=PKW(P1,2), pw2); \
    VRD(6); SBAR(); GAPA(C1=MF32(kf[5],qa,C1),   P1[6],P1[7],P1[8],P1[9],     pw2[2]=PKW(P1,4), pw2[3]=PKW(P1,6), pw2); \
    VRD(3); SBAR(); GAPA(C0=MF32(kf[6],qb,C0),   P1[10],P1[11],P1[12],P1[13], pw3[0]=PKW(P1,8), pw3[1]=PKW(P1,10), pw3); \
    VRD(7); SBAR(); GAPA(C1=MF32(kf[7],qb,C1),   P1[14],P1[15],0.f,0.f,       pw3[2]=PKW(P1,12),pw3[3]=PKW(P1,14), pw3); \
    l_reg+=sacc; \
    float mxa,mxb; SBAR(); \
    GAPM(o[0]=MF32(PAF(0),VFR(0),o[0]), mxa=MX3(C0[0],C0[1],C1[0]); mxb=MX3(C0[2],C0[3],C1[1]); mxa=MX3(mxa,C1[2],C1[3]); PIN(mxa); PIN(mxb));  VRD2(0); \
    GAPM(o[1]=MF32(PAF(0),VFR(4),o[1]), MXG(C0,C1,4));  VRD2(4); if(GK){DMA_KA((t)+3,sl_cur);} \
    GAPM(o[0]=MF32(PAF(1),VFR(1),o[0]), MXG(C0,C1,8));  VRD2(1); \
    GAPM(o[1]=MF32(PAF(1),VFR(5),o[1]), MXG(C0,C1,12)); VRD2(5); \
    { float rm=__builtin_fmaxf(mxa,mxb); { auto rr=__builtin_amdgcn_permlane32_swap(__float_as_uint(rm),__float_as_uint(rm),false,false); rm=__builtin_fmaxf(__uint_as_float(rr[0]),__uint_as_float(rr[1])); } \
      resc=false; \
      if(__builtin_expect(__any(rm>(float)THRL),0)){ const float dl=__builtin_fmaxf(rm,0.f); mhat+=dl; \
        _Pragma("unroll") for(int r=0;r<16;++r){C0[r]-=dl;C1[r]-=dl;} \
        _Pragma("unroll") for(int r=0;r<16;++r)negm[r]=-mhat; asm volatile("":"+v"(negm)); \
        const float f=__builtin_amdgcn_exp2f(-dl); l_reg*=f; if(hi==0)wsf[r32]=f; resc=true; } } \
    SBAR(); \
    GAPE3(o[0]=MF32(PAF(2),VFR(2),o[0]), C0,0,1,2);    VRD2(2); \
    GAPE3(o[1]=MF32(PAF(2),VFR(6),o[1]), C0,3,4,5);    VRD2(6); if(GK){DMA_KB((t)+3,sl_cur);} \
    GAPE2(o[0]=MF32(PAF(3),VFR(3),o[0]), C0,6,7);      VRD2(3); \
    GAPE3(o[1]=MF32(PAF(3),VFR(7),o[1]), C0,8,9,10);   VRD2(7); \
    GAPE3(o[2]=MF32(PAF(0),VFR(0),o[2]), C0,11,12,13); \
    GAPE2(o[3]=MF32(PAF(0),VFR(4),o[3]), C0,14,15); if(GV){DMA_VA((t)+1,sl_next);} \
    KRD(GL,0); GAPE3(o[2]=MF32(PAF(1),VFR(1),o[2]), C1,0,1,2); \
    KRD(GL,1); GAPE3(o[3]=MF32(PAF(1),VFR(5),o[3]), C1,3,4,5); \
    KRD(GL,2); GAPE2(o[2]=MF32(PAF(2),VFR(2),o[2]), C1,6,7); \
    KRD(GL,3); GAPE3(o[3]=MF32(PAF(2),VFR(6),o[3]), C1,8,9,10); if(GV){DMA_VB((t)+1,sl_next);} \
    qa=QF(0); SBAR(); GAPE3(o[2]=MF32(PAF(3),VFR(3),o[2]), C1,11,12,13); \
    qb=QF(1); SBAR(); GAPE2(o[3]=MF32(PAF(3),VFR(7),o[3]), C1,14,15); \
    }while(0)
  bf16x8 qa=QF(0),qb=QF(1);
  int t=1;
  for(;t+5<NT;t+=2){
    STEP(pB0,pB1,pA0,pA1,t,true,true,true);     WB(4,8); RESC(); ROT();
    STEP(pA0,pA1,pB0,pB1,t+1,true,true,true);   WB(4,8); RESC(); ROT();
  }
  #define ENDW(tt) do{ if((tt)+3<NT){WB(4,8);} else if((tt)+2<NT){WB(2,4);} else {WAIT_BAR(0);} }while(0)
  for(;t+1<NT;t+=2){
    STEP(pB0,pB1,pA0,pA1,t,(t+3<NT),(t+1<NT),(t+1<NT));       ENDW(t);   RESC(); ROT();
    STEP(pA0,pA1,pB0,pB1,t+1,(t+4<NT),(t+2<NT),(t+2<NT));     ENDW(t+1); RESC(); ROT();
  }
  STEP(pB0,pB1,pA0,pA1,NT-1,false,false,false); RESC();
  { float sacc=pB0[0]+pB0[1]; _Pragma("unroll") for(int r=2;r<16;++r)sacc+=pB0[r]; _Pragma("unroll") for(int r=0;r<16;++r)sacc+=pB1[r]; l_reg+=sacc;
    pw0=(u32x4){PKW(pB0,0),PKW(pB0,2),PKW(pB0,4),PKW(pB0,6)};pw1=(u32x4){PKW(pB0,8),PKW(pB0,10),PKW(pB0,12),PKW(pB0,14)};pw2=(u32x4){PKW(pB1,0),PKW(pB1,2),PKW(pB1,4),PKW(pB1,6)};pw3=(u32x4){PKW(pB1,8),PKW(pB1,10),PKW(pB1,12),PKW(pB1,14)};
    SBAR(); pv4(o,vb0+sl_cur,PAF(0),PAF(1),PAF(2),PAF(3)); }
  #undef PKW
  #undef PAF
  #undef VFR
  #undef PIN
  #undef MX3
  #undef GAPA
  #undef GAPB
  #undef GAPM
  #undef MXG
  #undef GAPE2
  #undef GAPE3
  #undef EX
  #undef VRD
  #undef VRD2
  #undef KRD
  #undef MF32
  #undef QF
  #undef STEP
  #undef ENDW
  {auto rr=__builtin_amdgcn_permlane32_swap(__float_as_uint(l_reg),__float_as_uint(l_reg),false,false);l_reg=__uint_as_float(rr[0])+__uint_as_float(rr[1]);}
  if(hi==0)wsf[32+r32]=l_reg;asm volatile("s_waitcnt lgkmcnt(0)":::"memory");
  float rli[16];
  #pragma unroll
  for(int r=0;r<16;++r)rli[r]=__builtin_amdgcn_rcpf(wsf[32+crow(r,hi)]);
  asm volatile("s_waitcnt lgkmcnt(0)\n\ts_barrier":::"memory");
  int tide_=threadIdx.x; asm volatile("":"+v"(tide_)); const int lane_e=tide_&63;
  __attribute__((address_space(3))) float*xf=(__attribute__((address_space(3))) float*)((lds_ptr)shm+qg*16384)+lane_e;
  if(c==1){
    #pragma unroll
    for(int d_=0;d_<4;++d_)
      #pragma unroll
      for(int r=0;r<16;++r)xf[(d_*16+r)*64]=o[d_][r]*rli[r];
  }
  asm volatile("s_waitcnt lgkmcnt(0)\n\ts_barrier":::"memory");
  if(c==0){
    float ss[16];
    #pragma unroll
    for(int r=0;r<16;++r)ss[r]=0.f;
    #pragma unroll
    for(int d_=0;d_<4;++d_)
      #pragma unroll
      for(int r=0;r<16;++r){const float v=o[d_][r]*rli[r]-lam*xf[(d_*16+r)*64];o[d_][r]=v;ss[r]+=v*v;}
    #pragma unroll
    for(int r=0;r<16;++r){const float s=half_sum(ss[r]);ss[r]=omli/sqrtf(s*(1.f/128.f)+DEPS);}
    __attribute__((address_space(3))) unsigned short*sb=(__attribute__((address_space(3))) unsigned short*)((lds_ptr)shm+65536+qg*8192);
    #pragma unroll
    for(int d_=0;d_<4;++d_){const float g=subg[d_*32+r32];
      #pragma unroll
      for(int r=0;r<16;++r){const float y=o[d_][r]*ss[r]*g; sb[crow(r,hi)*128+d_*32+r32]=(unsigned short)(cvtpk_s(y,y)&0xffffu);}}
    asm volatile("s_waitcnt lgkmcnt(0)":::"memory");
    bf16*Ow=Ob+(long)(q0+qg*QBLK)*OPITCH;
    #pragma unroll
    for(int i=0;i<8;++i){const int row=i*4+(lane_e>>4),ch=lane_e&15; const u32x4 v=*(const __attribute__((address_space(3))) u32x4*)(sb+row*128+ch*8); ATTN_STORE16(Ow+(long)row*OPITCH+ch*8,v);}
  }
  asm volatile("s_waitcnt lgkmcnt(0)\n\ts_barrier":::"memory");
  #undef DMA_K
  #undef DMA_V
  #undef RFL
  #undef WB
  #undef DMA_K1
  #undef DMA_KA
  #undef DMA_KB
  #undef DMA_VA
  #undef DMA_VB
  #undef DMA_V1
  #undef START
  #undef RESC
  #undef ROT
}

typedef int v4i_a __attribute__((ext_vector_type(4)));
typedef int v8i_a __attribute__((ext_vector_type(8)));
#define CAT8A(a,b) __builtin_shufflevector((a),(b),0,1,2,3,4,5,6,7)
template<int THRL> __device__ __forceinline__ void dattn_unit_f8(const unsigned char*P8,const unsigned char*VTh,int h,bf16*Ob,int q0,float lam,float omli,const float*subg,char*shm){
  constexpr int OPITCH=1024,P8P=1536; constexpr float DEPS=1e-6f; constexpr int NT=SEQ/64; constexpr int SLOT=8192,F_K=0,F_V=3*SLOT,F_WS=6*SLOT;
  int tid_=threadIdx.x; asm volatile("":"+v"(tid_)); const int tid=tid_,lane=tid&63,r32=lane&31,hi=lane>>5; const int wid=__builtin_amdgcn_readfirstlane(tid>>6);
  const int qg=wid>>1,c=wid&1;
  const unsigned lds0=(unsigned)(uintptr_t)shm;
  float*wsf=(float*)(shm+F_WS)+wid*64;
  #define RFL(x) ((unsigned)__builtin_amdgcn_readfirstlane(x))
  const unsigned char*Kg=P8+512+h*128;
  const unsigned kvoff=(unsigned)(lane*P8P+(wid&3)*16+(wid>>2)*64);
  const unsigned vvoff=(unsigned)(((wid>>2)*64+lane)*SEQ+(wid&3)*16);
  const unsigned kdst=lds0+F_K+wid*1024, vdst=lds0+F_V+(wid&3)*2048+(wid>>2)*1024;
  #define DMAK(t,slot) glds16s(Kg+(long)(t)*64*P8P,kvoff,RFL(kdst+(slot)))
  #define DMAV(t,slot) glds16s(VTh+(long)(t)*64,vvoff,RFL(vdst+(slot)))
  v8i_a q8; { const unsigned char*Qp=P8+(long)(q0+qg*32+r32)*P8P+h*128+c*64+hi*32; const v4i_a qa=*(const v4i_a*)Qp, qb=*(const v4i_a*)(Qp+16); q8=CAT8A(qa,qb); }
  DMAK(0,0);DMAV(0,0);DMAK(1,SLOT);DMAV(1,SLOT);
  typedef __attribute__((address_space(3))) const v4i_a* lv4;
  const lds_cptr shm3=(lds_cptr)shm; const lds_cptr kp0=shm3+F_K+c*4096+(2*hi)*1024+r32*16, vp0=shm3+F_V+(2*hi)*2048+r32*16;
  float zf_=0.f; asm volatile("":"+v"(zf_)); f32x16 zz_; _Pragma("unroll") for(int r=0;r<16;++r)zz_[r]=zf_;
  float mhat=0.f; f32x16 o[4]; o[0]=zz_;o[1]=zz_;o[2]=zz_;o[3]=zz_; f32x16 lacc=zz_; f32x16 negm=zz_; asm volatile("":"+v"(negm));
  v8i_a ones; { int on_=0x38383838; asm volatile("":"+v"(on_)); _Pragma("unroll") for(int j=0;j<8;++j)ones[j]=on_; }
  #define MFQK(C,KF) asm volatile("v_mfma_f32_32x32x64_f8f6f4 %0, %1, %2, %3":"=&v"(C):"v"(KF),"v"(q8),"v"(negm))
  #define MFPV(O,VF) asm volatile("v_mfma_f32_32x32x64_f8f6f4 %0, %1, %2, %0":"+v"(O):"v"(pw),"v"(VF))
  #define KFRAG(kp) const v8i_a kf0=CAT8A(*(lv4)(kp),*(lv4)((kp)+1024)), kf1=CAT8A(*(lv4)((kp)+512),*(lv4)((kp)+1536))
  #define VFRAG(vp) do{ vf0=CAT8A(*(lv4)(vp),*(lv4)((vp)+2048)); vf1=CAT8A(*(lv4)((vp)+512),*(lv4)((vp)+2560)); vf2=CAT8A(*(lv4)((vp)+1024),*(lv4)((vp)+3072)); vf3=CAT8A(*(lv4)((vp)+1536),*(lv4)((vp)+3584)); }while(0)
  #define SOFTMAX(FIRST,WAITO) do{ const float rm=rowmax(C0,C1); \
    if((FIRST)||__any(rm>(float)THRL)){ const float dl=(FIRST)?rm:__builtin_fmaxf(rm,0.f); mhat+=dl; \
      _Pragma("unroll") for(int r=0;r<16;++r){C0[r]-=dl;C1[r]-=dl;} \
      _Pragma("unroll") for(int r=0;r<16;++r)negm[r]=-mhat; asm volatile("":"+v"(negm)); \
      if(!(FIRST)){ const float f=__builtin_amdgcn_exp2f(-dl); if(hi==0)wsf[r32]=f; \
        if(WAITO){ _Pragma("unroll") for(int rep_=0;rep_<RESC_NOPS;++rep_) asm volatile("s_nop 15\n\ts_nop 15\n\ts_nop 15\n\ts_nop 15\n\ts_nop 15\n\ts_nop 15":"+v"(o[0]),"+v"(o[1]),"+v"(o[2]),"+v"(o[3]),"+v"(lacc)); } \
        asm volatile("s_waitcnt lgkmcnt(0)":::"memory"); \
        _Pragma("unroll") for(int r=0;r<16;++r){ const float fr_=wsf[crow(r,hi)]; o[0][r]*=fr_; o[1][r]*=fr_; o[2][r]*=fr_; o[3][r]*=fr_; lacc[r]*=fr_; } } } \
    _Pragma("unroll") for(int r=0;r<16;++r){C0[r]=__builtin_amdgcn_exp2f(C0[r]);C1[r]=__builtin_amdgcn_exp2f(C1[r]);} \
    _Pragma("unroll") for(int j=0;j<4;++j){ int w0=0,w1=0; \
      w0=__builtin_amdgcn_cvt_pk_fp8_f32(C0[4*j],C0[4*j+1],w0,false); w0=__builtin_amdgcn_cvt_pk_fp8_f32(C0[4*j+2],C0[4*j+3],w0,true); \
      w1=__builtin_amdgcn_cvt_pk_fp8_f32(C1[4*j],C1[4*j+1],w1,false); w1=__builtin_amdgcn_cvt_pk_fp8_f32(C1[4*j+2],C1[4*j+3],w1,true); \
      pw[j]=w0; pw[4+j]=w1; } }while(0)
  #define DRAIN() do{ float d_=lacc[15]; asm volatile("v_mov_b32 %0, %0":"+v"(d_),"+v"(C0),"+v"(C1)::"memory"); }while(0)
  v8i_a pw,vf0,vf1,vf2,vf3; f32x16 C0,C1;
  int sl=0,sl2=2*SLOT;
  #define ROTS() do{ sl=(sl==2*SLOT)?0:sl+SLOT; sl2=(sl2==2*SLOT)?0:sl2+SLOT; }while(0)
  if(wid<LEAD_WAVES){
    WAIT_BAR(2); DMAK(2,sl2);DMAV(2,sl2);
    { KFRAG(kp0); MFQK(C0,kf0); MFQK(C1,kf1); VFRAG(vp0); asm volatile("s_nop 15\n\ts_nop 15":"+v"(C0),"+v"(C1)); SOFTMAX(true,false); }
    ROTS();
    #pragma unroll 1
    for(int t=1;t<NT;++t){
      if(t+1<NT){WAIT_BAR(2);}else{WAIT_BAR(0);}
      if(t+2<NT){DMAK(t+2,sl2);DMAV(t+2,sl2);}
      { KFRAG(kp0+sl); MFQK(C0,kf0); MFQK(C1,kf1); }
      MFPV(o[0],vf0); SBAR();
      asm volatile("":"+v"(C0));
      float ma=max3f(C0[0],C0[1],C0[2]); ma=max3f(ma,C0[3],C0[4]); ma=max3f(ma,C0[5],C0[6]); ma=max3f(ma,C0[7],C0[8]); ma=max3f(ma,C0[9],C0[10]); ma=max3f(ma,C0[11],C0[12]); ma=max3f(ma,C0[13],C0[14]); ma=max2f(ma,C0[15]);
      SBAR(); MFPV(o[1],vf1); SBAR();
      asm volatile("":"+v"(C1));
      float mb=max3f(C1[0],C1[1],C1[2]); mb=max3f(mb,C1[3],C1[4]); mb=max3f(mb,C1[5],C1[6]); mb=max3f(mb,C1[7],C1[8]); mb=max3f(mb,C1[9],C1[10]); mb=max3f(mb,C1[11],C1[12]); mb=max3f(mb,C1[13],C1[14]); mb=max3f(mb,C1[15],ma);
      float rm; { auto rr=__builtin_amdgcn_permlane32_swap(__float_as_uint(mb),__float_as_uint(mb),false,false); rm=max2f(__uint_as_float(rr[0]),__uint_as_float(rr[1])); }
      SBAR(); MFPV(o[2],vf2); SBAR();
      _Pragma("unroll") for(int r=0;r<8;++r)C0[r]=__builtin_amdgcn_exp2f(C0[r]);
      SBAR(); MFPV(o[3],vf3); SBAR();
      _Pragma("unroll") for(int r=8;r<16;++r)C0[r]=__builtin_amdgcn_exp2f(C0[r]);
      SBAR(); MFPV(lacc,ones); SBAR();
      _Pragma("unroll") for(int r=0;r<16;++r)C1[r]=__builtin_amdgcn_exp2f(C1[r]);
      if(__any(rm>(float)THRL)){ const float dl=__builtin_fmaxf(rm,0.f); mhat+=dl;
        _Pragma("unroll") for(int r=0;r<16;++r)negm[r]=-mhat; asm volatile("":"+v"(negm));
        const float f=__builtin_amdgcn_exp2f(-dl); if(hi==0)wsf[r32]=f;
        _Pragma("unroll") for(int r=0;r<16;++r){C0[r]*=f;C1[r]*=f;}
        _Pragma("unroll") for(int rep_=0;rep_<RESC_NOPS;++rep_) asm volatile("s_nop 15\n\ts_nop 15\n\ts_nop 15\n\ts_nop 15\n\ts_nop 15\n\ts_nop 15":"+v"(o[0]),"+v"(o[1]),"+v"(o[2]),"+v"(o[3]),"+v"(lacc));
        asm volatile("s_waitcnt lgkmcnt(0)":::"memory");
        _Pragma("unroll") for(int r=0;r<16;++r){ const float fr_=wsf[crow(r,hi)]; o[0][r]*=fr_; o[1][r]*=fr_; o[2][r]*=fr_; o[3][r]*=fr_; lacc[r]*=fr_; } }
      _Pragma("unroll") for(int j=0;j<4;++j){ int w0=0,w1=0;
        w0=__builtin_amdgcn_cvt_pk_fp8_f32(C0[4*j],C0[4*j+1],w0,false); w0=__builtin_amdgcn_cvt_pk_fp8_f32(C0[4*j+2],C0[4*j+3],w0,true);
        w1=__builtin_amdgcn_cvt_pk_fp8_f32(C1[4*j],C1[4*j+1],w1,false); w1=__builtin_amdgcn_cvt_pk_fp8_f32(C1[4*j+2],C1[4*j+3],w1,true);
        pw[j]=w0; pw[4+j]=w1; }
      VFRAG(vp0+sl);
      ROTS();
    }
    asm volatile("s_waitcnt lgkmcnt(0)":::"memory");
    MFPV(o[0],vf0); MFPV(o[1],vf1); MFPV(o[2],vf2); MFPV(o[3],vf3); MFPV(lacc,ones);
  } else {
    WAIT_BAR(2); DMAK(2,sl2);DMAV(2,sl2);
    { KFRAG(kp0); MFQK(C0,kf0); MFQK(C1,kf1); VFRAG(vp0); asm volatile("s_nop 15\n\ts_nop 15":"+v"(C0),"+v"(C1)); SOFTMAX(true,false); }
    MFPV(o[0],vf0); MFPV(o[1],vf1); MFPV(o[2],vf2); MFPV(o[3],vf3); MFPV(lacc,ones);
    ROTS();
    #pragma unroll 1
    for(int t=1;t<NT;++t){
      if(t+1<NT){WAIT_BAR(2);}else{WAIT_BAR(0);}
      if(t+2<NT){DMAK(t+2,sl2);DMAV(t+2,sl2);}
      { KFRAG(kp0+sl); MFQK(C0,kf0); MFQK(C1,kf1); }
      VFRAG(vp0+sl);
      asm volatile("s_nop 15\n\ts_nop 15":"+v"(C0),"+v"(C1));
      SOFTMAX(false,true);
      MFPV(o[0],vf0); MFPV(o[1],vf1); MFPV(o[2],vf2); MFPV(o[3],vf3); MFPV(lacc,ones);
      ROTS();
    }
  }
  asm volatile("s_nop 15\n\ts_nop 15\n\ts_nop 15\n\ts_nop 15\n\ts_nop 15\n\ts_nop 15":"+v"(o[0]),"+v"(o[1]),"+v"(o[2]),"+v"(o[3]),"+v"(lacc));
  #undef MFQK
  #undef MFPV
  #undef KFRAG
  #undef VFRAG
  #undef SOFTMAX
  #undef ROTS
  #undef DRAIN
  float rli[16];
  #pragma unroll
  for(int r=0;r<16;++r)rli[r]=__builtin_amdgcn_rcpf(lacc[r]);
  asm volatile("s_waitcnt lgkmcnt(0)\n\ts_barrier":::"memory");
  int tide_=threadIdx.x; asm volatile("":"+v"(tide_)); const int lane_e=tide_&63;
  __attribute__((address_space(3))) float*xf=(__attribute__((address_space(3))) float*)((lds_ptr)shm+qg*16384)+lane_e;
  if(c==1){
    #pragma unroll
    for(int d_=0;d_<4;++d_)
      #pragma unroll
      for(int r=0;r<16;++r)xf[(d_*16+r)*64]=o[d_][r]*rli[r];
  }
  asm volatile("s_waitcnt lgkmcnt(0)\n\ts_barrier":::"memory");
  if(c==0){
    float ss[16];
    #pragma unroll
    for(int r=0;r<16;++r)ss[r]=0.f;
    #pragma unroll
    for(int d_=0;d_<4;++d_)
      #pragma unroll
      for(int r=0;r<16;++r){const float v=o[d_][r]*rli[r]-lam*xf[(d_*16+r)*64];o[d_][r]=v;ss[r]+=v*v;}
    #pragma unroll
    for(int r=0;r<16;++r){const float s=half_sum(ss[r]);ss[r]=omli/sqrtf(s*(1.f/128.f)+DEPS);}
    __attribute__((address_space(3))) unsigned short*sb=(__attribute__((address_space(3))) unsigned short*)((lds_ptr)shm+65536+qg*8192);
    #pragma unroll
    for(int d_=0;d_<4;++d_){const float g=subg[d_*32+r32];
      #pragma unroll
      for(int r=0;r<16;++r){const float y=o[d_][r]*ss[r]*g; sb[crow(r,hi)*128+d_*32+r32]=(unsigned short)(cvtpk_s(y,y)&0xffffu);}}
    asm volatile("s_waitcnt lgkmcnt(0)":::"memory");
    bf16*Ow=Ob+(long)(q0+qg*QBLK)*OPITCH;
    #pragma unroll
    for(int i=0;i<8;++i){const int row=i*4+(lane_e>>4),ch=lane_e&15; const u32x4 v=*(const __attribute__((address_space(3))) u32x4*)(sb+row*128+ch*8); ATTN_STORE16(Ow+(long)row*OPITCH+ch*8,v);}
  }
  asm volatile("s_waitcnt lgkmcnt(0)\n\ts_barrier":::"memory");
  #undef RFL
  #undef DMAK
  #undef DMAV
}
#undef CAT8A
constexpr int ATTN_LDS_BYTES=LDS_BYTES;
#undef SBAR
#undef WAIT_BAR
}

constexpr size_t MiB = 1u << 20;
constexpr size_t WS_CTL = 0, CTL_ZERO_BYTES = 1 * MiB;
constexpr size_t WS_MOD = 1 * MiB;
constexpr size_t WS_RC = 2 * MiB, WS_RS = 4 * MiB;
constexpr size_t WS_ROUTE = 6 * MiB, ROUTE_LAYER = 1024 * 1024;
constexpr size_t WS_WIN = 8 * MiB, WS_WOUT = 26 * MiB, WS_WGU_D = 34 * MiB, WS_WD_D = 62 * MiB, WS_WGU_M = 76 * MiB, WS_WD_M = 300 * MiB;
constexpr size_t WS_HA = 412 * MiB;
constexpr size_t WS_PROJ = 444 * MiB;
constexpr size_t WS_ATT = 516 * MiB;
constexpr size_t WS_PROJ8 = 548 * MiB;
constexpr size_t WS_VT = 576 * MiB;
constexpr size_t WS_OD = 548 * MiB;
constexpr size_t WS_HMID = 444 * MiB;
constexpr size_t WS_XS = 682 * MiB;
constexpr size_t WS_XB = 682 * MiB;
constexpr size_t WS_YSP = 716 * MiB;
constexpr size_t WS_YS = 750 * MiB;
constexpr size_t WS_END = 818 * MiB;
static_assert(WS_WD_M + (size_t)2 * NE * DM * FF * 2 <= WS_HA && WS_HMID + (size_t)PMAX * FF * 2 <= WS_XS && WS_XS + (size_t)PMAX * DM * 2 <= WS_YS && WS_YS + (size_t)PMAX * DM * 2 <= WS_END, "d_ws map");
static_assert(WS_XB + (size_t)NTOK * DM * 2 <= WS_YSP && WS_YSP + (size_t)6 * pg8::TAILROWS * DM * 2 <= WS_YS, "d_ws map 3");
static_assert(WS_OD + (size_t)2 * NTOK * 512 * 2 <= WS_HMID + (size_t)NTOK * FF * 2 + 200 * MiB, "d_ws map 2");
constexpr int CW_BAR = 4096;
constexpr int CW_IPDONE = 8192 + 1100;
constexpr int CW_QCTR = 8192 + 1024;
constexpr int CW_CNT = 8192;

constexpr int RING_OFF = 0, RING_BYTES = 135168;
constexpr int LDSCTL_OFF = RING_BYTES, MISC_OFF = LDSCTL_OFF + 320;
constexpr int TAB_OFF = MISC_OFF + 128;
constexpr int IDX_OFF = TAB_OFF + 4 * 176, IDX_UNITS = 16;
constexpr int LDS_BYTES = 155648;
static_assert(16 + NCHUNK_MAX <= 160 && IDX_OFF + IDX_UNITS * 1024 <= LDS_BYTES && (NCHUNK_MAX * (2 * FF / 256) + 255) / 256 <= IDX_UNITS && 8 * 64 * 65 * 4 <= RING_BYTES, "LDS map");

#define GAS __attribute__((address_space(1)))
#define LAS __attribute__((address_space(3)))
typedef unsigned short bf16;
typedef unsigned v4u __attribute__((ext_vector_type(4)));
typedef float f32x4 __attribute__((ext_vector_type(4)));
typedef short bf16x8 __attribute__((ext_vector_type(8)));
typedef GAS unsigned gu32;
typedef GAS unsigned long long gu64;
#define RLX_AGENT __ATOMIC_RELAXED, __HIP_MEMORY_SCOPE_AGENT
#define LDS_WAIT() asm volatile("s_waitcnt lgkmcnt(0)" ::: "memory")
#define VM_WAIT() asm volatile("s_waitcnt vmcnt(0)" ::: "memory")
__device__ __forceinline__ unsigned long long rt() { return __builtin_amdgcn_s_memrealtime(); }
__device__ __forceinline__ unsigned f2bf(float f) { unsigned u = __builtin_bit_cast(unsigned, f); return (u + 0x7fffu + ((u >> 16) & 1u)) >> 16; }
__device__ __forceinline__ unsigned pk2(float lo, float hi) { return f2bf(lo) | (f2bf(hi) << 16); }

#define XB_TMO      128
#define XB_XCNT(j)  (256  + 64 * (j))
#define XB_XSUB(j)  (1280 + 64 * (j))
#define XB_XGEN(j)  (2304 + 64 * (j))
#define XB_TOP      3328
#define XB_TOPGEN   3392
#define XCD_BAR_WORDS 3456
#define XB_SPIN_CAP (1u << 18)

__device__ __forceinline__ unsigned xb_ld(GAS unsigned* p)          { return __hip_atomic_load(p, __ATOMIC_RELAXED, __HIP_MEMORY_SCOPE_AGENT); }
__device__ __forceinline__ unsigned xb_add(GAS unsigned* p, unsigned v) { return __hip_atomic_fetch_add(p, v, __ATOMIC_RELAXED, __HIP_MEMORY_SCOPE_AGENT); }
__device__ __forceinline__ unsigned xb_xcc_id() { return (unsigned)__builtin_amdgcn_s_getreg((3 << 11) | 20) & 0xFu; }
#define XB_SPIN(cond, bar) do { unsigned _sp = 0; while (cond) { __builtin_amdgcn_s_sleep(1); \
    if ((++_sp & 255u) == 0u) { if (xb_ld(&(bar)[XB_TMO])) break; if (_sp > XB_SPIN_CAP) { (void)xb_add(&(bar)[XB_TMO], 1u); break; } } } } while (0)

struct XcdBarrier {
    unsigned* bar; unsigned x;
    volatile LAS unsigned* st;
};

__device__ __forceinline__ XcdBarrier xcd_barrier_post(unsigned* bar, volatile LAS unsigned* st) {
    XcdBarrier b; b.bar = bar; b.x = xb_xcc_id(); b.st = st;
    if (threadIdx.x == 0) (void)xb_add((GAS unsigned*)bar + XB_XCNT(b.x), 1u);
    return b;
}
__device__ __forceinline__ void xcd_barrier_complete(GAS unsigned* bar, unsigned x, unsigned& nloc, unsigned& nx) {
    const unsigned G = gridDim.x * gridDim.y * gridDim.z;
    unsigned sum, cnt, mine, sp = 0u;
    for (;;) {
        sum = 0u; cnt = 0u; mine = 0u;
#pragma unroll
        for (unsigned j = 0; j < 16; ++j) { const unsigned c = xb_ld(&bar[XB_XCNT(j)]); sum += c; cnt += (c > 0u) ? 1u : 0u; mine = (j == x) ? c : mine; }
        if (sum == G) break;
        __builtin_amdgcn_s_sleep(1);
        if ((++sp & 255u) == 0u) { if (xb_ld(&bar[XB_TMO])) break; if (sp > XB_SPIN_CAP) { (void)xb_add(&bar[XB_TMO], 1u); break; } }
    }
    nloc = mine > 0u ? mine : 1u; nx = cnt > 0u ? cnt : 1u;
}

__device__ __forceinline__ void xcd_barrier(const XcdBarrier& b) {
    asm volatile("s_waitcnt vmcnt(0)" ::: "memory");
    __syncthreads();
    if (threadIdx.x == 0) {
        GAS unsigned* bar = (GAS unsigned*)b.bar; unsigned bx_ = b.x; asm volatile("" : "+s"(bar), "+s"(bx_));
        __builtin_amdgcn_s_waitcnt(0);
        unsigned nloc = b.st[0], nx = b.st[1];
        if (nloc == 0u) { xcd_barrier_complete(bar, bx_, nloc, nx); b.st[0] = nloc; b.st[1] = nx; }
        const unsigned old = xb_add(&bar[XB_XSUB(bx_)], 1u);
        const unsigned gen = old / nloc;
        if (old + 1u == (gen + 1u) * nloc) {
            __builtin_amdgcn_fence(__ATOMIC_RELEASE, "agent");
            asm volatile("s_waitcnt vmcnt(0)" ::: "memory");
            const unsigned og = xb_add(&bar[XB_TOP], 1u);
            const unsigned tg = og / nx;
            if (og + 1u == (tg + 1u) * nx) xb_add(&bar[XB_TOPGEN], 1u);
            else XB_SPIN(xb_ld(&bar[XB_TOPGEN]) == tg, bar);
            __builtin_amdgcn_fence(__ATOMIC_ACQUIRE, "agent");
            xb_add(&bar[XB_XGEN(bx_)], 1u);
            asm volatile("s_waitcnt vmcnt(0)" ::: "memory");
        } else {
            XB_SPIN(xb_ld(&bar[XB_XGEN(bx_)]) == gen, bar);
            __builtin_amdgcn_fence(__ATOMIC_ACQUIRE, "agent");
            asm volatile("s_waitcnt vmcnt(0)" ::: "memory");
        }
    }
    __syncthreads();
}


constexpr int NWAVES = 8;
struct Frame {
    LAS unsigned char* lds;
    volatile LAS unsigned* MISC;
    gu32* ctl;
    int tid, lane, wave;
    int vcu, G;
};
__device__ __forceinline__ float wave_sum(float v) {
#define WS_DPP(ctrl) v += __builtin_bit_cast(float, __builtin_amdgcn_update_dpp(0, __builtin_bit_cast(int, v), ctrl, 0xF, 0xF, true))
    WS_DPP(0xB1); WS_DPP(0x4E); WS_DPP(0x141); WS_DPP(0x140);
#undef WS_DPP
    v += __builtin_bit_cast(float, __builtin_amdgcn_ds_swizzle(__builtin_bit_cast(int, v), 0x401F));
    const auto rr = __builtin_amdgcn_permlane32_swap(__builtin_bit_cast(unsigned, v), __builtin_bit_cast(unsigned, v), false, false);
    return __uint_as_float(rr[0]) + __uint_as_float(rr[1]);
}
__device__ __forceinline__ void sincos_acc(float angf, float& s, float& c) {
    const double a = (double)angf;
    const double k = rint(a * 0.63661977236758134308);
    double r = fma(-k, 1.57079632679489655800e+00, a); r = fma(-k, 6.12323399573676603587e-17, r);
    const double r2 = r * r;
    double sp = -2.5052108385441718775e-08; sp = sp * r2 + 2.7557319223985890653e-06; sp = sp * r2 - 1.9841269841269841253e-04; sp = sp * r2 + 8.3333333333333332177e-03; sp = sp * r2 - 1.6666666666666665741e-01;
    const double sn = r + r * r2 * sp;
    double cp = 2.0876756987868098979e-09; cp = cp * r2 - 2.7557319223985888e-07; cp = cp * r2 + 2.4801587301587301566e-05; cp = cp * r2 - 1.3888888888888889419e-03; cp = cp * r2 + 4.1666666666666664354e-02; cp = cp * r2 - 0.5;
    const double cs = 1.0 + r2 * cp;
    const int q = ((int)k) & 3;
    const double ss = (q == 0) ? sn : (q == 1) ? cs : (q == 2) ? -sn : -cs;
    const double cc = (q == 0) ? cs : (q == 1) ? -sn : (q == 2) ? -cs : sn;
    s = (float)ss; c = (float)cc;
}

template <int MAP> __device__ __forceinline__ int rowmap(int n) {
    if (MAP == 1) { const bool rope = (n < COL_VA) || (n >= COL_QD && n < COL_VD); if (!rope) return n; const int d = n & 63; return (n & ~63) + ((d < 32) ? 2 * d : 2 * (d - 32) + 1); }
    if (MAP == 2) return ((n >> 7) << 8) + (n & 127);
    if (MAP == 3) return ((n >> 7) << 8) + 128 + (n & 127);
    return n;
}
template <int MAP, bool F8 = false> __device__ __forceinline__ void cvt_item(const float* W, int K, int N, bf16* WT, LAS float* scr, int item, int lane, float f8s = 1.f) {
    const int kblk = K >> 6, nb = item / kblk, kb = item - nb * kblk, k0 = kb * 64, n0 = nb * 64;
    const GAS float* src = (const GAS float*)W + (size_t)k0 * N + n0 + lane;
    float tv[64];
#pragma unroll
    for (int kk = 0; kk < 64; ++kk) tv[kk] = __builtin_nontemporal_load(src + (size_t)kk * N);
#pragma unroll
    for (int kk = 0; kk < 64; ++kk) scr[kk * 65 + lane] = tv[kk];
    LDS_WAIT(); asm volatile("" ::: "memory");
    const int c = lane & 7;
#pragma unroll
    for (int j = 0; j < 8; ++j) { const int n = (lane >> 3) + 8 * j; const LAS float* s = scr + (8 * c) * 65 + n;
        if (F8) { const unsigned long long o8 = (unsigned long long)pg8::pack4_fp8(s[0 * 65] * f8s, s[1 * 65] * f8s, s[2 * 65] * f8s, s[3 * 65] * f8s) | ((unsigned long long)pg8::pack4_fp8(s[4 * 65] * f8s, s[5 * 65] * f8s, s[6 * 65] * f8s, s[7 * 65] * f8s) << 32);
            *(GAS unsigned long long*)((GAS unsigned char*)WT + (size_t)rowmap<MAP>(n0 + n) * K + k0 + 8 * c) = o8; }
        else { v4u o; o.x = pk2(s[0 * 65], s[1 * 65]); o.y = pk2(s[2 * 65], s[3 * 65]); o.z = pk2(s[4 * 65], s[5 * 65]); o.w = pk2(s[6 * 65], s[7 * 65]);
            *(GAS v4u*)(WT + (size_t)rowmap<MAP>(n0 + n) * K + k0 + 8 * c) = o; } }
    LDS_WAIT(); asm volatile("" ::: "memory");
}
constexpr int IT_IN = (DM / 64) * (INC / 64)  , IT_OUT = (DM / 64) * (DM / 64)  , IT_FF = (DM / 64) * (FF / 64)  ;
constexpr int IT_A = DEPTH * IT_IN, IT_B = IT_A + DEPTH * IT_OUT, IT_SET = 3 * IT_FF, NITEMS = IT_B + 18 * IT_SET;
struct Ptrs {
    const float* in[23]; float* out; unsigned char* ws;
};
struct RopeFreq { float inv[32]; };
struct Args { Ptrs p; RopeFreq rf; float lam_init[4]; int ph_lo, ph_hi; };
typedef const __attribute__((address_space(4))) Args* CArgs;
__device__ __forceinline__ CArgs kargs() { CArgs a = (CArgs)__builtin_amdgcn_kernarg_segment_ptr(); asm volatile("" : "+s"(a)); return a; }
__device__ __forceinline__ void convert_item(CArgs ka, int it, LAS float* scr, int lane) {
    const auto& P = ka->p; unsigned char* ws = P.ws;
    if (it < IT_A) { const int l = it / IT_IN, r = it - l * IT_IN; if (pg8::F8_IN) cvt_item<1, true>(P.in[7] + (size_t)l * DM * INC, DM, INC, (bf16*)(ws + WS_WIN + (size_t)l * INC * DM), scr, r, lane, pg8::F8_SW1); else cvt_item<1>(P.in[7] + (size_t)l * DM * INC, DM, INC, (bf16*)(ws + WS_WIN) + (size_t)l * INC * DM, scr, r, lane); return; }
    if (it < IT_B) { it -= IT_A; const int l = it / IT_OUT, r = it - l * IT_OUT; cvt_item<0>(P.in[8] + (size_t)l * DM * DM, DM, DM, (bf16*)(ws + WS_WOUT) + (size_t)l * DM * DM, scr, r, lane); return; }
    it -= IT_B; const int set = it / IT_SET; int r = it - set * IT_SET; const int kind = r / IT_FF; r -= kind * IT_FF;
    const float *wg, *wu, *wd; bf16 *dgu, *dd;
    bool f1, f2;
    if (set < 2) { f1 = pg8::F8_D1; f2 = pg8::F8_D2; const size_t o = (size_t)set * DM * FF; wg = P.in[15] + o; wu = P.in[16] + o; wd = P.in[17] + o; dgu = (bf16*)(ws + WS_WGU_D + (size_t)set * 2 * FF * DM * (f1 ? 1 : 2)); dd = (bf16*)(ws + WS_WD_D + (size_t)set * DM * FF * (f2 ? 1 : 2)); }
    else { f1 = pg8::F8_M1; f2 = pg8::F8_M2; const size_t o = (size_t)(set - 2) * DM * FF; wg = P.in[19] + o; wu = P.in[20] + o; wd = P.in[21] + o; dgu = (bf16*)(ws + WS_WGU_M + (size_t)(set - 2) * 2 * FF * DM * (f1 ? 1 : 2)); dd = (bf16*)(ws + WS_WD_M + (size_t)(set - 2) * DM * FF * (f2 ? 1 : 2)); }
    if (kind == 0) { if (f1) cvt_item<2, true>(wg, DM, FF, dgu, scr, r, lane, pg8::F8_SW1); else cvt_item<2>(wg, DM, FF, dgu, scr, r, lane); }
    else if (kind == 1) { if (f1) cvt_item<3, true>(wu, DM, FF, dgu, scr, r, lane, pg8::F8_SW1); else cvt_item<3>(wu, DM, FF, dgu, scr, r, lane); }
    else { if (f2) cvt_item<0, true>(wd, FF, DM, dd, scr, r, lane, pg8::F8_SW2); else cvt_item<0>(wd, FF, DM, dd, scr, r, lane); }
}
__device__ __forceinline__ void mod_item(const Frame& F, CArgs ka, int it) {
    const auto& P = ka->p;
    const int l = it / (MODB / 64), cg = it - l * (MODB / 64), col = cg * 64 + F.lane, k0 = F.wave * 128;
    const GAS float* w = (const GAS float*)P.in[3] + (size_t)l * DM * MODB + (size_t)k0 * MODB + col; const float* c = P.in[1] + k0;
    float a0 = 0.f, a1 = 0.f;
#pragma unroll 32
    for (int k = 0; k < 128; ++k) { const float wv = w[(size_t)k * MODB]; const float c0 = c[k], c1 = c[DM + k];
        a0 += (c0 / (1.f + __expf(-c0))) * wv; a1 += (c1 / (1.f + __expf(-c1))) * wv; }
    LAS float* red = (LAS float*)(F.lds + RING_OFF);
    red[(F.wave * 2 + 0) * 64 + F.lane] = a0; red[(F.wave * 2 + 1) * 64 + F.lane] = a1;
    __syncthreads();
    if (F.wave < 2) { float t = P.in[4][l * MODB + col];
#pragma unroll
        for (int w8 = 0; w8 < 8; ++w8) t += red[(w8 * 2 + F.wave) * 64 + F.lane];
        ((float*)(P.ws + WS_MOD))[((size_t)l * 2 + F.wave) * MODB + col] = t; }
    __syncthreads();
}
constexpr int PRO_ITEMS = IT_IN + IT_OUT + IT_SET;
constexpr int Q1 = IT_IN, Q2 = Q1 + IT_OUT, Q3 = Q2 + 8 * IT_SET, Q4 = Q3 + IT_IN, Q5 = Q4 + IT_OUT, Q6 = Q5 + IT_SET, Q7 = Q6 + IT_IN, Q8 = Q7 + IT_OUT, QEND = Q8 + 8 * IT_SET;
constexpr int Q3A = Q2 + 8 * 2 * IT_FF, Q8A = Q8 + 8 * 2 * IT_FF;
static_assert(QEND + PRO_ITEMS == NITEMS, "queue covers every item once");
__device__ __forceinline__ int pro_item(int p) { return p < IT_IN ? p : (p < IT_IN + IT_OUT ? IT_A + (p - IT_IN) : IT_B + (p - IT_IN - IT_OUT)); }
__device__ __forceinline__ int qitem(int q) {
    if (q < Q1) return 1 * IT_IN + q;
    if (q < Q2) return IT_A + 1 * IT_OUT + (q - Q1);
    if (q < Q3) { const int m = q - Q2; if (m < 8 * 2 * IT_FF) return IT_B + (2 + m / (2 * IT_FF)) * IT_SET + m % (2 * IT_FF);
        const int d = m - 8 * 2 * IT_FF; return IT_B + (2 + d / IT_FF) * IT_SET + 2 * IT_FF + d % IT_FF; }
    if (q < Q4) return 2 * IT_IN + (q - Q3);
    if (q < Q5) return IT_A + 2 * IT_OUT + (q - Q4);
    if (q < Q6) return IT_B + 1 * IT_SET + (q - Q5);
    if (q < Q7) return 3 * IT_IN + (q - Q6);
    if (q < Q8) return IT_A + 3 * IT_OUT + (q - Q7);
    { const int m = q - Q8; if (m < 8 * 2 * IT_FF) return IT_B + (10 + m / (2 * IT_FF)) * IT_SET + m % (2 * IT_FF);
      const int d = m - 8 * 2 * IT_FF; return IT_B + (10 + d / IT_FF) * IT_SET + 2 * IT_FF + d % IT_FF; }
}
struct CvtJob { const float* src; bf16* WT; int K, N, n0, k0, map; bool valid; float f8s; };
__device__ __forceinline__ CvtJob make_job(CArgs ka, int q) {
    CvtJob j; j.valid = q < QEND; j.src = nullptr; j.WT = nullptr; j.K = DM; j.N = DM; j.n0 = 0; j.k0 = 0; j.map = 0; j.f8s = 0.f; if (!j.valid) return j;
    const auto& P = ka->p; unsigned char* ws = P.ws; int it = qitem(q), r;
    if (it < IT_A) { const int l = it / IT_IN; r = it - l * IT_IN; j.src = P.in[7] + (size_t)l * DM * INC; j.K = DM; j.N = INC; j.WT = (bf16*)(ws + WS_WIN + (size_t)l * INC * DM * (pg8::F8_IN ? 1 : 2)); j.map = 1; j.f8s = pg8::F8_IN ? pg8::F8_SW1 : 0.f; }
    else if (it < IT_B) { it -= IT_A; const int l = it / IT_OUT; r = it - l * IT_OUT; j.src = P.in[8] + (size_t)l * DM * DM; j.K = DM; j.N = DM; j.WT = (bf16*)(ws + WS_WOUT) + (size_t)l * DM * DM; j.map = 0; }
    else { it -= IT_B; const int set = it / IT_SET; r = it - set * IT_SET; const int kind = r / IT_FF; r -= kind * IT_FF;
        const float *wg, *wu, *wd; bf16 *dgu, *dd;
        bool f1, f2;
        if (set < 2) { f1 = pg8::F8_D1; f2 = pg8::F8_D2; const size_t o = (size_t)set * DM * FF; wg = P.in[15] + o; wu = P.in[16] + o; wd = P.in[17] + o; dgu = (bf16*)(ws + WS_WGU_D + (size_t)set * 2 * FF * DM * (f1 ? 1 : 2)); dd = (bf16*)(ws + WS_WD_D + (size_t)set * DM * FF * (f2 ? 1 : 2)); }
        else { f1 = pg8::F8_M1; f2 = pg8::F8_M2; const size_t o = (size_t)(set - 2) * DM * FF; wg = P.in[19] + o; wu = P.in[20] + o; wd = P.in[21] + o; dgu = (bf16*)(ws + WS_WGU_M + (size_t)(set - 2) * 2 * FF * DM * (f1 ? 1 : 2)); dd = (bf16*)(ws + WS_WD_M + (size_t)(set - 2) * DM * FF * (f2 ? 1 : 2)); }
        if (kind == 0) { j.src = wg; j.K = DM; j.N = FF; j.WT = dgu; j.map = 2; j.f8s = f1 ? pg8::F8_SW1 : 0.f; } else if (kind == 1) { j.src = wu; j.K = DM; j.N = FF; j.WT = dgu; j.map = 3; j.f8s = f1 ? pg8::F8_SW1 : 0.f; } else { j.src = wd; j.K = FF; j.N = DM; j.WT = dd; j.map = 0; j.f8s = f2 ? pg8::F8_SW2 : 0.f; } }
    const int kblk = j.K >> 6, nb = r / kblk, kb = r - nb * kblk; j.k0 = kb * 64; j.n0 = nb * 64;
    return j;
}
__device__ __forceinline__ int rowmap_rt(int map, int n) { return map == 1 ? rowmap<1>(n) : (map == 2 ? rowmap<2>(n) : (map == 3 ? rowmap<3>(n) : n)); }
#define CVT_LOAD(J, tv) do { const GAS float* src_ = (const GAS float*)(J).src + (size_t)(J).k0 * (J).N + (J).n0 + F.lane; const size_t N_ = (size_t)(J).N; \
        _Pragma("unroll") for (int kk = 0; kk < 64; ++kk) tv[kk] = __builtin_nontemporal_load(src_ + (size_t)kk * N_); } while (0)
__device__ __forceinline__ void queue_convert(const Frame& F0, CArgs ka, int limit, int batches, const gu32* stop = nullptr, unsigned stop_at = 0u) {
    Frame F = F0; asm volatile("" : "+v"(F.tid)); F.lane = F.tid & 63;
    gu32* qc = F.ctl + CW_QCTR;
    LAS float* scr = (LAS float*)(F.lds + RING_OFF + F.wave * (64 * 65 * 4));
    volatile LAS int* slot = (volatile LAS int*)(F.lds + LDSCTL_OFF + 16);
    constexpr int SENT = 0x7fffffff;
    __syncthreads();
    if (F.tid == 0) *slot = (int)__hip_atomic_load(qc, __ATOMIC_RELAXED, __HIP_MEMORY_SCOPE_AGENT);
    __syncthreads();
    if (*slot >= limit) return;
#define QC_CLAIM(dst) do { __syncthreads(); \
        if (F.tid == 0) *slot = (stop && __hip_atomic_load(stop, __ATOMIC_RELAXED, __HIP_MEMORY_SCOPE_AGENT) >= stop_at) ? SENT : (int)__hip_atomic_fetch_add(qc, 8u, __ATOMIC_RELAXED, __HIP_MEMORY_SCOPE_AGENT); \
        __syncthreads(); dst = *slot; } while (0)
    int base; QC_CLAIM(base);
    if (base != SENT) {
        CvtJob job = make_job(ka, base + F.wave);
        float tv[64];
        if (job.valid) CVT_LOAD(job, tv);
        for (int nb = 1;; ++nb) {
            int nbase = SENT;
            if (nb < batches && base + 8 < limit) QC_CLAIM(nbase);
            CvtJob nj; nj.valid = false; if (nbase != SENT) nj = make_job(ka, nbase + F.wave);
            if (job.valid) {
#pragma unroll
                for (int kk = 0; kk < 64; ++kk) scr[kk * 65 + F.lane] = tv[kk];
                LDS_WAIT(); asm volatile("" ::: "memory"); }
            if (nj.valid) CVT_LOAD(nj, tv);
            if (job.valid) {
                const int c = F.lane & 7;
#pragma unroll
                for (int j = 0; j < 8; ++j) { const int n = (F.lane >> 3) + 8 * j; const LAS float* sp = scr + (8 * c) * 65 + n;
                    if (job.f8s != 0.f) { const float fs = job.f8s;
                        const unsigned long long o8 = (unsigned long long)pg8::pack4_fp8(sp[0 * 65] * fs, sp[1 * 65] * fs, sp[2 * 65] * fs, sp[3 * 65] * fs) | ((unsigned long long)pg8::pack4_fp8(sp[4 * 65] * fs, sp[5 * 65] * fs, sp[6 * 65] * fs, sp[7 * 65] * fs) << 32);
                        *(GAS unsigned long long*)((GAS unsigned char*)job.WT + (size_t)rowmap_rt(job.map, job.n0 + n) * job.K + job.k0 + 8 * c) = o8; }
                    else { v4u o; o.x = pk2(sp[0 * 65], sp[1 * 65]); o.y = pk2(sp[2 * 65], sp[3 * 65]); o.z = pk2(sp[4 * 65], sp[5 * 65]); o.w = pk2(sp[6 * 65], sp[7 * 65]);
                        *(GAS v4u*)(job.WT + (size_t)rowmap_rt(job.map, job.n0 + n) * job.K + job.k0 + 8 * c) = o; } }
                LDS_WAIT(); asm volatile("" ::: "memory"); }
            if (nbase == SENT) break;
            base = nbase; job = nj;
        }
    }
#undef QC_CLAIM
    __syncthreads();
}
__device__ __forceinline__ void p0_prologue(const Frame& F0, CArgs ka) {
    Frame F = F0; asm volatile("" : "+v"(F.tid)); F.lane = F.tid & 63; const auto& P = ka->p;
    { const int* pos = (const int*)P.in[2]; float* rc = (float*)(P.ws + WS_RC); float* rs = (float*)(P.ws + WS_RS);
      for (int idx = F.vcu * 512 + F.tid; idx < NTOK * 32; idx += F.G * 512) { const int tok = idx >> 5, i = idx & 31; float s, c; sincos_acc((float)pos[tok] * ka->rf.inv[i], s, c); rc[idx] = c; rs[idx] = s; } }
    for (int it = (int)blockIdx.x; it < DEPTH * (MODB / 64); it += F.G) mod_item(F, ka, it);
    LAS float* scr = (LAS float*)(F.lds + RING_OFF + F.wave * (64 * 65 * 4));
    LAS int* ctr = (LAS int*)(F.lds + LDSCTL_OFF);
    const int ipb = (PRO_ITEMS + F.G - 1) / F.G, lo = (int)blockIdx.x * ipb, hi = (lo + ipb < PRO_ITEMS) ? lo + ipb : PRO_ITEMS;
    for (;;) {
        int it = 0; if (F.lane == 0) it = __hip_atomic_fetch_add(ctr, 1, __ATOMIC_RELAXED, __HIP_MEMORY_SCOPE_WORKGROUP);
        it = lo + __builtin_amdgcn_readfirstlane(it);
        if (it >= hi) break;
        convert_item(ka, pro_item(it), scr, F.lane);
    }
    __syncthreads();
}

struct NormArgs {
    const float* xin; float* xout;
    const bf16* xinb; bf16* xoutb;
    const float* g; const float* sh; const float* sc;
    bf16* ha; float* of32;
    const bf16* ys; const float* slot_w; const float* cgate;
    const bf16* ysp; int tail0, tails;
    const float* rw; int* slot_e; int* slot_pos; float* slot_w_out; unsigned* cnt; int* row_list;
    const int* cslot_e; const int* cslot_pos;
    float oscale;
};
template <bool COMBINE, bool MODULATE, bool ROUTER, bool OUT_F32, bool XBF, bool TAILK = false, bool OUT_F8 = false>
__device__ __forceinline__ void norm_phase(const Frame& F0, const NormArgs& A) {
    Frame F = F0; asm volatile("" : "+v"(F.tid)); F.lane = F.tid & 63;
    LAS int* sE = (LAS int*)(F.lds + RING_OFF); LAS int* sR = sE + 128; LAS int* sB = sE + 256;
    for (int rb = F.vcu; rb < NTOK / 64; rb += F.G) {
        const int b = (rb * 64) / SEQ;
        f32x4 gs[4], shv[4], cg[4];
#pragma unroll
        for (int q = 0; q < 4; ++q) { const int col = 4 * F.lane + 256 * q; gs[q] = *(const f32x4*)(A.g + col);
            if (MODULATE) { gs[q] = gs[q] * (1.f + *(const f32x4*)(A.sc + (size_t)b * MODB + col)); shv[q] = *(const f32x4*)(A.sh + (size_t)b * MODB + col); }
            if (COMBINE) cg[q] = *(const f32x4*)(A.cgate + (size_t)b * MODB + col); }
        f32x4 rwv[ROUTER ? 16 : 1][2];
        if (ROUTER) {
#pragma unroll
            for (int q = 0; q < 4; ++q)
#pragma unroll
                for (int t = 0; t < 4; ++t) { const float* wp = A.rw + (size_t)(4 * F.lane + 256 * q + t) * 8; rwv[q * 4 + t][0] = *(const f32x4*)wp; rwv[q * 4 + t][1] = *(const f32x4*)(wp + 4); }
        }
#pragma unroll 1
        for (int j = 0; j < 8; j += 2) {
            const int row0 = rb * 64 + F.wave * 8 + j;
            f32x4 v[2][4];
#pragma unroll
            for (int u = 0; u < 2; ++u) {
                if (XBF) { const GAS unsigned long long* xr = (const GAS unsigned long long*)(A.xinb + (size_t)(row0 + u) * DM) + F.lane;
#pragma unroll
                    for (int q = 0; q < 4; ++q) { const unsigned long long w = xr[64 * q]; const unsigned wl = (unsigned)w, wh = (unsigned)(w >> 32);
                        v[u][q] = (f32x4){__uint_as_float(wl << 16), __uint_as_float(wl & 0xffff0000u), __uint_as_float(wh << 16), __uint_as_float(wh & 0xffff0000u)}; }
                } else { const GAS f32x4* xr = (const GAS f32x4*)(A.xin + (size_t)(row0 + u) * DM) + F.lane;
#pragma unroll
                    for (int q = 0; q < 4; ++q) v[u][q] = xr[64 * q]; } }
            if (COMBINE) {
                unsigned long long ya[2][4], yb[2][4]; float w0[2], w1[2]; int dd0[2], dd1[2];
#pragma unroll
                for (int u = 0; u < 2; ++u) { const int row = row0 + u; const LAS int* tab_ = (const LAS int*)(F.lds + TAB_OFF);
                    const int d0 = tab_[A.cslot_e[row * 2]] + A.cslot_pos[row * 2], d1 = tab_[A.cslot_e[row * 2 + 1]] + A.cslot_pos[row * 2 + 1]; w0[u] = A.slot_w[row * 2]; w1[u] = A.slot_w[row * 2 + 1];
                    dd0[u] = d0; dd1[u] = d1;
                    const GAS unsigned long long* y0 = (const GAS unsigned long long*)(A.ys + (size_t)d0 * DM) + F.lane; const GAS unsigned long long* y1 = (const GAS unsigned long long*)(A.ys + (size_t)d1 * DM) + F.lane;
#pragma unroll
                    for (int q = 0; q < 4; ++q) { ya[u][q] = y0[64 * q]; yb[u][q] = y1[64 * q]; } }
#pragma unroll
                for (int u = 0; u < 2; ++u) { GAS f32x4* xo = (GAS f32x4*)(A.xout + (size_t)(row0 + u) * DM) + F.lane; GAS unsigned long long* xob = (GAS unsigned long long*)(A.xoutb + (size_t)(row0 + u) * DM) + F.lane;
                    f32x4 ta[4], tb[4];
                    if (TAILK) {
#pragma unroll
                        for (int q = 0; q < 4; ++q) { ta[q] = (f32x4){0.f, 0.f, 0.f, 0.f}; tb[q] = ta[q]; }
                        const int t0 = __builtin_amdgcn_readfirstlane(dd0[u]) - A.tail0, t1 = __builtin_amdgcn_readfirstlane(dd1[u]) - A.tail0;
                        if (t0 >= 0) {
#pragma unroll 1
                            for (int k = 0; k < A.tails - 1; ++k) { const GAS unsigned long long* yp = (const GAS unsigned long long*)(A.ysp + ((size_t)k * pg8::TAILROWS + t0) * DM) + F.lane;
#pragma unroll
                                for (int q = 0; q < 4; ++q) { const unsigned long long w = yp[64 * q]; const unsigned wl = (unsigned)w, wh = (unsigned)(w >> 32);
                                    ta[q] = ta[q] + (f32x4){__uint_as_float(wl << 16), __uint_as_float(wl & 0xffff0000u), __uint_as_float(wh << 16), __uint_as_float(wh & 0xffff0000u)}; } } }
                        if (t1 >= 0) {
#pragma unroll 1
                            for (int k = 0; k < A.tails - 1; ++k) { const GAS unsigned long long* yp = (const GAS unsigned long long*)(A.ysp + ((size_t)k * pg8::TAILROWS + t1) * DM) + F.lane;
#pragma unroll
                                for (int q = 0; q < 4; ++q) { const unsigned long long w = yp[64 * q]; const unsigned wl = (unsigned)w, wh = (unsigned)(w >> 32);
                                    tb[q] = tb[q] + (f32x4){__uint_as_float(wl << 16), __uint_as_float(wl & 0xffff0000u), __uint_as_float(wh << 16), __uint_as_float(wh & 0xffff0000u)}; } } }
                    }
#pragma unroll
                    for (int q = 0; q < 4; ++q) {
                        const unsigned al = (unsigned)ya[u][q], ah = (unsigned)(ya[u][q] >> 32), cl = (unsigned)yb[u][q], ch = (unsigned)(yb[u][q] >> 32);
                        f32x4 fa = {__uint_as_float(al << 16), __uint_as_float(al & 0xffff0000u), __uint_as_float(ah << 16), __uint_as_float(ah & 0xffff0000u)};
                        f32x4 fb = {__uint_as_float(cl << 16), __uint_as_float(cl & 0xffff0000u), __uint_as_float(ch << 16), __uint_as_float(ch & 0xffff0000u)};
                        if (TAILK) { fa = fa + ta[q]; fb = fb + tb[q]; }
                        v[u][q] = v[u][q] + cg[q] * (fa * w0[u] + fb * w1[u]);
                        if (!OUT_F32) { if (XBF) xob[64 * q] = (unsigned long long)pk2(v[u][q].x, v[u][q].y) | ((unsigned long long)pk2(v[u][q].z, v[u][q].w) << 32); else xo[64 * q] = v[u][q]; }
                    } }
            }
#pragma unroll
            for (int u = 0; u < 2; ++u) {
                const int row = row0 + u;
                float s = 0.f;
#pragma unroll
                for (int q = 0; q < 4; ++q) s += (v[u][q].x * v[u][q].x + v[u][q].y * v[u][q].y) + (v[u][q].z * v[u][q].z + v[u][q].w * v[u][q].w);
                const float r = 1.f / sqrtf(wave_sum(s) * (1.f / DM) + EPS);
#pragma unroll
                for (int q = 0; q < 4; ++q) {
                    const int col = 4 * F.lane + 256 * q;
                    v[u][q] = v[u][q] * r * gs[q];
                    if (MODULATE) v[u][q] = v[u][q] + shv[q];
                    if (OUT_F32) *(GAS f32x4*)(A.of32 + (size_t)row * DM + col) = (PROBE >= 30) ? v[u][q] * A.oscale : v[u][q];
                    else if (OUT_F8) *(GAS unsigned*)((GAS unsigned char*)A.ha + (size_t)row * DM + col) = pg8::pack4_fp8(v[u][q].x * pg8::F8_SA, v[u][q].y * pg8::F8_SA, v[u][q].z * pg8::F8_SA, v[u][q].w * pg8::F8_SA);
                    else *(GAS unsigned long long*)(A.ha + (size_t)row * DM + col) = (unsigned long long)pk2(v[u][q].x, v[u][q].y) | ((unsigned long long)pk2(v[u][q].z, v[u][q].w) << 32);
                }
                if (ROUTER) {
                    float lg[8];
#pragma unroll
                    for (int e = 0; e < 8; ++e) lg[e] = 0.f;
#pragma unroll
                    for (int q = 0; q < 4; ++q)
#pragma unroll
                        for (int t = 0; t < 4; ++t) { const float hv = v[u][q][t]; const f32x4 w0 = rwv[q * 4 + t][0], w1 = rwv[q * 4 + t][1];
                            lg[0] += hv * w0.x; lg[1] += hv * w0.y; lg[2] += hv * w0.z; lg[3] += hv * w0.w; lg[4] += hv * w1.x; lg[5] += hv * w1.y; lg[6] += hv * w1.z; lg[7] += hv * w1.w; }
#pragma unroll
                    for (int e = 0; e < 8; ++e) lg[e] = wave_sum(lg[e]);
                    if (F.lane == 0) {
                        int e0 = 0; float v0 = lg[0];
#pragma unroll
                        for (int e = 1; e < 8; ++e) if (lg[e] > v0) { v0 = lg[e]; e0 = e; }
                        int e1 = 0; float v1 = -INFINITY;
#pragma unroll
                        for (int e = 0; e < 8; ++e) if (e != e0 && lg[e] > v1) { v1 = lg[e]; e1 = e; }
                        const float p1 = __expf(v1 - v0), inv = 1.f / (1.f + p1);
                        A.slot_w_out[row * 2] = inv; A.slot_w_out[row * 2 + 1] = p1 * inv;
                        sE[(F.wave * 8 + j + u) * 2] = e0; sE[(F.wave * 8 + j + u) * 2 + 1] = e1;
                    }
                }
            }
        }
        if (ROUTER) {
            __syncthreads();
            if (F.tid < 8) { const int e = F.tid; int n = 0; for (int s = 0; s < 128; ++s) if (sE[s] == e) sR[s] = n++;
                sB[e] = n ? (int)__hip_atomic_fetch_add(A.cnt + e, (unsigned)n, __ATOMIC_RELAXED, __HIP_MEMORY_SCOPE_AGENT) : 0; }
            __syncthreads();
            if (F.tid < 128) { const int s = F.tid, tok = rb * 64 + (s >> 1), slot = tok * 2 + (s & 1), e = sE[s], pos = sB[e] + sR[s]; A.slot_e[slot] = e; A.slot_pos[slot] = pos; A.row_list[e * 16384 + pos] = tok; }
            __syncthreads();
        }
    }
}
__device__ __forceinline__ void moe_table(const Frame& F0, const unsigned* cnt) {
    Frame F = F0; asm volatile("" : "+v"(F.tid)); F.lane = F.tid & 63;
    LAS int* tab = (LAS int*)(F.lds + TAB_OFF);
    if (F.tid == 0) { int acc = 0;
        for (int e = 0; e < NE; ++e) { const int c = (int)__hip_atomic_load(cnt + e, __ATOMIC_RELAXED, __HIP_MEMORY_SCOPE_AGENT); tab[e] = acc; tab[160 + e] = c; const int pd = (c + 255) / 256 * 256; for (int ch = acc / 256; ch < (acc + pd) / 256 && ch < NCHUNK_MAX; ++ch) tab[16 + ch] = e; acc += pd; }
        tab[8] = acc / 256 < NCHUNK_MAX ? acc / 256 : NCHUNK_MAX; }
    __syncthreads();
}
__device__ __forceinline__ void gather_phase(const Frame& F0, const bf16* ha, bf16* xs, const int* slot_e, const int* slot_pos, int* dest_of) {
    Frame F = F0; asm volatile("" : "+v"(F.tid)); F.lane = F.tid & 63;
    const LAS int* tab = (const LAS int*)(F.lds + TAB_OFF);
    for (int s = F.vcu * NWAVES + F.wave; s < NTOK * 2; s += F.G * NWAVES) {
        const int tok = s >> 1, e = slot_e[s], dest = tab[e] + slot_pos[s];
        const GAS v4u* src = (const GAS v4u*)(ha + (size_t)tok * DM); GAS v4u* dst = (GAS v4u*)(xs + (size_t)dest * DM);
        const v4u a = src[F.lane], b = src[F.lane + 64]; dst[F.lane] = a; dst[F.lane + 64] = b;
        if (F.lane == 0) dest_of[s] = dest;
    }
}
__device__ __forceinline__ void vt_phase(const Frame& F0, const unsigned char* p8, unsigned char* vt) {
    Frame F = F0; asm volatile("" : "+v"(F.tid)); F.lane = F.tid & 63;
    constexpr int LP = 528;
    LAS unsigned char* tile = (LAS unsigned char*)(F.lds + RING_OFF);
    for (int rb = F.vcu; rb < NTOK / 64; rb += F.G) {
        const int tok0 = rb * 64, b = tok0 / SEQ, t0 = tok0 - b * SEQ;
        __syncthreads();
#pragma unroll
        for (int pss = 0; pss < 4; ++pss) { const int tk = pss * 16 + (F.tid >> 5), ch = F.tid & 31;
            const v4u v = *(const GAS v4u*)(p8 + (size_t)(tok0 + tk) * 1536 + 1024 + ch * 16); *(LAS v4u*)(tile + tk * LP + ch * 16) = v; }
        __syncthreads();
        const int col = F.tid, hh = col >> 7, d = col & 127;
        unsigned w[16];
#pragma unroll
        for (int j = 0; j < 16; ++j) { unsigned acc = 0u;
#pragma unroll
            for (int e = 0; e < 4; ++e) { const int pos = 4 * j + e, hi_ = pos >> 5, tl = (pos >> 4) & 1, r = pos & 15, key = 32 * tl + (r & 3) + 8 * (r >> 2) + 4 * hi_;
                acc |= (unsigned)tile[key * LP + col] << (8 * e); }
            w[j] = acc; }
        GAS v4u* dst = (GAS v4u*)(vt + ((size_t)((b * 4 + hh) * 128 + d)) * SEQ + t0);
#pragma unroll
        for (int q = 0; q < 4; ++q) { v4u o; o.x = w[4 * q]; o.y = w[4 * q + 1]; o.z = w[4 * q + 2]; o.w = w[4 * q + 3]; dst[q] = o; }
    }
    __syncthreads();
}
__device__ __forceinline__ void diff_combine(const Frame& F0, const bf16* od, bf16* att, int b, int h, int q0, float lam, float omli, const float* subg) {
    Frame F = F0; asm volatile("" : "+v"(F.tid)); F.lane = F.tid & 63;
    const float g0 = subg[2 * F.lane], g1 = subg[2 * F.lane + 1];
    for (int j = 0; j < 32; ++j) {
        const int tok = b * SEQ + q0 + F.wave * 32 + j;
        const unsigned w1 = __hip_atomic_load((const unsigned*)(od + (size_t)tok * 512 + h * 128) + F.lane, __ATOMIC_RELAXED, __HIP_MEMORY_SCOPE_AGENT);
        const unsigned w2 = __hip_atomic_load((const unsigned*)(od + ((size_t)NTOK + tok) * 512 + h * 128) + F.lane, __ATOMIC_RELAXED, __HIP_MEMORY_SCOPE_AGENT);
        const float v0 = __uint_as_float(w1 << 16) - lam * __uint_as_float(w2 << 16), v1 = __uint_as_float(w1 & 0xffff0000u) - lam * __uint_as_float(w2 & 0xffff0000u);
        const float r = 1.f / sqrtf(wave_sum(v0 * v0 + v1 * v1) * (1.f / 128.f) + EPS);
        *((GAS unsigned*)(att + (size_t)tok * DM + 512 + h * 128) + F.lane) = pk2(v0 * r * g0 * omli, v1 * r * g1 * omli);
    }
}

#ifndef CONV_NB
#define CONV_NB 64
#endif
#define REP(k) _Pragma("unroll 1") for (int rep_ = 0; rep_ < ((PROBE == (k)) ? 2 : 1); ++rep_)
constexpr int PH_PRO = 0, PH_FINAL = 1 + DEPTH * 10, PH_END = PH_FINAL + 1;
#define WSP(T, off) ((T*)(ws + (off)))
#define IN(k) (lo <= (k) && (k) < hi)
#define SEAM(k) do { if ((k) + 1 < hi) { xcd_barrier(bar); if (PROBE == 12) xcd_barrier(bar); } } while (0)
#define PH() Frame Fp = F; int bx = (int)blockIdx.x; asm volatile("" : "+s"(Fp.G), "+s"(Fp.vcu), "+s"(bx)); constexpr int l = l_, i2 = l_ >> 1; (void)l; (void)i2; (void)bx
template <int L> __device__ __forceinline__ void run_layer(const Frame& F, const XcdBarrier& bar, const int lo, const int hi, unsigned char* lds) {
    constexpr int l_ = L; constexpr int pb = 1 + L * 10; constexpr bool moe = (L & 1) != 0;
        if (IN(pb + 0)) { PH();
            CArgs ka = kargs(); unsigned char* ws = ka->p.ws; const float* ml = WSP(float, WS_MOD) + (size_t)l * 2 * MODB;
            if (l > 0) queue_convert(Fp, ka, l == 1 ? Q2 : (l == 2 ? Q6 : Q8), 1 << 20);
            NormArgs A; A.g = ka->p.in[5] + l * DM; A.sh = ml + 0 * DM; A.sc = ml + 1 * DM; A.ha = WSP(bf16, WS_HA); A.of32 = nullptr;
            A.rw = nullptr; A.slot_e = nullptr; A.slot_pos = nullptr; A.slot_w_out = nullptr; A.cnt = nullptr; A.row_list = nullptr;
            if (l > 0 && ((l - 1) & 1)) {
                unsigned char* pr = ws + WS_ROUTE + (size_t)((l - 1) >> 1) * ROUTE_LAYER;
                A.xin = nullptr; A.xout = nullptr; A.xinb = WSP(bf16, WS_XB); A.xoutb = WSP(bf16, WS_XB); A.ys = WSP(bf16, WS_YS); A.cslot_e = (const int*)pr; A.cslot_pos = (const int*)(pr + 128 * 1024); A.slot_w = (const float*)(pr + 256 * 1024); A.cgate = WSP(float, WS_MOD) + (size_t)(l - 1) * 2 * MODB + 5 * DM;
                moe_table(Fp, (const unsigned*)(F.ctl + CW_CNT + 64 * ((l - 1) >> 1)));
                norm_phase<true, true, false, false, true, false, pg8::F8_IN>(Fp, A);
            } else {
                A.xin = ka->p.in[0]; A.xout = nullptr; A.xinb = WSP(bf16, WS_XB); A.xoutb = nullptr; A.ys = nullptr; A.cslot_e = nullptr; A.cslot_pos = nullptr; A.slot_w = nullptr; A.cgate = nullptr;
                REP(7) norm_phase<false, true, false, false, (L > 0), false, pg8::F8_IN>(Fp, A);
            }
            SEAM(pb + 0);
        }
        if (IN(pb + 1)) { PH();
            CArgs ka = kargs(); unsigned char* ws = ka->p.ws;
            constexpr int nwg = (NTOK / 256) * (INC / 256); const int rounds = (nwg + Fp.G - 1) / Fp.G; int GW = (((nwg + rounds - 1) / rounds) + 7) & ~7; if ((Fp.G & 7) || GW > Fp.G) GW = Fp.G;
            if (bx < GW) {
                constexpr bool FI = pg8::F8_IN;
                pg8::Gemm g{WSP(bf16, WS_HA), (const bf16*)(ws + WS_WIN + (size_t)l * INC * DM * (FI ? 1 : 2)), NTOK, INC, DM}; pg8::StaticOrder S; S.init(NTOK, INC, GW, bx);
                pg8::EpiRope E{WSP(bf16, WS_PROJ), WSP(const float, WS_RC), WSP(const float, WS_RS), FI ? pg8::F8_INV1 : 1.f, pg8::F8_ATT ? ws + WS_PROJ8 : nullptr};
                REP(2) pg8::gemm_phase<pg8::EpiRope, pg8::StaticOrder, true, true, pg8::NoGather, FI>(F.lds + RING_OFF, g, S, E);
                if (GW == Fp.G && (rounds - 1) * Fp.G + bx >= nwg) queue_convert(Fp, kargs(), QEND, 2);
                __syncthreads(); if (threadIdx.x == 0) __hip_atomic_fetch_add(F.ctl + CW_IPDONE + l, 1u, __ATOMIC_RELAXED, __HIP_MEMORY_SCOPE_AGENT);
            } else queue_convert(Fp, kargs(), QEND, CONV_NB, F.ctl + CW_IPDONE + l, (unsigned)GW);
            SEAM(pb + 1);
        }
        if (IN(pb + 2)) { PH();
            if constexpr (pg8::F8_ATT) { CArgs ka = kargs(); unsigned char* ws = ka->p.ws; vt_phase(Fp, ws + WS_PROJ8, ws + WS_VT); if (hi - lo > 1) xcd_barrier(bar); }
            REP(3) for (int su = Fp.vcu; su < 256; su += Fp.G) {
                const int bh = su >> 5, b = bh >> 2, h = bh & 3, q0 = (su & 31) * 256;
#pragma unroll 1
                for (int u2 = 0; u2 < 2; ++u2) {
                    CArgs ka = kargs(); unsigned char* ws = ka->p.ws; const attn_body::bf16* pj = WSP(const attn_body::bf16, WS_PROJ) + (size_t)b * SEQ * INC;
                    const int ln = (int)(threadIdx.x & 63); const float li = ka->lam_init[l];
                    const float lam = __expf(wave_sum(ka->p.in[10][l * 64 + ln] * ka->p.in[11][l * 64 + ln])) - __expf(wave_sum(ka->p.in[12][l * 64 + ln] * ka->p.in[13][l * 64 + ln])) + li;
                    if constexpr (pg8::F8_ATT) attn_body::dattn_unit_f8<8>(ws + WS_PROJ8 + (size_t)b * SEQ * 1536, ws + WS_VT + (size_t)(b * 4 + h) * 128 * SEQ, h,
                        WSP(attn_body::bf16, WS_ATT) + (size_t)b * SEQ * DM + 512 + h * 128, q0 + u2 * 128, lam, 1.f - li, ka->p.in[14] + l * 128, (char*)lds + RING_OFF);
                    else attn_body::dattn_unit<8>(pj + COL_QD + h * 128, pj + COL_KD + h * 128, pj + COL_VD + h * 128,
                        WSP(attn_body::bf16, WS_ATT) + (size_t)b * SEQ * DM + 512 + h * 128, q0 + u2 * 128, lam, 1.f - li, ka->p.in[14] + l * 128, (char*)lds + RING_OFF);
                }
#pragma unroll 1
                for (int i_ = 0; i_ < ((PROBE == 13) ? 6 : 2); ++i_) { const int i = i_ & 1;
                    CArgs ka = kargs(); unsigned char* ws = ka->p.ws; const attn_body::bf16* pj = WSP(const attn_body::bf16, WS_PROJ) + (size_t)b * SEQ * INC;
                    const int hq = 2 * h + i, hkv = hq >> 2;
                    attn_body::attn_unit<8, true>(pj + COL_QA + hq * 64, pj + COL_KA + hkv * 64, pj + COL_VA + hkv * 64,
                        WSP(attn_body::bf16, WS_ATT) + (size_t)b * SEQ * DM + hq * 64, DM, q0, ka->p.in[9][l * 8 + hq] * 1.4426950408889634f, (char*)lds + RING_OFF);
                }
            }
            SEAM(pb + 2);
        }
        if (IN(pb + 3)) { PH();
            CArgs ka = kargs(); unsigned char* ws = ka->p.ws; const float* ml = WSP(float, WS_MOD) + (size_t)l * 2 * MODB;
            pg8::Gemm g{WSP(bf16, WS_ATT), WSP(const bf16, WS_WOUT) + (size_t)l * DM * DM, NTOK, DM, DM}; pg8::StaticOrder S; S.init(NTOK, DM, Fp.G, bx);
            using EpiO = pg8::EpiResGateB<(L == 0)>;
            EpiO E{(l == 0) ? (const void*)ka->p.in[0] : (const void*)WSP(bf16, WS_XB), WSP(pg8::bf16_t, WS_XB), ml + 2 * DM};
            pg8::gemm_phase<EpiO, pg8::StaticOrder, true, true>(F.lds + RING_OFF, g, S, E);
            SEAM(pb + 3);
        }
        if (IN(pb + 4)) { PH();
            CArgs ka = kargs(); unsigned char* ws = ka->p.ws; const float* ml = WSP(float, WS_MOD) + (size_t)l * 2 * MODB;
            unsigned char* route = ws + WS_ROUTE + (size_t)i2 * ROUTE_LAYER;
            NormArgs A; A.xin = nullptr; A.xout = nullptr; A.xinb = WSP(bf16, WS_XB); A.xoutb = nullptr; A.g = ka->p.in[6] + l * DM; A.sh = ml + 3 * DM; A.sc = ml + 4 * DM; A.ha = WSP(bf16, WS_HA); A.of32 = nullptr;
            A.ys = nullptr; A.cslot_e = nullptr; A.cslot_pos = nullptr; A.slot_w = nullptr; A.cgate = nullptr; A.row_list = nullptr;
            if (moe) { A.rw = ka->p.in[18] + (size_t)i2 * DM * NE; A.slot_e = (int*)route; A.slot_pos = (int*)(route + 128 * 1024); A.slot_w_out = (float*)(route + 256 * 1024); A.cnt = (unsigned*)(F.ctl + CW_CNT + 64 * i2); A.row_list = (int*)(route + 512 * 1024); norm_phase<false, true, true, false, true, false, pg8::F8_M1>(Fp, A);
                queue_convert(Fp, ka, l == 1 ? Q3A : Q8A, 1 << 20); }
            else { A.rw = nullptr; A.slot_e = nullptr; A.slot_pos = nullptr; A.slot_w_out = nullptr; A.cnt = nullptr; REP(11) norm_phase<false, true, false, false, true, false, pg8::F8_D1>(Fp, A); }
            SEAM(pb + 4);
        }
        if constexpr (!moe) {
            if (IN(pb + 5)) { PH();
                CArgs ka = kargs(); unsigned char* ws = ka->p.ws;
                constexpr bool F1 = pg8::F8_D1, F2 = pg8::F8_D2;
                pg8::Gemm g{WSP(bf16, WS_HA), (const bf16*)(ws + WS_WGU_D + (size_t)i2 * 2 * FF * DM * (F1 ? 1 : 2)), NTOK, 2 * FF, DM}; pg8::StaticOrder S; S.init(NTOK, 2 * FF, Fp.G, bx);
                if constexpr (F2) { pg8::EpiSwigluF8 E{ws + WS_HMID, FF, F1 ? pg8::F8_INV1 : 1.f, pg8::F8_SH}; REP(4) pg8::gemm_phase<pg8::EpiSwigluF8, pg8::StaticOrder, true, true, pg8::NoGather, F1>(F.lds + RING_OFF, g, S, E); }
                else { pg8::EpiSwiglu E{WSP(bf16, WS_HMID), FF, F1 ? pg8::F8_INV1 : 1.f}; REP(4) pg8::gemm_phase<pg8::EpiSwiglu, pg8::StaticOrder, true, true, pg8::NoGather, F1>(F.lds + RING_OFF, g, S, E); }
                SEAM(pb + 5);
            }
            if (IN(pb + 6)) { PH();
                CArgs ka = kargs(); unsigned char* ws = ka->p.ws; const float* ml = WSP(float, WS_MOD) + (size_t)l * 2 * MODB;
                constexpr bool F2 = pg8::F8_D2;
                pg8::Gemm g{WSP(bf16, WS_HMID), (const bf16*)(ws + WS_WD_D + (size_t)i2 * DM * FF * (F2 ? 1 : 2)), NTOK, DM, FF}; pg8::StaticOrder S; S.init(NTOK, DM, Fp.G, bx);
                using EpiF = pg8::EpiResGateB<false>;
                EpiF E{(const void*)WSP(bf16, WS_XB), WSP(pg8::bf16_t, WS_XB), ml + 5 * DM, F2 ? pg8::F8_INV2 : 1.f};
                pg8::gemm_phase<EpiF, pg8::StaticOrder, true, true, pg8::NoGather, F2>(F.lds + RING_OFF, g, S, E);
                SEAM(pb + 6);
            }
        } else {
            const int* tabp = (const int*)(lds + TAB_OFF);
            if (IN(pb + 6)) { PH();
                CArgs ka = kargs(); unsigned char* ws = ka->p.ws;
                moe_table(Fp, (const unsigned*)(F.ctl + CW_CNT + 64 * i2)); const int nch = tabp[8];
                constexpr bool F1 = pg8::F8_M1, F2 = pg8::F8_M2;
                pg8::Gemm g{WSP(bf16, WS_HA), (const bf16*)(ws + WS_WGU_M + (size_t)i2 * NE * 2 * FF * DM * (F1 ? 1 : 2)), nch * 256, 2 * FF, DM}; pg8::StaticOrder S; S.init(nch * 256, 2 * FF, Fp.G, bx, tabp + 16);
                { const int* rl = (const int*)(ws + WS_ROUTE + (size_t)i2 * ROUTE_LAYER + 512 * 1024); LAS int* idx = (LAS int*)(F.lds + IDX_OFF); const LAS int* tb = (const LAS int*)(F.lds + TAB_OFF);
                  pg8::Unit uu; int tl_ = (int)threadIdx.x; asm volatile("" : "+v"(tl_));
                  for (int i = 0; i < IDX_UNITS && S.next(i, uu); ++i) {
                      const int e = tb[16 + uu.pm], rbase = (uu.pm << 8) - tb[e], cnt_e = tb[160 + e];
                      if (tl_ < 256) { const int rr = rbase + tl_; idx[i * 256 + tl_] = rr < cnt_e ? rl[e * 16384 + rr] : 0; } }
                  __syncthreads(); }
                pg8::LdsGather GA{(const LAS int*)(F.lds + IDX_OFF)};
                if constexpr (F2) { pg8::EpiSwigluF8 E{ws + WS_HMID, FF, F1 ? pg8::F8_INV1 : 1.f, pg8::F8_SH}; REP(5) pg8::gemm_phase<pg8::EpiSwigluF8, pg8::StaticOrder, true, true, pg8::LdsGather, F1>(F.lds + RING_OFF, g, S, E, GA); }
                else { pg8::EpiSwiglu E{WSP(bf16, WS_HMID), FF, F1 ? pg8::F8_INV1 : 1.f}; REP(5) pg8::gemm_phase<pg8::EpiSwiglu, pg8::StaticOrder, true, true, pg8::LdsGather, F1>(F.lds + RING_OFF, g, S, E, GA); }
                queue_convert(Fp, kargs(), l == 1 ? Q3 : QEND, 1 << 20);
                SEAM(pb + 6);
            }
            if (IN(pb + 7)) { PH();
                CArgs ka = kargs(); unsigned char* ws = ka->p.ws;
                moe_table(Fp, (const unsigned*)(F.ctl + CW_CNT + 64 * i2)); const int nch = tabp[8];
                constexpr bool F2 = pg8::F8_M2; constexpr int KT = F2 ? 128 : 64;
                pg8::Gemm g{WSP(bf16, WS_HMID), (const bf16*)(ws + WS_WD_M + (size_t)i2 * NE * DM * FF * (F2 ? 1 : 2)), nch * 256, DM, FF};
                if constexpr (L == DEPTH - 1) {
                    pg8::TailOrder S; S.init(nch, DM, FF * 64 / KT, Fp.G, bx, Fp.vcu, tabp + 16);
                    pg8::EpiBf16T E{WSP(pg8::bf16_t, WS_YS), DM, WSP(pg8::bf16_t, WS_YSP), S.pm0, F2 ? pg8::F8_INV2 : 1.f};
                    pg8::gemm_phase<pg8::EpiBf16T, pg8::TailOrder, true, true, pg8::NoGather, F2>(F.lds + RING_OFF, g, S, E);
                } else {
                    pg8::StaticOrder S; S.init(nch * 256, DM, Fp.G, bx, tabp + 16);
                    pg8::EpiBf16 E{WSP(bf16, WS_YS), DM, F2 ? pg8::F8_INV2 : 1.f};
                    REP(6) pg8::gemm_phase<pg8::EpiBf16, pg8::StaticOrder, true, true, pg8::NoGather, F2>(F.lds + RING_OFF, g, S, E);
                    { const int nwg = nch * (DM / 256), rounds = (nwg + Fp.G - 1) / Fp.G; if ((rounds - 1) * Fp.G + bx >= nwg) queue_convert(Fp, kargs(), QEND, 7); }
                }
                SEAM(pb + 7);
            }
        }
}

__global__ void __launch_bounds__(NWAVES * 64, 2) mk_fwd(Args args_by_value_unused) {
    extern __shared__ __attribute__((aligned(16))) unsigned char lds[];
    Frame F;
    F.lds = (LAS unsigned char*)lds;
    F.MISC = (volatile LAS unsigned*)(F.lds + MISC_OFF);
    F.tid = threadIdx.x; F.lane = F.tid & 63; F.wave = __builtin_amdgcn_readfirstlane(F.tid >> 6);
    F.G = gridDim.x; { const int bx = blockIdx.x; F.vcu = (F.G % 8 == 0) ? (bx % 8) * (F.G / 8) + bx / 8 : bx; }
    int lo, hi_full; { CArgs ka = kargs(); lo = ka->ph_lo; hi_full = ka->ph_hi; F.ctl = (gu32*)(ka->p.ws + WS_CTL); }
    { const int hi = hi_full; (void)hi; }
    for (int u = F.tid; u < (LDS_BYTES - LDSCTL_OFF) / 4; u += NWAVES * 64) ((LAS unsigned*)(F.lds + LDSCTL_OFF))[u] = 0u;
    __syncthreads();
    XcdBarrier bar; bar.bar = (unsigned*)(F.ctl + CW_BAR); bar.x = 0; bar.st = nullptr;
    if (hi_full - lo > 1) bar = xcd_barrier_post((unsigned*)(F.ctl + CW_BAR), F.MISC + 8);
#if PROBE >= 100
    { constexpr int hi = PROBE - 100;
      if (IN(PH_PRO)) { p0_prologue(F, kargs()); SEAM(PH_PRO); }
      run_layer<0>(F, bar, lo, hi, lds); run_layer<1>(F, bar, lo, hi, lds); run_layer<2>(F, bar, lo, hi, lds); run_layer<3>(F, bar, lo, hi, lds);
      xcd_barrier(bar); if (blockIdx.x == 0 && F.tid < 128) F.ctl[CW_CNT + F.tid] = 0u; __syncthreads(); if (F.tid == 0) *(LAS int*)(F.lds + LDSCTL_OFF) = 0; __syncthreads(); }
#endif
    { const int hi = hi_full;
    if (IN(PH_PRO)) { REP(1) { p0_prologue(F, kargs()); if (PROBE == 1) { __syncthreads(); if (F.tid == 0) *(LAS int*)(F.lds + LDSCTL_OFF) = 0; __syncthreads(); } } SEAM(PH_PRO); }

    run_layer<0>(F, bar, lo, hi, lds); run_layer<1>(F, bar, lo, hi, lds); run_layer<2>(F, bar, lo, hi, lds); run_layer<3>(F, bar, lo, hi, lds);
    if (IN(PH_FINAL)) {
        constexpr int l_ = DEPTH; PH();
        CArgs ka = kargs(); unsigned char* ws = ka->p.ws;
        unsigned char* pr = ws + WS_ROUTE + (size_t)((DEPTH - 1) >> 1) * ROUTE_LAYER;
        NormArgs A; A.xin = nullptr; A.xout = nullptr; A.xinb = WSP(bf16, WS_XB); A.xoutb = nullptr; A.g = ka->p.in[22]; A.sh = nullptr; A.sc = nullptr; A.ha = nullptr; A.of32 = ka->p.out;
        A.ys = WSP(bf16, WS_YS); A.cslot_e = (const int*)pr; A.cslot_pos = (const int*)(pr + 128 * 1024); A.slot_w = (const float*)(pr + 256 * 1024); A.cgate = WSP(float, WS_MOD) + (size_t)(DEPTH - 1) * 2 * MODB + 5 * DM;
        moe_table(Fp, (const unsigned*)(F.ctl + CW_CNT + 64 * ((DEPTH - 1) >> 1)));
        A.rw = nullptr; A.slot_e = nullptr; A.slot_pos = nullptr; A.slot_w_out = nullptr; A.cnt = nullptr; A.row_list = nullptr;
        A.oscale = 1.f;
        { int MC, ts; pg8::tail_params(((const LAS int*)(F.lds + TAB_OFF))[8], DM / 256, FF / (pg8::F8_M2 ? 128 : 64), Fp.G, MC, ts); A.ysp = WSP(bf16, WS_YSP); A.tail0 = MC * 256; A.tails = ts; }
        norm_phase<true, false, false, true, true, true>(Fp, A);
    }
    }
#undef IN
#undef SEAM
}

#ifndef MK_PER_PHASE
#define MK_PER_PHASE 0
#endif
extern "C" void kernel_launch(void* const* d_in, const int* in_sizes, int n_in, void* d_out, int out_size, void* d_ws, size_t ws_size, hipStream_t stream) {
    static int grid = 0;
    if (grid == 0) {
        if (n_in != 23 || out_size != NTOK * DM || ws_size < WS_END) { fprintf(stderr, "kernel_launch: unexpected problem (n_in %d out %d ws %zu)\n", n_in, out_size, ws_size); grid = -1; return; }
        int dev = 0, cus = 0, per_cu = 0;
        if (hipGetDevice(&dev) != hipSuccess || hipDeviceGetAttribute(&cus, hipDeviceAttributeMultiprocessorCount, dev) != hipSuccess) { grid = -1; return; }
        if (hipFuncSetAttribute((const void*)mk_fwd, hipFuncAttributeMaxDynamicSharedMemorySize, LDS_BYTES) != hipSuccess) { grid = -1; return; }
        if (hipOccupancyMaxActiveBlocksPerMultiprocessor(&per_cu, (const void*)mk_fwd, NWAVES * 64, LDS_BYTES) != hipSuccess || per_cu < 1) { fprintf(stderr, "kernel_launch: occupancy query reports %d\n", per_cu); }
        (void)hipGetLastError();
        grid = cus;
    }
    if (grid < 0) return;
    if (hipMemsetAsync((char*)d_ws + WS_CTL, 0, CTL_ZERO_BYTES, stream) != hipSuccess) return;
    Args a; memset(&a, 0, sizeof(a));
    for (int i = 0; i < 23; ++i) a.p.in[i] = (const float*)d_in[i];
    a.p.out = (float*)d_out; a.p.ws = (unsigned char*)d_ws;
    for (int i = 0; i < 32; ++i) a.rf.inv[i] = (float)(1.0 / pow(10000.0, (double)((float)(2 * i) / 64.0f)));
    for (int l = 0; l < DEPTH; ++l) a.lam_init[l] = (float)(0.8 - 0.6 * exp(-0.3 * (double)l));
#if MK_PER_PHASE
    for (int ph = 0; ph < PH_END; ++ph) { a.ph_lo = ph; a.ph_hi = ph + 1; hipLaunchKernelGGL(mk_fwd, dim3(grid), dim3(NWAVES * 64), LDS_BYTES, stream, a); }
#else
    a.ph_lo = 0; a.ph_hi = PH_END;
    hipLaunchKernelGGL(mk_fwd, dim3(grid), dim3(NWAVES * 64), LDS_BYTES, stream, a);
#endif
}
```

```cpp
#include <hip/hip_runtime.h>
#ifndef PROBE
#define PROBE 0
#endif
#ifndef RESC_NOPS
#define RESC_NOPS 10
#endif
#ifndef LEAD_WAVES
#define LEAD_WAVES 4
#endif
#include <hip/hip_bf16.h>
#include <cstdio>
#include <cstdint>
#include <cmath>
#include <cstring>

constexpr int BATCH = 2, SEQ = 8192, DM = 1024, NTOK = BATCH * SEQ, DEPTH = 4;
constexpr int INC = 2304, FF = 3584, NE = 8, NMOD = 6;
constexpr int COL_QA = 0, COL_KA = 512, COL_VA = 640, COL_QD = 768, COL_KD = 1280, COL_VD = 1792;
constexpr int PMAX = NTOK * 2 + NE * 256;
constexpr int NCHUNK_MAX = PMAX / 256;
constexpr float EPS = 1e-6f;
constexpr float QK_C2 = 0.125f * 1.4426950408889634f;
constexpr int MODB = NMOD * DM;

namespace pg8 {
#define PG8_LAS __attribute__((address_space(3)))
typedef unsigned short bf16_t;
typedef short bf16x8 __attribute__((ext_vector_type(8)));
typedef float f32x4 __attribute__((ext_vector_type(4)));
typedef unsigned u32x4 __attribute__((ext_vector_type(4)));
constexpr int BM = 256, BK = 64, HALF = 128, HTB = HALF * BK * 2  , STAGE_BYTES = 8 * HTB, NXCD = 8, WGM = 8;

__host__ __device__ __forceinline__ int lds_byte(int r, int c) { const int st = (r >> 4) * 2 + (c >> 5), rr = r & 15, cc = c & 31, ob = rr * 64 + cc * 2; return st * 1024 + (ob ^ (((ob >> 9) & 1) << 5)); }
__host__ __device__ __forceinline__ void stage_rc(int b, int& R, int& C) { const int st = b / 1024, sb = b % 1024, swz = sb ^ (((sb >> 9) & 1) << 5); R = (st >> 1) * 16 + swz / 64; C = (st & 1) * 32 + (swz % 64) / 2; }
__host__ __device__ __forceinline__ int perm32(int rho) { const int n = rho >> 4, i = rho & 15; return 8 * (i >> 2) + 4 * n + (i & 3); }

struct Unit { int pm, pn, pnb; int koff, nt, ks; };
struct Gemm { const bf16_t* A; const bf16_t* Bt; int M, N, K; };

struct StaticOrder {
    static constexpr bool VARK = false;
    int nM, nN, nwg, G, c; const int* chunk_e;
    __device__ __forceinline__ void init(int M, int N, int G_, int c_, const int* ce = nullptr) { nM = M / BM; nN = N / BM; nwg = nM * nN; G = G_; c = c_; chunk_e = ce; }
    __device__ __forceinline__ bool next(int i, Unit& u) const {
        const long L = (long)i * G + c; if (L >= nwg) return false;
        int wgid = (int)L; { const int q = nwg / NXCD, r = nwg % NXCD, xcd = wgid % NXCD, off = wgid / NXCD; wgid = (xcd < r ? xcd * (q + 1) : r * (q + 1) + (xcd - r) * q) + off; }
        const int nig = WGM * nN, gid = wgid / nig, fm = gid * WGM, gsz = (nM - fm) < WGM ? (nM - fm) : WGM;
        u.pm = fm + ((wgid % nig) % gsz); u.pn = (wgid % nig) / gsz; u.pnb = chunk_e ? chunk_e[u.pm] * nN + u.pn : u.pn; return true;
    }
    __device__ __forceinline__ void a_ready(const Unit&) const {}
    __device__ __forceinline__ void done(const Unit&) const {}
};
__host__ __device__ __forceinline__ void tail_params(int nch, int nN, int nt_all, int G, int& MC, int& s) {
    MC = ((nch * nN) / G) * G / nN; const int T = nch - MC;
    s = (T * nN * 7 <= G && nt_all % 14 == 0) ? 7 : (T * nN * 4 <= G && nt_all % 8 == 0) ? 4 : (T * nN * 2 <= G && nt_all % 4 == 0) ? 2 : 1;
}
struct TailOrder {
    static constexpr bool VARK = true;
    StaticOrder main; int G, vcu, nmine, npieces, s, kt, pm0, nN; const int* chunk_e;
    __device__ __forceinline__ void init(int nch, int N, int K, int G_, int c_, int vcu_, const int* ce) {
        nN = N / BM; G = G_; vcu = vcu_; chunk_e = ce; int MC; tail_params(nch, nN, K / BK, G, MC, s);
        main.init(MC * BM, N, G, c_, ce); const int nmain = MC * nN; nmine = c_ < nmain ? (nmain - c_ + G - 1) / G : 0;
        pm0 = MC; kt = (K / BK) / s; npieces = (nch - MC) * nN * s;
    }
    __device__ __forceinline__ bool next(int i, Unit& u) const {
        if (i < nmine) { main.next(i, u); u.koff = 0; u.nt = kt * s; u.ks = 0; return true; }
        const int q = (i - nmine) * G + vcu; if (q >= npieces) return false;
        const int pn = q % nN, r = q / nN, ks = r % s, ch = r / s;
        u.pm = pm0 + ch; u.pn = pn; u.pnb = chunk_e[u.pm] * nN + pn; u.koff = ks * kt * BK * 2; u.nt = kt; u.ks = ks; return true;
    }
    __device__ __forceinline__ void a_ready(const Unit&) const {}
    __device__ __forceinline__ void done(const Unit&) const {}
};
constexpr int TAILROWS = 8 * 256;

#ifndef F8CFG
#define F8CFG 62
#endif
constexpr bool F8_D1 = (F8CFG & 1) != 0, F8_D2 = (F8CFG & 2) != 0, F8_M1 = (F8CFG & 4) != 0, F8_M2 = (F8CFG & 8) != 0, F8_IN = (F8CFG & 16) != 0, F8_ATT = (F8CFG & 32) != 0;
constexpr float F8_SA = 8.f, F8_SW1 = 128.f, F8_SH = 4.f, F8_SW2 = 256.f;
constexpr float F8_INV1 = 1.f / (F8_SA * F8_SW1), F8_INV2 = 1.f / (F8_SH * F8_SW2);
__device__ __forceinline__ unsigned pack4_fp8(float a, float b, float c, float d) {
    a = __builtin_amdgcn_fmed3f(a, -448.f, 448.f); b = __builtin_amdgcn_fmed3f(b, -448.f, 448.f); c = __builtin_amdgcn_fmed3f(c, -448.f, 448.f); d = __builtin_amdgcn_fmed3f(d, -448.f, 448.f);
    unsigned r = 0u; r = (unsigned)__builtin_amdgcn_cvt_pk_fp8_f32(a, b, (int)r, false); r = (unsigned)__builtin_amdgcn_cvt_pk_fp8_f32(c, d, (int)r, true); return r; }
__device__ __forceinline__ unsigned cvt_pk_bf16(float lo, float hi) { unsigned r; asm volatile("v_cvt_pk_bf16_f32 %0, %1, %2" : "=v"(r) : "v"(lo), "v"(hi)); return r; }

struct EpiBf16 {
    static constexpr bool PERM = true, AFTER_DRAIN = false;
    bf16_t* O; int ldc; float ascale = 1.f;
    __device__ __forceinline__ void operator()(const f32x4 (&acc)[2][2][4][2], const Unit& u, int wr, int wc, int fr, int fq) const {
        const int row0 = u.pm * BM + wr * 64 + fr, col0 = u.pn * BM + wc * 32 + 8 * fq;
#pragma unroll
        for (int ai = 0; ai < 2; ++ai)
#pragma unroll
            for (int m = 0; m < 4; ++m) { bf16_t* rowp = O + (size_t)(row0 + ai * HALF + m * 16) * ldc + col0;
#pragma unroll
                for (int bj = 0; bj < 2; ++bj) { const f32x4 v0 = acc[ai][bj][m][0] * ascale, v1 = acc[ai][bj][m][1] * ascale;
                    u32x4 w; w.x = cvt_pk_bf16(v0[0], v0[1]); w.y = cvt_pk_bf16(v0[2], v0[3]); w.z = cvt_pk_bf16(v1[0], v1[1]); w.w = cvt_pk_bf16(v1[2], v1[3]);
                    *(u32x4*)(rowp + bj * HALF) = w; } }
    }
};
struct EpiBf16T {
    static constexpr bool PERM = true, AFTER_DRAIN = false;
    bf16_t* O; int ldc; bf16_t* P; int pm0; float ascale = 1.f;
    __device__ __forceinline__ void operator()(const f32x4 (&acc)[2][2][4][2], const Unit& u, int wr, int wc, int fr, int fq) const {
        bf16_t* base = O; int rowb = u.pm * BM;
        if (u.ks != 0) { base = P + (size_t)(u.ks - 1) * TAILROWS * ldc; rowb = (u.pm - pm0) * BM; }
        const int row0 = rowb + wr * 64 + fr, col0 = u.pn * BM + wc * 32 + 8 * fq;
#pragma unroll
        for (int ai = 0; ai < 2; ++ai)
#pragma unroll
            for (int m = 0; m < 4; ++m) { bf16_t* rowp = base + (size_t)(row0 + ai * HALF + m * 16) * ldc + col0;
#pragma unroll
                for (int bj = 0; bj < 2; ++bj) { const f32x4 v0 = acc[ai][bj][m][0] * ascale, v1 = acc[ai][bj][m][1] * ascale;
                    u32x4 w; w.x = cvt_pk_bf16(v0[0], v0[1]); w.y = cvt_pk_bf16(v0[2], v0[3]); w.z = cvt_pk_bf16(v1[0], v1[1]); w.w = cvt_pk_bf16(v1[2], v1[3]);
                    *(u32x4*)(rowp + bj * HALF) = w; } }
    }
};
struct EpiRope {
    static constexpr bool PERM = true, AFTER_DRAIN = false;
    bf16_t* O; const float* rc; const float* rs; float ascale = 1.f; unsigned char* O8 = nullptr;
    __device__ __forceinline__ void operator()(const f32x4 (&acc)[2][2][4][2], const Unit& u, int wr, int wc, int fr, int fq) const {
        const int row0 = u.pm * BM + wr * 64 + fr;
#pragma unroll
        for (int bj = 0; bj < 2; ++bj) {
            const int cbase = u.pn * BM + bj * HALF;
            const bool rope = (cbase < COL_VA) || (cbase >= COL_QD && cbase < COL_VD);
            const bool f8o = O8 != nullptr && cbase >= COL_QD;
            const float sc = (((cbase < COL_KA) || (cbase >= COL_QD && cbase < COL_KD)) ? QK_C2 : 1.0f) * ascale * (f8o ? (cbase < COL_KD ? 8.f : (cbase < COL_VD ? 0.125f : 1.f)) : 1.f);
            const int col0 = cbase + wc * 32 + 8 * fq, i0 = (col0 & 63) >> 1;
#pragma unroll
            for (int ai = 0; ai < 2; ++ai)
#pragma unroll
                for (int m = 0; m < 4; ++m) {
                    const int row = row0 + ai * HALF + m * 16;
                    f32x4 v0 = acc[ai][bj][m][0], v1 = acc[ai][bj][m][1];
                    if (rope) {
                        const f32x4 c4 = *(const f32x4*)(rc + (size_t)row * 32 + i0), s4 = *(const f32x4*)(rs + (size_t)row * 32 + i0);
                        const f32x4 a0 = v0, a1 = v1;
                        v0[0] = a0[0] * c4[0] - a0[1] * s4[0]; v0[1] = a0[1] * c4[0] + a0[0] * s4[0];
                        v0[2] = a0[2] * c4[1] - a0[3] * s4[1]; v0[3] = a0[3] * c4[1] + a0[2] * s4[1];
                        v1[0] = a1[0] * c4[2] - a1[1] * s4[2]; v1[1] = a1[1] * c4[2] + a1[0] * s4[2];
                        v1[2] = a1[2] * c4[3] - a1[3] * s4[3]; v1[3] = a1[3] * c4[3] + a1[2] * s4[3];
                    }
                    v0 = v0 * sc; v1 = v1 * sc;
                    if (f8o) { *(unsigned long long*)(O8 + (size_t)row * (INC - COL_QD) + (col0 - COL_QD)) = (unsigned long long)pack4_fp8(v0[0], v0[1], v0[2], v0[3]) | ((unsigned long long)pack4_fp8(v1[0], v1[1], v1[2], v1[3]) << 32); }
                    else { u32x4 w; w.x = cvt_pk_bf16(v0[0], v0[1]); w.y = cvt_pk_bf16(v0[2], v0[3]); w.z = cvt_pk_bf16(v1[0], v1[1]); w.w = cvt_pk_bf16(v1[2], v1[3]);
                        *(u32x4*)(O + (size_t)row * INC + col0) = w; }
                }
        }
    }
};
struct EpiSwiglu {
    static constexpr bool PERM = true, AFTER_DRAIN = false;
    bf16_t* O; int ldc; float ain = 1.f;
    __device__ __forceinline__ static float silu_mul(float g, float u) { return g * u * __builtin_amdgcn_rcpf(1.0f + __builtin_amdgcn_exp2f(-1.4426950408889634f * g)); }
    __device__ __forceinline__ void operator()(const f32x4 (&acc)[2][2][4][2], const Unit& u, int wr, int wc, int fr, int fq) const {
        const int row0 = u.pm * BM + wr * 64 + fr, col0 = u.pn * HALF + wc * 32 + 8 * fq;
#pragma unroll
        for (int ai = 0; ai < 2; ++ai)
#pragma unroll
            for (int m = 0; m < 4; ++m) {
                const f32x4 g0 = acc[ai][0][m][0] * ain, g1 = acc[ai][0][m][1] * ain, u0 = acc[ai][1][m][0] * ain, u1 = acc[ai][1][m][1] * ain;
                u32x4 w; w.x = cvt_pk_bf16(silu_mul(g0[0], u0[0]), silu_mul(g0[1], u0[1])); w.y = cvt_pk_bf16(silu_mul(g0[2], u0[2]), silu_mul(g0[3], u0[3]));
                w.z = cvt_pk_bf16(silu_mul(g1[0], u1[0]), silu_mul(g1[1], u1[1])); w.w = cvt_pk_bf16(silu_mul(g1[2], u1[2]), silu_mul(g1[3], u1[3]));
                *(u32x4*)(O + (size_t)(row0 + ai * HALF + m * 16) * ldc + col0) = w;
            }
    }
};
struct EpiSwigluF8 {
    static constexpr bool PERM = true, AFTER_DRAIN = false;
    unsigned char* O; int ldc; float ain, oscale;
    __device__ __forceinline__ void operator()(const f32x4 (&acc)[2][2][4][2], const Unit& u, int wr, int wc, int fr, int fq) const {
        const int row0 = u.pm * BM + wr * 64 + fr, col0 = u.pn * HALF + wc * 32 + 8 * fq;
#pragma unroll
        for (int ai = 0; ai < 2; ++ai)
#pragma unroll
            for (int m = 0; m < 4; ++m) {
                const f32x4 g0 = acc[ai][0][m][0] * ain, g1 = acc[ai][0][m][1] * ain, u0 = acc[ai][1][m][0] * (ain * oscale), u1 = acc[ai][1][m][1] * (ain * oscale);
                unsigned long long w = (unsigned long long)pack4_fp8(EpiSwiglu::silu_mul(g0[0], u0[0]), EpiSwiglu::silu_mul(g0[1], u0[1]), EpiSwiglu::silu_mul(g0[2], u0[2]), EpiSwiglu::silu_mul(g0[3], u0[3]))
                    | ((unsigned long long)pack4_fp8(EpiSwiglu::silu_mul(g1[0], u1[0]), EpiSwiglu::silu_mul(g1[1], u1[1]), EpiSwiglu::silu_mul(g1[2], u1[2]), EpiSwiglu::silu_mul(g1[3], u1[3])) << 32);
                *(unsigned long long*)(O + (size_t)(row0 + ai * HALF + m * 16) * ldc + col0) = w;
            }
    }
};
struct EpiResGate {
    static constexpr bool PERM = false, AFTER_DRAIN = false;
    const float* base; float* out; const float* gate;
    __device__ __forceinline__ void operator()(const f32x4 (&acc)[2][2][4][2], const Unit& u, int wr, int wc, int fr, int fq) const {
        const int row0 = u.pm * BM + wr * 64 + fr, col0 = u.pn * BM + wc * 32 + 4 * fq;
        const float* gp = gate + (size_t)((u.pm * BM) / SEQ) * MODB + col0;
        f32x4 gv[2][2];
#pragma unroll
        for (int bj = 0; bj < 2; ++bj)
#pragma unroll
            for (int n = 0; n < 2; ++n) gv[bj][n] = *(const f32x4*)(gp + bj * HALF + n * 16);
#pragma unroll
        for (int ai = 0; ai < 2; ++ai)
#pragma unroll
            for (int m = 0; m < 4; ++m) { const size_t off = (size_t)(row0 + ai * HALF + m * 16) * DM + col0;
#pragma unroll
                for (int bj = 0; bj < 2; ++bj)
#pragma unroll
                    for (int n = 0; n < 2; ++n) { const f32x4 bs = *(const f32x4*)(base + off + bj * HALF + n * 16); *(f32x4*)(out + off + bj * HALF + n * 16) = bs + gv[bj][n] * acc[ai][bj][m][n]; } }
    }
};

template <bool BASE_F32>
struct EpiResGateB {
    static constexpr bool PERM = true, AFTER_DRAIN = false;
    const void* base; bf16_t* out; const float* gate; float ascale = 1.f;
    __device__ __forceinline__ void operator()(const f32x4 (&acc)[2][2][4][2], const Unit& u, int wr, int wc, int fr, int fq) const {
        const int row0 = u.pm * BM + wr * 64 + fr, col0 = u.pn * BM + wc * 32 + 8 * fq;
        const float* gp = gate + (size_t)((u.pm * BM) / SEQ) * MODB + col0;
        f32x4 gv[2][2];
#pragma unroll
        for (int bj = 0; bj < 2; ++bj)
#pragma unroll
            for (int n = 0; n < 2; ++n) gv[bj][n] = *(const f32x4*)(gp + bj * HALF + n * 4) * ascale;
#pragma unroll
        for (int ai = 0; ai < 2; ++ai)
#pragma unroll
            for (int m = 0; m < 4; ++m) { const size_t off = (size_t)(row0 + ai * HALF + m * 16) * DM + col0;
#pragma unroll
                for (int bj = 0; bj < 2; ++bj) { f32x4 b0, b1;
                    if (BASE_F32) { b0 = *(const f32x4*)((const float*)base + off + bj * HALF); b1 = *(const f32x4*)((const float*)base + off + bj * HALF + 4); }
                    else { const u32x4 w = *(const u32x4*)((const bf16_t*)base + off + bj * HALF);
                        b0 = (f32x4){__uint_as_float(w.x << 16), __uint_as_float(w.x & 0xffff0000u), __uint_as_float(w.y << 16), __uint_as_float(w.y & 0xffff0000u)};
                        b1 = (f32x4){__uint_as_float(w.z << 16), __uint_as_float(w.z & 0xffff0000u), __uint_as_float(w.w << 16), __uint_as_float(w.w & 0xffff0000u)}; }
                    const f32x4 v0 = b0 + gv[bj][0] * acc[ai][bj][m][0], v1 = b1 + gv[bj][1] * acc[ai][bj][m][1];
                    u32x4 o; o.x = cvt_pk_bf16(v0[0], v0[1]); o.y = cvt_pk_bf16(v0[2], v0[3]); o.z = cvt_pk_bf16(v1[0], v1[1]); o.w = cvt_pk_bf16(v1[2], v1[3]);
                    *(u32x4*)(out + off + bj * HALF) = o; } }
    }
};

struct NoGather { static constexpr bool ON = false; __device__ __forceinline__ int tok(int, int) const { return 0; } };
struct LdsGather { static constexpr bool ON = true; const PG8_LAS int* idx; __device__ __forceinline__ int tok(int ui, int r) const { return idx[ui * 256 + r]; } };
typedef int v4i_t __attribute__((ext_vector_type(4)));
typedef int v8i_t __attribute__((ext_vector_type(8)));
template <class Epi, class Sched, bool ALIGN_EPI = false, bool SP2 = false, class Gath = NoGather, bool F8 = false>
__device__ __forceinline__ void gemm_phase(PG8_LAS unsigned char* lds, const Gemm g, const Sched& S, const Epi& E, const Gath GA = Gath()) {
    static_assert(!Gath::ON || SP2, "the row gather is written for the SP2 loop");
    int tid_ = threadIdx.x; asm volatile("" : "+v"(tid_));
    const int tid = tid_, wid = __builtin_amdgcn_readfirstlane(tid >> 6), lane = tid & 63, wr = wid >> 2, wc = wid & 3, fr = lane & 15, fq = lane >> 4;
    const int K = g.K, RB = F8 ? K : 2 * K  , nt = RB / (2 * BK);
    unsigned voffA[2], voffB[2];
#pragma unroll
    for (int i = 0; i < 2; ++i) { int R, C; stage_rc(tid * 16 + i * 8192, R, C); const int Rb = Epi::PERM ? ((R & ~31) + perm32(R & 31)) : R;
        voffA[i] = (unsigned)(R * RB + C * 2); voffB[i] = (unsigned)(Rb * RB + C * 2); }
    unsigned voffG[2][2], voffN[2][2];
#define PG8_GOFF(dst, uidx) do { _Pragma("unroll") for (int i_ = 0; i_ < 2; ++i_) { int R_, C_; stage_rc(tid * 16 + i_ * 8192, R_, C_); _Pragma("unroll") for (int h_ = 0; h_ < 2; ++h_) dst[h_][i_] = (unsigned)(GA.tok(uidx, h_ * HALF + R_) * RB + C_ * 2); } } while (0)
#define PG8_STAGE_A(bufoff, gbase, h, NX) do { if constexpr (Gath::ON) { PG8_STAGE(bufoff, gbase, ((NX) ? voffN : voffG)[h]); } else { PG8_STAGE(bufoff, (gbase) + (h) * hstep, voffA); } } while (0)
    const size_t kstep = (size_t)(BK * 2);
    const size_t hstep = (size_t)HALF * RB;
    const size_t tstep = 2 * hstep;
    const unsigned ldsw = (unsigned)wid * 1024u;
    const int aoff = lds_byte(wr * 64 + fr, fq * 8), boff = lds_byte(wc * 32 + fr, fq * 8);
#define PG8_SA(b, h) (((b) * 2 + (h)) * HTB)
#define PG8_SB(b, h) ((4 + (b) * 2 + (h)) * HTB)
#define PG8_STAGE(bufoff, gbase, voff) do { _Pragma("unroll") for (int _i = 0; _i < 2; ++_i) \
        __builtin_amdgcn_global_load_lds((const unsigned*)((const char*)(gbase) + (voff)[_i]), (PG8_LAS unsigned*)(lds + (bufoff) + ldsw + _i * 8192), 16, 0, 0); } while (0)
#define PG8_LDA(dst, b, h) do { _Pragma("unroll") for (int m = 0; m < 4; ++m) _Pragma("unroll") for (int k = 0; k < 2; ++k) dst[m][k] = *(const PG8_LAS bf16x8*)(lds + PG8_SA(b, h) + aoff + m * 2048 + k * 1024); } while (0)
#define PG8_LDB(dst, b, h) do { _Pragma("unroll") for (int n = 0; n < 2; ++n) _Pragma("unroll") for (int k = 0; k < 2; ++k) dst[n][k] = *(const PG8_LAS bf16x8*)(lds + PG8_SB(b, h) + boff + n * 2048 + k * 1024); } while (0)
#define PG8_CAT8(x) __builtin_shufflevector(__builtin_bit_cast(v4i_t, (x)[0]), __builtin_bit_cast(v4i_t, (x)[1]), 0, 1, 2, 3, 4, 5, 6, 7)
#define PG8_MMA(ai, bj, At, Bt) do { __builtin_amdgcn_s_setprio(1); if constexpr (F8) { _Pragma("unroll") for (int m = 0; m < 4; ++m) _Pragma("unroll") for (int n = 0; n < 2; ++n) \
        asm("v_mfma_f32_16x16x128_f8f6f4 %0, %1, %2, %0" : "+v"(acc[ai][bj][m][n]) : "v"(PG8_CAT8(Bt[n])), "v"(PG8_CAT8(At[m]))); } else { \
        _Pragma("unroll") for (int m = 0; m < 4; ++m) _Pragma("unroll") for (int n = 0; n < 2; ++n) _Pragma("unroll") for (int k = 0; k < 2; ++k) \
        acc[ai][bj][m][n] = __builtin_amdgcn_mfma_f32_16x16x32_bf16(Bt[n][k], At[m][k], acc[ai][bj][m][n], 0, 0, 0); } __builtin_amdgcn_s_setprio(0); } while (0)
#define PG8_WAIT_V(n) asm volatile("s_waitcnt vmcnt(" #n ")" ::: "memory")
#define PG8_WAIT_L(n) asm volatile("s_waitcnt lgkmcnt(" #n ")" ::: "memory")
#define PG8_BAR __builtin_amdgcn_s_barrier()
#define PG8_SCHED __builtin_amdgcn_sched_barrier(0)
    Unit cur, nxt; int ui = 0;
    if (!S.next(0, cur)) return;
    float zf_ = 0.f; asm volatile("" : "+v"(zf_));
    f32x4 acc[2][2][4][2];
#pragma unroll
    for (int a = 0; a < 2; ++a)
#pragma unroll
        for (int b = 0; b < 2; ++b)
#pragma unroll
            for (int m = 0; m < 4; ++m)
#pragma unroll
                for (int n = 0; n < 2; ++n) acc[a][b][m][n] = (f32x4){zf_, zf_, zf_, zf_};
    bf16x8 At[4][2], B0[2][2], B1[2][2];
    const char* cA = (const char*)g.A + (Gath::ON ? (size_t)0 : (size_t)cur.pm * tstep) + (Sched::VARK ? cur.koff : 0); const char* cB = (const char*)g.Bt + (size_t)cur.pnb * tstep + (Sched::VARK ? cur.koff : 0);
    if constexpr (Gath::ON) { PG8_GOFF(voffG, 0); }
    S.a_ready(cur);
    if constexpr (SP2) {
        PG8_STAGE(PG8_SB(0, 0), cB, voffB); PG8_STAGE(PG8_SB(0, 1), cB + hstep, voffB); PG8_STAGE_A(PG8_SA(0, 0), cA, 0, false); PG8_STAGE_A(PG8_SA(0, 1), cA, 1, false);
        if (wr == 1) PG8_BAR;
        PG8_WAIT_V(2); PG8_BAR;
        PG8_STAGE(PG8_SB(1, 0), cB + kstep, voffB); PG8_STAGE_A(PG8_SA(1, 0), cA + kstep, 0, false); PG8_STAGE(PG8_SB(1, 1), cB + hstep + kstep, voffB);
        PG8_WAIT_V(6); PG8_BAR;
    } else {
        PG8_STAGE(PG8_SB(0, 0), cB, voffB); PG8_STAGE(PG8_SA(0, 0), cA, voffA); PG8_STAGE(PG8_SB(0, 1), cB + hstep, voffB); PG8_STAGE(PG8_SA(0, 1), cA + hstep, voffA);
        if (wr == 1) PG8_BAR;
        PG8_WAIT_V(4); PG8_BAR;
        PG8_STAGE(PG8_SB(1, 0), cB + kstep, voffB); PG8_STAGE(PG8_SA(1, 0), cA + kstep, voffA); PG8_STAGE(PG8_SB(1, 1), cB + hstep + kstep, voffB);
        PG8_WAIT_V(6); PG8_BAR;
    }
    for (;;) {
        const bool has_next = S.next(ui + 1, nxt);
        const char* nA = (has_next && !Gath::ON) ? (const char*)g.A + (size_t)nxt.pm * tstep + (Sched::VARK ? nxt.koff : 0) : cA; const char* nB = has_next ? (const char*)g.Bt + (size_t)nxt.pnb * tstep + (Sched::VARK ? nxt.koff : 0) : cB;
        const int ntu = Sched::VARK ? cur.nt : nt;
        for (int t = 0; t < ntu; t += 2) {
            const bool last = (t == ntu - 2);
            const char* a1 = cA + (size_t)(t + 1) * kstep;
            const char* a2 = last ? nA : cA + (size_t)(t + 2) * kstep; const char* b2 = last ? nB : cB + (size_t)(t + 2) * kstep;
            const char* a3 = a2 + kstep; const char* b3 = b2 + kstep;
            if (last && has_next) S.a_ready(nxt);
            if constexpr (Gath::ON) { if (last) { PG8_GOFF(voffN, has_next ? ui + 1 : ui); } }
            if constexpr (SP2) {
            PG8_LDB(B0, 0, 0); PG8_LDB(B1, 0, 1); PG8_SCHED; PG8_LDA(At, 0, 0); PG8_STAGE_A(PG8_SA(1, 1), a1, 1, false);
            PG8_WAIT_V(8); PG8_WAIT_L(0); PG8_BAR; PG8_MMA(0, 0, At, B0); PG8_MMA(0, 1, At, B1); PG8_BAR; PG8_SCHED;
            PG8_LDA(At, 0, 1); PG8_STAGE(PG8_SB(0, 0), b2, voffB); PG8_STAGE(PG8_SB(0, 1), b2 + hstep, voffB); PG8_STAGE_A(PG8_SA(0, 0), a2, 0, last);
            PG8_WAIT_V(8); PG8_WAIT_L(0); PG8_BAR; PG8_MMA(1, 0, At, B0); PG8_MMA(1, 1, At, B1); PG8_BAR; PG8_SCHED;
            PG8_LDB(B0, 1, 0); PG8_LDB(B1, 1, 1); PG8_SCHED; PG8_LDA(At, 1, 0); PG8_STAGE_A(PG8_SA(0, 1), a2, 1, last);
            PG8_WAIT_V(8); PG8_WAIT_L(0); PG8_BAR; PG8_MMA(0, 0, At, B0); PG8_MMA(0, 1, At, B1); PG8_BAR; PG8_SCHED;
            PG8_LDA(At, 1, 1); PG8_STAGE(PG8_SB(1, 0), b3, voffB); PG8_STAGE(PG8_SB(1, 1), b3 + hstep, voffB); PG8_STAGE_A(PG8_SA(1, 0), a3, 0, last);
            PG8_WAIT_V(8); PG8_WAIT_L(0); PG8_BAR; PG8_MMA(1, 0, At, B0); PG8_MMA(1, 1, At, B1); PG8_BAR; PG8_SCHED;
            } else {
            PG8_LDB(B0, 0, 0); PG8_SCHED; PG8_LDA(At, 0, 0); PG8_STAGE(PG8_SA(1, 1), a1 + hstep, voffA);
            PG8_WAIT_L(8); PG8_BAR; PG8_WAIT_L(0); PG8_MMA(0, 0, At, B0); PG8_BAR; PG8_SCHED;
            PG8_LDB(B1, 0, 1); PG8_STAGE(PG8_SB(0, 0), b2, voffB);
            PG8_BAR; PG8_WAIT_L(0); PG8_MMA(0, 1, At, B1); PG8_BAR;
            PG8_LDA(At, 0, 1); PG8_STAGE(PG8_SA(0, 0), a2, voffA);
            PG8_BAR; PG8_WAIT_L(0); PG8_MMA(1, 0, At, B0); PG8_BAR; PG8_SCHED;
            PG8_STAGE(PG8_SB(0, 1), b2 + hstep, voffB);
            PG8_WAIT_V(6); PG8_BAR; PG8_MMA(1, 1, At, B1); PG8_BAR;
            PG8_LDB(B0, 1, 0); PG8_SCHED; PG8_LDA(At, 1, 0); PG8_STAGE(PG8_SA(0, 1), a2 + hstep, voffA);
            PG8_WAIT_L(8); PG8_BAR; PG8_WAIT_L(0); PG8_MMA(0, 0, At, B0); PG8_BAR; PG8_SCHED;
            PG8_LDB(B1, 1, 1); PG8_STAGE(PG8_SB(1, 0), b3, voffB);
            PG8_BAR; PG8_WAIT_L(0); PG8_MMA(0, 1, At, B1); PG8_BAR;
            PG8_LDA(At, 1, 1); PG8_STAGE(PG8_SA(1, 0), a3, voffA);
            PG8_BAR; PG8_WAIT_L(0); PG8_MMA(1, 0, At, B0); PG8_BAR; PG8_SCHED;
            PG8_STAGE(PG8_SB(1, 1), b3 + hstep, voffB);
            PG8_WAIT_V(6); PG8_BAR; PG8_MMA(1, 1, At, B1); PG8_BAR;
            }
        }
        if constexpr (F8) { asm volatile("s_nop 15\n\ts_nop 15" ::: "memory"); PG8_SCHED; }
        if constexpr (ALIGN_EPI) { if (wr == 0) PG8_BAR; }
        if constexpr (!Epi::AFTER_DRAIN) { E(acc, cur, wr, wc, fr, fq); S.done(cur); }
        if (!has_next) break;
#pragma unroll
        for (int a = 0; a < 2; ++a)
#pragma unroll
            for (int b = 0; b < 2; ++b)
#pragma unroll
                for (int m = 0; m < 4; ++m)
#pragma unroll
                    for (int n = 0; n < 2; ++n) acc[a][b][m][n] = (f32x4){zf_, zf_, zf_, zf_};
        cur = nxt; cA = nA; cB = nB; ++ui;
        if constexpr (Gath::ON) { _Pragma("unroll") for (int h_ = 0; h_ < 2; ++h_) _Pragma("unroll") for (int i_ = 0; i_ < 2; ++i_) voffG[h_][i_] = voffN[h_][i_]; }
        if constexpr (ALIGN_EPI) { if (wr == 1) PG8_BAR; }
    }
    PG8_WAIT_V(0);
    if constexpr (!ALIGN_EPI) { if (wr == 0) PG8_BAR; }
    PG8_BAR;
    if constexpr (Epi::AFTER_DRAIN) { E.fused(acc, cur, wr, wc, fr, fq, lds, wid, lane); S.done(cur); }
#undef PG8_SA
#undef PG8_SB
#undef PG8_STAGE
#undef PG8_STAGE_A
#undef PG8_GOFF
#undef PG8_LDA
#undef PG8_LDB
#undef PG8_MMA
#undef PG8_CAT8
#undef PG8_WAIT_V
#undef PG8_WAIT_L
#undef PG8_BAR
#undef PG8_SCHED
}
}

#include <hip/hip_bf16.h>
#include <cmath>
namespace attn_body {
using bf16=__hip_bfloat16;
using bf16x8=__attribute__((ext_vector_type(8)))short;
using s16x4=__attribute__((ext_vector_type(4)))short;
using f32x16=__attribute__((ext_vector_type(16)))float;
using u32x4=__attribute__((ext_vector_type(4)))unsigned;
constexpr int SEQ=8192,D=64,PITCH=2304;
constexpr int NW=8,QBLK=32,QB=QBLK*NW,KVBLK=64,NQB=SEQ/QB;
constexpr int ATTN_UNIT_ROWS=QB;
__device__ __forceinline__ int crow(int r,int hi){return (r&3)+8*(r>>2)+4*hi;}
#define SBAR() __builtin_amdgcn_sched_barrier(0)
__device__ __forceinline__ void bmask(f32x16&p0,f32x16&p1,int T,int qw,int qabs,int hi){
  if(64*T+63-qw<=128 && qw+31-64*T<=128) return;
  const float NEG=-INFINITY; const int kb=64*T+4*hi-qabs;
  #pragma unroll
  for(int r=0;r<16;++r){const int d=kb+(r&3)+8*(r>>2); if(d>128||d<-128)p0[r]=NEG; if(d+32>128||d+32<-128)p1[r]=NEG;}
}
__device__ __forceinline__ void cmask(f32x16&p0,f32x16&p1,int jb,int qrel,int hi){
  const float NEG=-INFINITY; int kb=64*jb+4*hi;
  #pragma unroll
  for(int r=0;r<16;++r){int kv=kb+(r&3)+8*(r>>2); if(kv>qrel)p0[r]=NEG; if(kv+32>qrel)p1[r]=NEG;}
}

constexpr int NSLOT=3, SLOTB=8192;
constexpr int LDS_K=0, LDS_V=NSLOT*SLOTB, LDS_WS=2*NSLOT*SLOTB, LDS_OST=LDS_WS+NW*64*4, LDS_BYTES=LDS_OST+NW*4096;
constexpr float C2=0.125f*1.4426950408889634f;
__device__ __forceinline__ void glds16(const void*gsrc,unsigned lds_dst){unsigned keep;
  asm volatile("s_mov_b32 %0, m0\n\ts_mov_b32 m0, %2\n\ts_nop 0\n\tglobal_load_lds_dwordx4 %1, off\n\ts_mov_b32 m0, %0":"=&s"(keep):"v"(gsrc),"s"(lds_dst):"memory");}
__device__ __forceinline__ void glds16s(const void*sbase,unsigned voff,unsigned lds_dst){unsigned keep;
  asm volatile("s_mov_b32 %0, m0\n\ts_mov_b32 m0, %3\n\ts_nop 0\n\tglobal_load_lds_dwordx4 %1, %2\n\ts_mov_b32 m0, %0":"=&s"(keep):"v"(voff),"s"(sbase),"s"(lds_dst):"memory");}
__device__ __forceinline__ float max3f(float a,float b,float c){float r;asm("v_max3_f32 %0, %1, %2, %3":"=v"(r):"v"(a),"v"(b),"v"(c));return r;}
__device__ __forceinline__ float max2f(float a,float b){float r;asm("v_max_f32_e32 %0, %1, %2":"=v"(r):"v"(a),"v"(b));return r;}
__device__ __forceinline__ float fadd_s(float a,float b){float r;asm("v_add_f32_e32 %0, %1, %2":"=v"(r):"v"(a),"v"(b));return r;}
__device__ __forceinline__ float fsub_s(float a,float b){float r;asm("v_sub_f32_e32 %0, %1, %2":"=v"(r):"v"(a),"v"(b));return r;}
typedef float f32x2_t __attribute__((ext_vector_type(2))); typedef __bf16 bf16x2_t __attribute__((ext_vector_type(2)));
__device__ __forceinline__ unsigned cvtpk_s(float lo,float hi){f32x2_t v={lo,hi};bf16x2_t b=__builtin_convertvector(v,bf16x2_t);return __builtin_bit_cast(unsigned,b);}
#define WAIT_BAR(N) asm volatile("s_waitcnt vmcnt(" #N ") lgkmcnt(0)\n\ts_barrier":::"memory")

__device__ __forceinline__ void qkt(f32x16&p0,f32x16&p1,const char*Kslot,const bf16x8*qr,const f32x16&negm,int r32,int hi){
  const char*kb=Kslot+hi*1024+r32*16;
  #pragma unroll
  for(int d0=0;d0<4;++d0){
    const bf16x8 b0=*reinterpret_cast<const bf16x8*>(kb+d0*2048);
    const bf16x8 b1=*reinterpret_cast<const bf16x8*>(kb+d0*2048+512);
    if(d0==0){p0=__builtin_amdgcn_mfma_f32_32x32x16_bf16(b0,qr[0],negm,0,0,0);p1=__builtin_amdgcn_mfma_f32_32x32x16_bf16(b1,qr[0],negm,0,0,0);}
    else{p0=__builtin_amdgcn_mfma_f32_32x32x16_bf16(b0,qr[d0],p0,0,0,0);p1=__builtin_amdgcn_mfma_f32_32x32x16_bf16(b1,qr[d0],p1,0,0,0);}}
}
typedef __attribute__((address_space(3))) const char* lds_cptr;
typedef short v4i16_t __attribute__((ext_vector_type(4)));
__device__ __forceinline__ void kload8(bf16x8*kf,lds_cptr kp){
  kf[0]=*(const __attribute__((address_space(3))) bf16x8*)(kp);      kf[1]=*(const __attribute__((address_space(3))) bf16x8*)(kp+512);
  kf[2]=*(const __attribute__((address_space(3))) bf16x8*)(kp+2048); kf[3]=*(const __attribute__((address_space(3))) bf16x8*)(kp+2560);
  kf[4]=*(const __attribute__((address_space(3))) bf16x8*)(kp+4096); kf[5]=*(const __attribute__((address_space(3))) bf16x8*)(kp+4608);
  kf[6]=*(const __attribute__((address_space(3))) bf16x8*)(kp+6144); kf[7]=*(const __attribute__((address_space(3))) bf16x8*)(kp+6656);
}
__device__ __forceinline__ void kload2(bf16x8*kf,lds_cptr kp,int j){ kf[2*j]=*(const __attribute__((address_space(3))) bf16x8*)(kp+j*2048); kf[2*j+1]=*(const __attribute__((address_space(3))) bf16x8*)(kp+j*2048+512); }
__device__ __forceinline__ s16x4 vtr(lds_cptr p){ return __builtin_bit_cast(s16x4,__builtin_amdgcn_ds_read_tr16_b64_v4i16((__attribute__((address_space(3))) v4i16_t*)p)); }
__device__ __forceinline__ float rowmax(const f32x16&p0,const f32x16&p1){
  float a=max3f(p0[0],p0[1],p1[0]),b=max3f(p0[2],p0[3],p1[1]);a=max3f(a,p1[2],p1[3]);
  #pragma unroll
  for(int r=4;r<16;r+=4){a=max3f(a,p0[r],p0[r+1]);b=max3f(b,p0[r+2],p0[r+3]);a=max3f(a,p1[r],p1[r+1]);b=max3f(b,p1[r+2],p1[r+3]);}
  const float m=max2f(a,b);
  auto rr=__builtin_amdgcn_permlane32_swap(__float_as_uint(m),__float_as_uint(m),false,false);
  return max2f(__uint_as_float(rr[0]),__uint_as_float(rr[1]));
}
__device__ __forceinline__ void pv(f32x16*o,int vb,bf16x8 pa0,bf16x8 pa1,bf16x8 pa2,bf16x8 pa3){
  #pragma unroll
  for(int d0=0;d0<2;++d0){s16x4 lo[4],hi[4];
    #pragma unroll
    for(int ks=0;ks<4;++ks){
      asm volatile("ds_read_b64_tr_b16 %0,%1 offset:%c2":"=&v"(lo[ks]):"v"(vb),"i"(d0*4096+ks*1024):"memory");
      asm volatile("ds_read_b64_tr_b16 %0,%1 offset:%c2":"=&v"(hi[ks]):"v"(vb),"i"(d0*4096+ks*1024+512):"memory");}
    asm volatile("s_waitcnt lgkmcnt(0)":::"memory");SBAR();
    #define PK(k) (bf16x8){lo[k][0],lo[k][1],lo[k][2],lo[k][3],hi[k][0],hi[k][1],hi[k][2],hi[k][3]}
    o[d0]=__builtin_amdgcn_mfma_f32_32x32x16_bf16(pa0,PK(0),o[d0],0,0,0);
    o[d0]=__builtin_amdgcn_mfma_f32_32x32x16_bf16(pa1,PK(1),o[d0],0,0,0);
    o[d0]=__builtin_amdgcn_mfma_f32_32x32x16_bf16(pa2,PK(2),o[d0],0,0,0);
    o[d0]=__builtin_amdgcn_mfma_f32_32x32x16_bf16(pa3,PK(3),o[d0],0,0,0);
    #undef PK
  }
}

#ifndef ATTN_STORE16
#define ATTN_STORE16(p,v) (*(u32x4*)(p)=(v))
#endif
template<int THRL,bool WIN> __device__ __forceinline__ void attn_unit(const bf16*Qb,const bf16*__restrict__ Kb,const bf16*__restrict__ Vb,bf16*Ob,int opitch,int q0,float sink_l2,char*shm){
  int tid_=threadIdx.x; asm volatile("":"+v"(tid_)); const int tid=tid_,lane=tid&63,r32=lane&31,hi=lane>>5; const int wid=__builtin_amdgcn_readfirstlane(tid>>6);
  const bf16*Qw=Qb+(long)(q0+wid*QBLK)*PITCH;
  const int tq=q0/KVBLK; const int ta=WIN?(tq-2<0?0:tq-2):0; const int tb=WIN?(tq+6>SEQ/KVBLK?SEQ/KVBLK:tq+6):SEQ/KVBLK;
  const int NT=tb-ta; const int s0=WIN?(tq+1-ta):0;
  #define TMAP(t) (WIN?(ta+(((t)+s0>=NT)?(t)+s0-NT:(t)+s0)):(t))
  const unsigned lds0=(unsigned)(uintptr_t)shm;
  float*wsf=(float*)(shm+LDS_WS)+wid*64;
  const bf16*ksrc=Kb+(long)lane*PITCH+wid*8;
  const bf16*vsrc=Vb+(long)(16*(wid&3)+(lane>>2))*PITCH+(wid>>2)*32+(lane&3)*8;
  const unsigned kdst=lds0+LDS_K+wid*1024, vdst=lds0+LDS_V+wid*1024;
  #define DMA_K(t,slot) glds16(ksrc+(long)TMAP(t)*KVBLK*PITCH,(unsigned)__builtin_amdgcn_readfirstlane(kdst+(slot)))
  #define DMA_V(t,slot) glds16(vsrc+(long)TMAP(t)*KVBLK*PITCH,(unsigned)__builtin_amdgcn_readfirstlane(vdst+(slot)))
  const int vb0=(int)(lds0+LDS_V)+((lane>>4)&1)*32+(lane&3)*8+(4*hi+((lane&15)>>2))*64;
  const char*Kbase=shm+LDS_K; bf16x8 kf[8];
  const lds_cptr shm3=(lds_cptr)shm; const lds_cptr kp0=shm3+LDS_K+hi*1024+r32*16; const lds_cptr vp0=shm3+LDS_V+((lane>>4)&1)*32+(lane&3)*8+(4*hi+((lane&15)>>2))*64;
  DMA_K(0,0);DMA_V(0,0);DMA_K(1,SLOTB);
  bf16x8 qr[4];
  #pragma unroll
  for(int d0=0;d0<4;++d0)qr[d0]=*reinterpret_cast<const bf16x8*>(&Qw[(long)r32*PITCH+d0*16+hi*8]);
  float zf_=0.f; asm volatile("":"+v"(zf_)); f32x16 zz_; _Pragma("unroll") for(int r=0;r<16;++r)zz_[r]=zf_;
  float mhat=0.f,l_reg=0.f;f32x16 o[2];o[0]=zz_;o[1]=zz_;f32x16 negm=zz_;asm volatile("":"+v"(negm));
  const int qw=q0+wid*QBLK, qabs=qw+r32;
  #define CMASK(P0,P1,t) do{ if constexpr(WIN) bmask(P0,P1,TMAP(t),qw,qabs,hi); }while(0)
  bool resc=false;
  #define START(P0,P1) do{ const float rm=rowmax(P0,P1); resc=false; \
    { const float dl=rm; mhat=fadd_s(mhat,dl); \
      _Pragma("unroll") for(int r=0;r<16;++r){P0[r]=fsub_s(P0[r],dl);P1[r]=fsub_s(P1[r],dl);} \
      _Pragma("unroll") for(int r=0;r<16;++r)negm[r]=-mhat; asm volatile("":"+v"(negm)); } \
    _Pragma("unroll") for(int r=0;r<16;++r)P0[r]=__builtin_amdgcn_exp2f(P0[r]); }while(0)
  #define RESC() do{ if(resc){ asm volatile("s_waitcnt lgkmcnt(0)":::"memory"); \
      _Pragma("unroll") for(int d_=0;d_<2;++d_) _Pragma("unroll") for(int r=0;r<16;++r)o[d_][r]*=wsf[crow(r,hi)]; } }while(0)
  f32x16 pA0,pA1,pB0,pB1;
  int sl_prev=0,sl_cur=0,sl_next=SLOTB;
  #define ROT() do{sl_prev=sl_cur;sl_cur=sl_next;sl_next=(sl_next==(NSLOT-1)*SLOTB)?0:sl_next+SLOTB;}while(0)
  DMA_K(2,2*SLOTB);
  WAIT_BAR(3);
  qkt(pA0,pA1,Kbase,qr,negm,r32,hi);asm volatile("s_nop 15\n\ts_nop 7":"+v"(pA0),"+v"(pA1));CMASK(pA0,pA1,0);
  START(pA0,pA1);
  _Pragma("unroll") for(int r=0;r<16;++r)pA1[r]=__builtin_amdgcn_exp2f(pA1[r]);
  WAIT_BAR(0);
  DMA_K(3,0);DMA_V(1,SLOTB);
  ROT();
  kload8(kf,kp0+sl_cur);
  WAIT_BAR(2);
  u32x4 pw0,pw1,pw2,pw3; { const unsigned zu_=__float_as_uint(zf_); pw0=(u32x4){zu_,zu_,zu_,zu_}; pw1=pw0; pw2=pw0; pw3=pw0; }
  #define PKW(P,B) cvtpk_s(P[B],P[B+1])
  #define PAF(k) __builtin_bit_cast(bf16x8,pw##k)
  #define VFR(i) (bf16x8){vlo[i][0],vlo[i][1],vlo[i][2],vlo[i][3],vhi[i][0],vhi[i][1],vhi[i][2],vhi[i][3]}
  #define PIN(x) asm volatile("":"+v"(x))
  #define MX3(a,b,c) __builtin_fmaxf(__builtin_fmaxf((a),(b)),(c))
  #define GAPA(MF,A0,A1,A2,A3,W0,W1,PW) do{ MF; sacc+=A0; sacc+=A1; sacc+=A2; sacc+=A3; PIN(sacc); W0; W1; PIN(PW); SBAR(); }while(0)
  #define EX(v) __builtin_amdgcn_exp2f(v)
  #define GAPB(MF,X,B) do{ MF; X[B]=EX(X[B]); X[B+1]=EX(X[B+1]); X[B+2]=EX(X[B+2]); X[B+3]=EX(X[B+3]); PIN(X); SBAR(); }while(0)
  #define VRD(i) do{ vlo[i]=vtr(vp_+(((i)>>2)*4096+((i)&3)*1024)); vhi[i]=vtr(vp_+(((i)>>2)*4096+((i)&3)*1024+512)); }while(0)
  #define KRD(G,j) do{ if(G){ kload2(kf,kp0+sl_next,j); SBAR(); } }while(0)
  #define STEP(C0,C1,P0,P1,t,GK,GV,GL) do{ SBAR(); s16x4 vlo[8],vhi[8]; \
    const lds_cptr vp_=vp0+sl_prev; \
    VRD(0); SBAR(); float sacc=(P0[0]+P0[1]); \
    GAPA(C0=__builtin_amdgcn_mfma_f32_32x32x16_bf16(kf[0],qr[0],negm,0,0,0), P0[2],P0[3],P0[4],P0[5],     pw0[0]=PKW(P0,0), pw0[1]=PKW(P0,2), pw0); \
    VRD(4); SBAR(); GAPA(C1=__builtin_amdgcn_mfma_f32_32x32x16_bf16(kf[1],qr[0],negm,0,0,0), P0[6],P0[7],P0[8],P0[9],     pw0[2]=PKW(P0,4), pw0[3]=PKW(P0,6), pw0); \
    VRD(1); SBAR(); GAPA(C0=__builtin_amdgcn_mfma_f32_32x32x16_bf16(kf[2],qr[1],C0,0,0,0),   P0[10],P0[11],P0[12],P0[13], pw1[0]=PKW(P0,8), pw1[1]=PKW(P0,10), pw1); \
    VRD(5); SBAR(); GAPA(C1=__builtin_amdgcn_mfma_f32_32x32x16_bf16(kf[3],qr[1],C1,0,0,0),   P0[14],P0[15],P1[0],P1[1],   pw1[2]=PKW(P0,12),pw1[3]=PKW(P0,14), pw1); \
    VRD(2); SBAR(); GAPA(C0=__builtin_amdgcn_mfma_f32_32x32x16_bf16(kf[4],qr[2],C0,0,0,0),   P1[2],P1[3],P1[4],P1[5],     pw2[0]=PKW(P1,0), pw2[1]=PKW(P1,2), pw2); \
    VRD(6); SBAR(); GAPA(C1=__builtin_amdgcn_mfma_f32_32x32x16_bf16(kf[5],qr[2],C1,0,0,0),   P1[6],P1[7],P1[8],P1[9],     pw2[2]=PKW(P1,4), pw2[3]=PKW(P1,6), pw2); \
    VRD(3); SBAR(); GAPA(C0=__builtin_amdgcn_mfma_f32_32x32x16_bf16(kf[6],qr[3],C0,0,0,0),   P1[10],P1[11],P1[12],P1[13], pw3[0]=PKW(P1,8), pw3[1]=PKW(P1,10), pw3); \
    VRD(7); SBAR(); GAPA(C1=__builtin_amdgcn_mfma_f32_32x32x16_bf16(kf[7],qr[3],C1,0,0,0),   P1[14],P1[15],0.f,0.f,       pw3[2]=PKW(P1,12),pw3[3]=PKW(P1,14), pw3); \
    l_reg+=sacc; \
    if(GK){DMA_K((t)+3,sl_cur);} if(GV){DMA_V((t)+1,sl_next);} \
    CMASK(C0,C1,t); \
    { float a=MX3(C0[0],C0[1],C1[0]),b=MX3(C0[2],C0[3],C1[1]); a=MX3(a,C1[2],C1[3]); \
      _Pragma("unroll") for(int r=4;r<16;r+=4){a=MX3(a,C0[r],C0[r+1]);b=MX3(b,C0[r+2],C0[r+3]);a=MX3(a,C1[r],C1[r+1]);b=MX3(b,C1[r+2],C1[r+3]);} \
      float rm=__builtin_fmaxf(a,b); { auto rr=__builtin_amdgcn_permlane32_swap(__float_as_uint(rm),__float_as_uint(rm),false,false); rm=__builtin_fmaxf(__uint_as_float(rr[0]),__uint_as_float(rr[1])); } \
      resc=false; \
      if(__builtin_expect(__any(rm>(float)THRL),0)){ const float dl=__builtin_fmaxf(rm,0.f); mhat+=dl; \
        _Pragma("unroll") for(int r=0;r<16;++r){C0[r]-=dl;C1[r]-=dl;} \
        _Pragma("unroll") for(int r=0;r<16;++r)negm[r]=-mhat; asm volatile("":"+v"(negm)); \
        const float f=__builtin_amdgcn_exp2f(-dl); l_reg*=f; if(hi==0)wsf[r32]=f; resc=true; } } \
    SBAR(); \
    GAPB(o[0]=__builtin_amdgcn_mfma_f32_32x32x16_bf16(PAF(0),VFR(0),o[0],0,0,0), C0,0); \
    GAPB(o[1]=__builtin_amdgcn_mfma_f32_32x32x16_bf16(PAF(0),VFR(4),o[1],0,0,0), C0,4); \
    KRD(GL,0); GAPB(o[0]=__builtin_amdgcn_mfma_f32_32x32x16_bf16(PAF(1),VFR(1),o[0],0,0,0), C0,8); \
    KRD(GL,1); GAPB(o[1]=__builtin_amdgcn_mfma_f32_32x32x16_bf16(PAF(1),VFR(5),o[1],0,0,0), C0,12); \
    KRD(GL,2); GAPB(o[0]=__builtin_amdgcn_mfma_f32_32x32x16_bf16(PAF(2),VFR(2),o[0],0,0,0), C1,0); \
    KRD(GL,3); GAPB(o[1]=__builtin_amdgcn_mfma_f32_32x32x16_bf16(PAF(2),VFR(6),o[1],0,0,0), C1,4); \
    GAPB(o[0]=__builtin_amdgcn_mfma_f32_32x32x16_bf16(PAF(3),VFR(3),o[0],0,0,0), C1,8); \
    GAPB(o[1]=__builtin_amdgcn_mfma_f32_32x32x16_bf16(PAF(3),VFR(7),o[1],0,0,0), C1,12); \
    }while(0)
  int t=1;
  for(;t+5<NT;t+=2){
    STEP(pB0,pB1,pA0,pA1,t,true,true,true);     WAIT_BAR(2); RESC(); ROT();
    STEP(pA0,pA1,pB0,pB1,t+1,true,true,true);   WAIT_BAR(2); RESC(); ROT();
  }
  #define ENDW(tt) do{ if((tt)+3<NT){WAIT_BAR(2);} else if((tt)+2<NT){WAIT_BAR(1);} else {WAIT_BAR(0);} }while(0)
  for(;t+1<NT;t+=2){
    STEP(pB0,pB1,pA0,pA1,t,(t+3<NT),(t+1<NT),(t+1<NT));       ENDW(t);   RESC(); ROT();
    STEP(pA0,pA1,pB0,pB1,t+1,(t+4<NT),(t+2<NT),(t+2<NT));     ENDW(t+1); RESC(); ROT();
  }
  STEP(pB0,pB1,pA0,pA1,NT-1,false,false,false); RESC();
  { float sacc=pB0[0]+pB0[1]; _Pragma("unroll") for(int r=2;r<16;++r)sacc+=pB0[r]; _Pragma("unroll") for(int r=0;r<16;++r)sacc+=pB1[r]; l_reg+=sacc;
    pw0=(u32x4){PKW(pB0,0),PKW(pB0,2),PKW(pB0,4),PKW(pB0,6)};pw1=(u32x4){PKW(pB0,8),PKW(pB0,10),PKW(pB0,12),PKW(pB0,14)};pw2=(u32x4){PKW(pB1,0),PKW(pB1,2),PKW(pB1,4),PKW(pB1,6)};pw3=(u32x4){PKW(pB1,8),PKW(pB1,10),PKW(pB1,12),PKW(pB1,14)};
    SBAR(); pv(o,vb0+sl_cur,PAF(0),PAF(1),PAF(2),PAF(3)); }
  #undef PKW
  #undef PAF
  #undef VFR
  #undef PIN
  #undef MX3
  #undef GAPA
  #undef GAPB
  #undef EX
  #undef VRD
  #undef KRD
  #undef STEP
  #undef ENDW
  {auto rr=__builtin_amdgcn_permlane32_swap(__float_as_uint(l_reg),__float_as_uint(l_reg),false,false);l_reg=__uint_as_float(rr[0])+__uint_as_float(rr[1]);}
  if constexpr(WIN) l_reg+=__builtin_amdgcn_exp2f(sink_l2-mhat);
  if(hi==0)wsf[32+r32]=l_reg;asm volatile("s_waitcnt lgkmcnt(0)":::"memory");
  float rli[16];
  #pragma unroll
  for(int r=0;r<16;++r)rli[r]=__builtin_amdgcn_rcpf(wsf[32+crow(r,hi)]);
  bf16*Ow=Ob+(long)(q0+wid*QBLK)*opitch;
  { bf16*stg=(bf16*)(shm+LDS_OST)+wid*2048;
    #pragma unroll
    for(int r=0;r<16;++r){const int orow=crow(r,hi);
      #pragma unroll
      for(int d0=0;d0<2;++d0)stg[orow*64+d0*32+r32]=__float2bfloat16(o[d0][r]*rli[r]);}
    asm volatile("s_waitcnt lgkmcnt(0)":::"memory");
    #pragma unroll
    for(int i=0;i<4;++i){const int row=i*8+(lane>>3),ch=lane&7; const u32x4 v=*(const u32x4*)(stg+row*64+ch*8); ATTN_STORE16(Ow+(long)row*opitch+ch*8,v);} }
  asm volatile("s_waitcnt lgkmcnt(0)\n\ts_barrier":::"memory");
  #undef DMA_K
  #undef TMAP
  #undef DMA_V
  #undef CMASK
  #undef START
  #undef RESC
  #undef ROT
}
constexpr int DSLOT=16384, D_LDS_K=0, D_LDS_V=3*DSLOT, D_LDS_WS=6*DSLOT, D_LDS_Q=D_LDS_WS+NW*256, D_LDS_BYTES=D_LDS_Q+NW*4096;
typedef __attribute__((address_space(3))) char* lds_ptr;
__device__ __forceinline__ void pv4(f32x16*o,int vb,bf16x8 pa0,bf16x8 pa1,bf16x8 pa2,bf16x8 pa3){
  #pragma unroll
  for(int d0=0;d0<4;++d0){s16x4 lo[4],hi[4];
    #pragma unroll
    for(int ks=0;ks<4;++ks){
      asm volatile("ds_read_b64_tr_b16 %0,%1 offset:%c2":"=&v"(lo[ks]):"v"(vb),"i"(d0*4096+ks*1024):"memory");
      asm volatile("ds_read_b64_tr_b16 %0,%1 offset:%c2":"=&v"(hi[ks]):"v"(vb),"i"(d0*4096+ks*1024+512):"memory");}
    asm volatile("s_waitcnt lgkmcnt(0)":::"memory");SBAR();
    #define PK(k) (bf16x8){lo[k][0],lo[k][1],lo[k][2],lo[k][3],hi[k][0],hi[k][1],hi[k][2],hi[k][3]}
    o[d0]=__builtin_amdgcn_mfma_f32_32x32x16_bf16(pa0,PK(0),o[d0],0,0,0);
    o[d0]=__builtin_amdgcn_mfma_f32_32x32x16_bf16(pa1,PK(1),o[d0],0,0,0);
    o[d0]=__builtin_amdgcn_mfma_f32_32x32x16_bf16(pa2,PK(2),o[d0],0,0,0);
    o[d0]=__builtin_amdgcn_mfma_f32_32x32x16_bf16(pa3,PK(3),o[d0],0,0,0);
    #undef PK
  }
}
__device__ __forceinline__ float half_sum(float v){
  #define HS_DPP(ctrl) v+=__builtin_bit_cast(float,__builtin_amdgcn_update_dpp(0,__builtin_bit_cast(int,v),ctrl,0xF,0xF,true))
  HS_DPP(0xB1); HS_DPP(0x4E); HS_DPP(0x141); HS_DPP(0x140);
  #undef HS_DPP
  v+=__builtin_bit_cast(float,__builtin_amdgcn_ds_swizzle(__builtin_bit_cast(int,v),0x401F));
  return v;
}
template<int THRL> __device__ __forceinline__ void dattn_unit(const bf16*Qb,const bf16*__restrict__ Kb,const bf16*__restrict__ Vb,bf16*Ob,int q0,float lam,float omli,const float*subg,char*shm){
  constexpr int OPITCH=1024; constexpr float DEPS=1e-6f;
  int tid_=threadIdx.x; asm volatile("":"+v"(tid_)); const int tid=tid_,lane=tid&63,r32=lane&31,hi=lane>>5; const int wid=__builtin_amdgcn_readfirstlane(tid>>6);
  const int qg=wid>>1,c=wid&1;
  const bf16*Qw=Qb+(long)(q0+qg*QBLK)*PITCH+c*64;
  constexpr int NT=SEQ/KVBLK;
  const unsigned lds0=(unsigned)(uintptr_t)shm;
  float*wsf=(float*)(shm+D_LDS_WS)+wid*64;
  const unsigned ksoff=(unsigned)(lane*PITCH+wid*8)*2u;
  const unsigned vsoff=(unsigned)((16*(wid&3)+(lane>>2))*PITCH+(wid>>2)*32+(lane&3)*8)*2u;
  const unsigned kdst=lds0+D_LDS_K+wid*1024, vdst=lds0+D_LDS_V+wid*1024;
  #define WB(a,b) do{ if(PROBE==20){WAIT_BAR(b);}else{WAIT_BAR(a);} if(PROBE==22){asm volatile("s_barrier":::"memory");} }while(0)
  #define RFL(x) ((unsigned)__builtin_amdgcn_readfirstlane(x))
  #define DMA_K1(t,slot) do{ glds16s(Kb+(long)(t)*KVBLK*PITCH,ksoff,RFL(kdst+(slot))); glds16s(Kb+64+(long)(t)*KVBLK*PITCH,ksoff,RFL(kdst+8192+(slot))); }while(0)
  #define DMA_K(t,slot) do{ DMA_K1(t,slot); if(PROBE==20){DMA_K1(t,slot);} }while(0)
  #define DMA_KA(t,slot) glds16s(Kb+(long)(t)*KVBLK*PITCH,ksoff,RFL(kdst+(slot)))
  #define DMA_KB(t,slot) glds16s(Kb+64+(long)(t)*KVBLK*PITCH,ksoff,RFL(kdst+8192+(slot)))
  #define DMA_VA(t,slot) glds16s(Vb+(long)(t)*KVBLK*PITCH,vsoff,RFL(vdst+(slot)))
  #define DMA_VB(t,slot) glds16s(Vb+64+(long)(t)*KVBLK*PITCH,vsoff,RFL(vdst+8192+(slot)))
  #define DMA_V1(t,slot) do{ glds16s(Vb+(long)(t)*KVBLK*PITCH,vsoff,RFL(vdst+(slot))); glds16s(Vb+64+(long)(t)*KVBLK*PITCH,vsoff,RFL(vdst+8192+(slot))); }while(0)
  #define DMA_V(t,slot) do{ DMA_V1(t,slot); if(PROBE==20){DMA_V1(t,slot);} }while(0)
  const int vb0=(int)(lds0+D_LDS_V)+((lane>>4)&1)*32+(lane&3)*8+(4*hi+((lane&15)>>2))*64;
  const char*Kbase=shm+D_LDS_K+c*8192; bf16x8 kf[8];
  const lds_cptr shm3=(lds_cptr)shm; const lds_cptr kp0=shm3+D_LDS_K+c*8192+hi*1024+r32*16; const lds_cptr vp0=shm3+D_LDS_V+((lane>>4)&1)*32+(lane&3)*8+(4*hi+((lane&15)>>2))*64;
  DMA_K(0,0);DMA_V(0,0);DMA_K(1,DSLOT);
  const __attribute__((address_space(3))) bf16x8*qsp=(const __attribute__((address_space(3))) bf16x8*)((lds_ptr)shm+D_LDS_Q+wid*4096)+lane;
  { bf16x8 qr[4];
    #pragma unroll
    for(int d0=0;d0<4;++d0)qr[d0]=*reinterpret_cast<const bf16x8*>(&Qw[(long)r32*PITCH+d0*16+hi*8]);
    #pragma unroll
    for(int d0=0;d0<4;++d0)((__attribute__((address_space(3))) bf16x8*)qsp)[64*d0]=qr[d0];
    asm volatile("s_waitcnt lgkmcnt(0)":::"memory"); }
  #define QF(d0) (qsp[64*(d0)])
  float zf_=0.f; asm volatile("":"+v"(zf_)); f32x16 zz_; _Pragma("unroll") for(int r=0;r<16;++r)zz_[r]=zf_;
  float mhat=0.f,l_reg=0.f;f32x16 o[4];o[0]=zz_;o[1]=zz_;o[2]=zz_;o[3]=zz_;f32x16 negm=zz_;asm volatile("":"+v"(negm));
  bool resc=false;
  #define START(P0,P1) do{ const float rm=rowmax(P0,P1); resc=false; \
    { const float dl=rm; mhat=fadd_s(mhat,dl); \
      _Pragma("unroll") for(int r=0;r<16;++r){P0[r]=fsub_s(P0[r],dl);P1[r]=fsub_s(P1[r],dl);} \
      _Pragma("unroll") for(int r=0;r<16;++r)negm[r]=-mhat; asm volatile("":"+v"(negm)); } \
    _Pragma("unroll") for(int r=0;r<16;++r)P0[r]=__builtin_amdgcn_exp2f(P0[r]); }while(0)
  #define RESC() do{ if(resc){ asm volatile("s_waitcnt lgkmcnt(0)":::"memory"); \
      _Pragma("unroll") for(int d_=0;d_<4;++d_) _Pragma("unroll") for(int r=0;r<16;++r)o[d_][r]*=wsf[crow(r,hi)]; } }while(0)
  f32x16 pA0,pA1,pB0,pB1;
  int sl_prev=0,sl_cur=0,sl_next=DSLOT;
  #define ROT() do{sl_prev=sl_cur;sl_cur=sl_next;sl_next=(sl_next==2*DSLOT)?0:sl_next+DSLOT;}while(0)
  DMA_K(2,2*DSLOT);
  WB(6,12);
  { bf16x8 qr[4]; _Pragma("unroll") for(int d0=0;d0<4;++d0)qr[d0]=QF(d0); qkt(pA0,pA1,Kbase,qr,negm,r32,hi); }asm volatile("s_nop 15\n\ts_nop 7":"+v"(pA0),"+v"(pA1));
  START(pA0,pA1);
  _Pragma("unroll") for(int r=0;r<16;++r)pA1[r]=__builtin_amdgcn_exp2f(pA1[r]);
  WAIT_BAR(0);
  DMA_K(3,0);DMA_V(1,DSLOT);
  ROT();
  kload8(kf,kp0+sl_cur);
  WB(4,8);
  u32x4 pw0,pw1,pw2,pw3; { const unsigned zu_=__float_as_uint(zf_); pw0=(u32x4){zu_,zu_,zu_,zu_}; pw1=pw0; pw2=pw0; pw3=pw0; }
  #define PKW(P,B) cvtpk_s(P[B],P[B+1])
  #define PAF(k) __builtin_bit_cast(bf16x8,pw##k)
  #define VFR(i) (bf16x8){vlo[i][0],vlo[i][1],vlo[i][2],vlo[i][3],vhi[i][0],vhi[i][1],vhi[i][2],vhi[i][3]}
  #define PIN(x) asm volatile("":"+v"(x))
  #define MX3(a,b,c) __builtin_fmaxf(__builtin_fmaxf((a),(b)),(c))
  #define GAPA(MF,A0,A1,A2,A3,W0,W1,PW) do{ MF; sacc+=A0; sacc+=A1; sacc+=A2; sacc+=A3; PIN(sacc); if(PROBE==23){float d0_; asm volatile("v_add_f32 %0, %1, %1\n\tv_add_f32 %0, %1, %1\n\tv_add_f32 %0, %1, %1\n\tv_add_f32 %0, %1, %1":"=&v"(d0_):"v"(sacc));} W0; W1; PIN(PW); SBAR(); }while(0)
  #define EX(v) __builtin_amdgcn_exp2f(v)
  #define GAPB(MF,X,B) do{ MF; X[B]=EX(X[B]); X[B+1]=EX(X[B+1]); if(PROBE==21){float d0_,d1_; asm volatile("v_exp_f32 %0, %2\n\tv_exp_f32 %1, %3":"=&v"(d0_),"=&v"(d1_):"v"(X[B]),"v"(X[B+1]));} PIN(X); SBAR(); }while(0)
  #define GAPM(MF,OPS) do{ MF; OPS; SBAR(); }while(0)
  #define MXG(X0,X1,r) mxa=MX3(mxa,X0[r],X0[(r)+1]); mxb=MX3(mxb,X0[(r)+2],X0[(r)+3]); mxa=MX3(mxa,X1[r],X1[(r)+1]); mxb=MX3(mxb,X1[(r)+2],X1[(r)+3]); PIN(mxa); PIN(mxb)
  #define GAPE2(MF,X,i0,i1) do{ MF; X[i0]=EX(X[i0]); X[i1]=EX(X[i1]); PIN(X); SBAR(); }while(0)
  #define GAPE3(MF,X,i0,i1,i2) do{ MF; X[i0]=EX(X[i0]); X[i1]=EX(X[i1]); X[i2]=EX(X[i2]); PIN(X); SBAR(); }while(0)
  #define VRD(i) do{ vlo[i]=vtr(vp_+(((i)>>2)*4096+((i)&3)*1024)); vhi[i]=vtr(vp_+(((i)>>2)*4096+((i)&3)*1024+512)); }while(0)
  #define VRD2(i) do{ vlo[i]=vtr(vp_+(((i)>>2)*4096+8192+((i)&3)*1024)); vhi[i]=vtr(vp_+(((i)>>2)*4096+8192+((i)&3)*1024+512)); SBAR(); }while(0)
  #define KRD(G,j) do{ if(G){ kload2(kf,kp0+sl_next,j); SBAR(); } }while(0)
  #define MF32(a,b,cc) __builtin_amdgcn_mfma_f32_32x32x16_bf16(a,b,cc,0,0,0)
  #define STEP(C0,C1,P0,P1,t,GK,GV,GL) do{ SBAR(); s16x4 vlo[8],vhi[8]; \
    const lds_cptr vp_=vp0+sl_prev; \
    VRD(0); SBAR(); float sacc=(P0[0]+P0[1]); \
    GAPA(C0=MF32(kf[0],qa,negm), P0[2],P0[3],P0[4],P0[5],     pw0[0]=PKW(P0,0), pw0[1]=PKW(P0,2), pw0); \
    VRD(4); SBAR(); GAPA(C1=MF32(kf[1],qa,negm), P0[6],P0[7],P0[8],P0[9],     pw0[2]=PKW(P0,4), pw0[3]=PKW(P0,6), pw0); \
    VRD(1); qa=QF(2); SBAR(); GAPA(C0=MF32(kf[2],qb,C0),   P0[10],P0[11],P0[12],P0[13], pw1[0]=PKW(P0,8), pw1[1]=PKW(P0,10), pw1); \
    VRD(5); SBAR(); GAPA(C1=MF32(kf[3],qb,C1),   P0[14],P0[15],P1[0],P1[1],   pw1[2]=PKW(P0,12),pw1[3]=PKW(P0,14), pw1); \
    VRD(2); qb=QF(3); SBAR(); GAPA(C0=MF32(kf[4],qa,C0),   P1[2],P1[3],P1[4],P1[5],     pw2[0]=PKW(P1,0), pw2[1]=PKW(P1,2), pw2); \
    VRD(6); SBAR(); GAPA(C1=MF32(kf[5],qa,C1),   P1[6],P1[7],P1[8],P1[9],     pw2[2]=PKW(P1,4), pw2[3]=PKW(P1,6), pw2); \
    VRD(3); SBAR(); GAPA(C0=MF32(kf[6],qb,C0),   P1[10],P1[11],P1[12],P1[13], pw3[0]=PKW(P1,8), pw3[1]=PKW(P1,10), pw3); \
    VRD(7); SBAR(); GAPA(C1=MF32(kf[7],qb,C1),   P1[14],P1[15],0.f,0.f,       pw3[2]=PKW(P1,12),pw3[3]=PKW(P1,14), pw3); \
    l_reg+=sacc; \
    float mxa,mxb; SBAR(); \
    GAPM(o[0]=MF32(PAF(0),VFR(0),o[0]), mxa=MX3(C0[0],C0[1],C1[0]); mxb=MX3(C0[2],C0[3],C1[1]); mxa=MX3(mxa,C1[2],C1[3]); PIN(mxa); PIN(mxb));  VRD2(0); \
    GAPM(o[1]=MF32(PAF(0),VFR(4),o[1]), MXG(C0,C1,4));  VRD2(4); if(GK){DMA_KA((t)+3,sl_cur);} \
    GAPM(o[0]=MF32(PAF(1),VFR(1),o[0]), MXG(C0,C1,8));  VRD2(1); \
    GAPM(o[1]=MF32(PAF(1),VFR(5),o[1]), MXG(C0,C1,12)); VRD2(5); \
    { float rm=__builtin_fmaxf(mxa,mxb); { auto rr=__builtin_amdgcn_permlane32_swap(__float_as_uint(rm),__float_as_uint(rm),false,false); rm=__builtin_fmaxf(__uint_as_float(rr[0]),__uint_as_float(rr[1])); } \
      resc=false; \
      if(__builtin_expect(__any(rm>(float)THRL),0)){ const float dl=__builtin_fmaxf(rm,0.f); mhat+=dl; \
        _Pragma("unroll") for(int r=0;r<16;++r){C0[r]-=dl;C1[r]-=dl;} \
        _Pragma("unroll") for(int r=0;r<16;++r)negm[r]=-mhat; asm volatile("":"+v"(negm)); \
        const float f=__builtin_amdgcn_exp2f(-dl); l_reg*=f; if(hi==0)wsf[r32]=f; resc=true; } } \
    SBAR(); \
    GAPE3(o[0]=MF32(PAF(2),VFR(2),o[0]), C0,0,1,2);    VRD2(2); \
    GAPE3(o[1]=MF32(PAF(2),VFR(6),o[1]), C0,3,4,5);    VRD2(6); if(GK){DMA_KB((t)+3,sl_cur);} \
    GAPE2(o[0]=MF32(PAF(3),VFR(3),o[0]), C0,6,7);      VRD2(3); \
    GAPE3(o[1]=MF32(PAF(3),VFR(7),o[1]), C0,8,9,10);   VRD2(7); \
    GAPE3(o[2]=MF32(PAF(0),VFR(0),o[2]), C0,11,12,13); \
    GAPE2(o[3]=MF32(PAF(0),VFR(4),o[3]), C0,14,15); if(GV){DMA_VA((t)+1,sl_next);} \
    KRD(GL,0); GAPE3(o[2]=MF32(PAF(1),VFR(1),o[2]), C1,0,1,2); \
    KRD(GL,1); GAPE3(o[3]=MF32(PAF(1),VFR(5),o[3]), C1,3,4,5); \
    KRD(GL,2); GAPE2(o[2]=MF32(PAF(2),VFR(2),o[2]), C1,6,7); \
    KRD(GL,3); GAPE3(o[3]=MF32(PAF(2),VFR(6),o[3]), C1,8,9,10); if(GV){DMA_VB((t)+1,sl_next);} \
    qa=QF(0); SBAR(); GAPE3(o[2]=MF32(PAF(3),VFR(3),o[2]), C1,11,12,13); \
    qb=QF(1); SBAR(); GAPE2(o[3]=MF32(PAF(3),VFR(7),o[3]), C1,14,15); \
    }while(0)
  bf16x8 qa=QF(0),qb=QF(1);
  int t=1;
  for(;t+5<NT;t+=2){
    STEP(pB0,pB1,pA0,pA1,t,true,true,true);     WB(4,8); RESC(); ROT();
    STEP(pA0,pA1,pB0,pB1,t+1,true,true,true);   WB(4,8); RESC(); ROT();
  }
  #define ENDW(tt) do{ if((tt)+3<NT){WB(4,8);} else if((tt)+2<NT){WB(2,4);} else {WAIT_BAR(0);} }while(0)
  for(;t+1<NT;t+=2){
    STEP(pB0,pB1,pA0,pA1,t,(t+3<NT),(t+1<NT),(t+1<NT));       ENDW(t);   RESC(); ROT();
    STEP(pA0,pA1,pB0,pB1,t+1,(t+4<NT),(t+2<NT),(t+2<NT));     ENDW(t+1); RESC(); ROT();
  }
  STEP(pB0,pB1,pA0,pA1,NT-1,false,false,false); RESC();
  { float sacc=pB0[0]+pB0[1]; _Pragma("unroll") for(int r=2;r<16;++r)sacc+=pB0[r]; _Pragma("unroll") for(int r=0;r<16;++r)sacc+=pB1[r]; l_reg+=sacc;
    pw0=(u32x4){PKW(pB0,0),PKW(pB0,2),PKW(pB0,4),PKW(pB0,6)};pw1=(u32x4){PKW(pB0,8),PKW(pB0,10),PKW(pB0,12),PKW(pB0,14)};pw2=(u32x4){PKW(pB1,0),PKW(pB1,2),PKW(pB1,4),PKW(pB1,6)};pw3=(u32x4){PKW(pB1,8),PKW(pB1,10),PKW(pB1,12),PKW(pB1,14)};
    SBAR(); pv4(o,vb0+sl_cur,PAF(0),PAF(1),PAF(2),PAF(3)); }
  #undef PKW
  #undef PAF
  #undef VFR
  #undef PIN
  #undef MX3
  #undef GAPA
  #undef GAPB
  #undef GAPM
  #undef MXG
  #undef GAPE2
  #undef GAPE3
  #undef EX
  #undef VRD
  #undef VRD2
  #undef KRD
  #undef MF32
  #undef QF
  #undef STEP
  #undef ENDW
  {auto rr=__builtin_amdgcn_permlane32_swap(__float_as_uint(l_reg),__float_as_uint(l_reg),false,false);l_reg=__uint_as_float(rr[0])+__uint_as_float(rr[1]);}
  if(hi==0)wsf[32+r32]=l_reg;asm volatile("s_waitcnt lgkmcnt(0)":::"memory");
  float rli[16];
  #pragma unroll
  for(int r=0;r<16;++r)rli[r]=__builtin_amdgcn_rcpf(wsf[32+crow(r,hi)]);
  asm volatile("s_waitcnt lgkmcnt(0)\n\ts_barrier":::"memory");
  int tide_=threadIdx.x; asm volatile("":"+v"(tide_)); const int lane_e=tide_&63;
  __attribute__((address_space(3))) float*xf=(__attribute__((address_space(3))) float*)((lds_ptr)shm+qg*16384)+lane_e;
  if(c==1){
    #pragma unroll
    for(int d_=0;d_<4;++d_)
      #pragma unroll
      for(int r=0;r<16;++r)xf[(d_*16+r)*64]=o[d_][r]*rli[r];
  }
  asm volatile("s_waitcnt lgkmcnt(0)\n\ts_barrier":::"memory");
  if(c==0){
    float ss[16];
    #pragma unroll
    for(int r=0;r<16;++r)ss[r]=0.f;
    #pragma unroll
    for(int d_=0;d_<4;++d_)
      #pragma unroll
      for(int r=0;r<16;++r){const float v=o[d_][r]*rli[r]-lam*xf[(d_*16+r)*64];o[d_][r]=v;ss[r]+=v*v;}
    #pragma unroll
    for(int r=0;r<16;++r){const float s=half_sum(ss[r]);ss[r]=omli/sqrtf(s*(1.f/128.f)+DEPS);}
    __attribute__((address_space(3))) unsigned short*sb=(__attribute__((address_space(3))) unsigned short*)((lds_ptr)shm+65536+qg*8192);
    #pragma unroll
    for(int d_=0;d_<4;++d_){const float g=subg[d_*32+r32];
      #pragma unroll
      for(int r=0;r<16;++r){const float y=o[d_][r]*ss[r]*g; sb[crow(r,hi)*128+d_*32+r32]=(unsigned short)(cvtpk_s(y,y)&0xffffu);}}
    asm volatile("s_waitcnt lgkmcnt(0)":::"memory");
    bf16*Ow=Ob+(long)(q0+qg*QBLK)*OPITCH;
    #pragma unroll
    for(int i=0;i<8;++i){const int row=i*4+(lane_e>>4),ch=lane_e&15; const u32x4 v=*(const __attribute__((address_space(3))) u32x4*)(sb+row*128+ch*8); ATTN_STORE16(Ow+(long)row*OPITCH+ch*8,v);}
  }
  asm volatile("s_waitcnt lgkmcnt(0)\n\ts_barrier":::"memory");
  #undef DMA_K
  #undef DMA_V
  #undef RFL
  #undef WB
  #undef DMA_K1
  #undef DMA_KA
  #undef DMA_KB
  #undef DMA_VA
  #undef DMA_VB
  #undef DMA_V1
  #undef START
  #undef RESC
  #undef ROT
}

typedef int v4i_a __attribute__((ext_vector_type(4)));
typedef int v8i_a __attribute__((ext_vector_type(8)));
#define CAT8A(a,b) __builtin_shufflevector((a),(b),0,1,2,3,4,5,6,7)
template<int THRL> __device__ __forceinline__ void dattn_unit_f8(const unsigned char*P8,const unsigned char*VTh,int h,bf16*Ob,int q0,float lam,float omli,const float*subg,char*shm){
  constexpr int OPITCH=1024,P8P=1536; constexpr float DEPS=1e-6f; constexpr int NT=SEQ/64; constexpr int SLOT=8192,F_K=0,F_V=3*SLOT,F_WS=6*SLOT;
  int tid_=threadIdx.x; asm volatile("":"+v"(tid_)); const int tid=tid_,lane=tid&63,r32=lane&31,hi=lane>>5; const int wid=__builtin_amdgcn_readfirstlane(tid>>6);
  const int qg=wid>>1,c=wid&1;
  const unsigned lds0=(unsigned)(uintptr_t)shm;
  float*wsf=(float*)(shm+F_WS)+wid*64;
  #define RFL(x) ((unsigned)__builtin_amdgcn_readfirstlane(x))
  const unsigned char*Kg=P8+512+h*128;
  const unsigned kvoff=(unsigned)(lane*P8P+(wid&3)*16+(wid>>2)*64);
  const unsigned vvoff=(unsigned)(((wid>>2)*64+lane)*SEQ+(wid&3)*16);
  const unsigned kdst=lds0+F_K+wid*1024, vdst=lds0+F_V+(wid&3)*2048+(wid>>2)*1024;
  #define DMAK(t,slot) glds16s(Kg+(long)(t)*64*P8P,kvoff,RFL(kdst+(slot)))
  #define DMAV(t,slot) glds16s(VTh+(long)(t)*64,vvoff,RFL(vdst+(slot)))
  v8i_a q8; { const unsigned char*Qp=P8+(long)(q0+qg*32+r32)*P8P+h*128+c*64+hi*32; const v4i_a qa=*(const v4i_a*)Qp, qb=*(const v4i_a*)(Qp+16); q8=CAT8A(qa,qb); }
  DMAK(0,0);DMAV(0,0);DMAK(1,SLOT);DMAV(1,SLOT);
  typedef __attribute__((address_space(3))) const v4i_a* lv4;
  const lds_cptr shm3=(lds_cptr)shm; const lds_cptr kp0=shm3+F_K+c*4096+(2*hi)*1024+r32*16, vp0=shm3+F_V+(2*hi)*2048+r32*16;
  float zf_=0.f; asm volatile("":"+v"(zf_)); f32x16 zz_; _Pragma("unroll") for(int r=0;r<16;++r)zz_[r]=zf_;
  float mhat=0.f; f32x16 o[4]; o[0]=zz_;o[1]=zz_;o[2]=zz_;o[3]=zz_; f32x16 lacc=zz_; f32x16 negm=zz_; asm volatile("":"+v"(negm));
  v8i_a ones; { int on_=0x38383838; asm volatile("":"+v"(on_)); _Pragma("unroll") for(int j=0;j<8;++j)ones[j]=on_; }
  #define MFQK(C,KF) asm volatile("v_mfma_f32_32x32x64_f8f6f4 %0, %1, %2, %3":"=&v"(C):"v"(KF),"v"(q8),"v"(negm))
  #define MFPV(O,VF) asm volatile("v_mfma_f32_32x32x64_f8f6f4 %0, %1, %2, %0":"+v"(O):"v"(pw),"v"(VF))
  #define KFRAG(kp) const v8i_a kf0=CAT8A(*(lv4)(kp),*(lv4)((kp)+1024)), kf1=CAT8A(*(lv4)((kp)+512),*(lv4)((kp)+1536))
  #define VFRAG(vp) do{ vf0=CAT8A(*(lv4)(vp),*(lv4)((vp)+2048)); vf1=CAT8A(*(lv4)((vp)+512),*(lv4)((vp)+2560)); vf2=CAT8A(*(lv4)((vp)+1024),*(lv4)((vp)+3072)); vf3=CAT8A(*(lv4)((vp)+1536),*(lv4)((vp)+3584)); }while(0)
  #define SOFTMAX(FIRST,WAITO) do{ const float rm=rowmax(C0,C1); \
    if((FIRST)||__any(rm>(float)THRL)){ const float dl=(FIRST)?rm:__builtin_fmaxf(rm,0.f); mhat+=dl; \
      _Pragma("unroll") for(int r=0;r<16;++r){C0[r]-=dl;C1[r]-=dl;} \
      _Pragma("unroll") for(int r=0;r<16;++r)negm[r]=-mhat; asm volatile("":"+v"(negm)); \
      if(!(FIRST)){ const float f=__builtin_amdgcn_exp2f(-dl); if(hi==0)wsf[r32]=f; \
        if(WAITO){ _Pragma("unroll") for(int rep_=0;rep_<(WAITO);++rep_) asm volatile("s_nop 15\n\ts_nop 15\n\ts_nop 15\n\ts_nop 15\n\ts_nop 15\n\ts_nop 15":"+v"(o[0]),"+v"(o[1]),"+v"(o[2]),"+v"(o[3]),"+v"(lacc)); } \
        asm volatile("s_waitcnt lgkmcnt(0)":::"memory"); \
        _Pragma("unroll") for(int r=0;r<16;++r){ const float fr_=wsf[crow(r,hi)]; o[0][r]*=fr_; o[1][r]*=fr_; o[2][r]*=fr_; o[3][r]*=fr_; lacc[r]*=fr_; } } } \
    _Pragma("unroll") for(int r=0;r<16;++r){C0[r]=__builtin_amdgcn_exp2f(C0[r]);C1[r]=__builtin_amdgcn_exp2f(C1[r]);} \
    _Pragma("unroll") for(int j=0;j<4;++j){ int w0=0,w1=0; \
      w0=__builtin_amdgcn_cvt_pk_fp8_f32(C0[4*j],C0[4*j+1],w0,false); w0=__builtin_amdgcn_cvt_pk_fp8_f32(C0[4*j+2],C0[4*j+3],w0,true); \
      w1=__builtin_amdgcn_cvt_pk_fp8_f32(C1[4*j],C1[4*j+1],w1,false); w1=__builtin_amdgcn_cvt_pk_fp8_f32(C1[4*j+2],C1[4*j+3],w1,true); \
      pw[j]=w0; pw[4+j]=w1; } }while(0)
  #define DRAIN() do{ float d_=lacc[15]; asm volatile("v_mov_b32 %0, %0":"+v"(d_),"+v"(C0),"+v"(C1)::"memory"); }while(0)
  v8i_a pw,vf0,vf1,vf2,vf3; f32x16 C0,C1;
  int sl=0,sl2=2*SLOT;
  #define ROTS() do{ sl=(sl==2*SLOT)?0:sl+SLOT; sl2=(sl2==2*SLOT)?0:sl2+SLOT; }while(0)
  if(wid<LEAD_WAVES){
    WAIT_BAR(2); DMAK(2,sl2);DMAV(2,sl2);
    { KFRAG(kp0); MFQK(C0,kf0); MFQK(C1,kf1); VFRAG(vp0); asm volatile("s_nop 15\n\ts_nop 15":"+v"(C0),"+v"(C1)); SOFTMAX(true,0); }
    ROTS();
    #pragma unroll 1
    for(int t=1;t<NT;++t){
      if(t+1<NT){WAIT_BAR(2);}else{WAIT_BAR(0);}
      if(t+2<NT){DMAK(t+2,sl2);DMAV(t+2,sl2);}
      { KFRAG(kp0+sl); MFQK(C0,kf0); MFQK(C1,kf1); }
      MFPV(o[0],vf0); SBAR();
      asm volatile("":"+v"(C0));
      float ma=max3f(C0[0],C0[1],C0[2]); ma=max3f(ma,C0[3],C0[4]); ma=max3f(ma,C0[5],C0[6]); ma=max3f(ma,C0[7],C0[8]); ma=max3f(ma,C0[9],C0[10]); ma=max3f(ma,C0[11],C0[12]); ma=max3f(ma,C0[13],C0[14]); ma=max2f(ma,C0[15]);
      SBAR(); MFPV(o[1],vf1); SBAR();
      asm volatile("":"+v"(C1));
      float mb=max3f(C1[0],C1[1],C1[2]); mb=max3f(mb,C1[3],C1[4]); mb=max3f(mb,C1[5],C1[6]); mb=max3f(mb,C1[7],C1[8]); mb=max3f(mb,C1[9],C1[10]); mb=max3f(mb,C1[11],C1[12]); mb=max3f(mb,C1[13],C1[14]); mb=max3f(mb,C1[15],ma);
      float rm; { auto rr=__builtin_amdgcn_permlane32_swap(__float_as_uint(mb),__float_as_uint(mb),false,false); rm=max2f(__uint_as_float(rr[0]),__uint_as_float(rr[1])); }
      SBAR(); MFPV(o[2],vf2); SBAR();
      _Pragma("unroll") for(int r=0;r<8;++r)C0[r]=__builtin_amdgcn_exp2f(C0[r]);
      SBAR(); MFPV(o[3],vf3); SBAR();
      _Pragma("unroll") for(int r=8;r<16;++r)C0[r]=__builtin_amdgcn_exp2f(C0[r]);
      SBAR(); MFPV(lacc,ones); SBAR();
      _Pragma("unroll") for(int r=0;r<16;++r)C1[r]=__builtin_amdgcn_exp2f(C1[r]);
      if(__any(rm>(float)THRL)){ const float dl=__builtin_fmaxf(rm,0.f); mhat+=dl;
        _Pragma("unroll") for(int r=0;r<16;++r)negm[r]=-mhat; asm volatile("":"+v"(negm));
        const float f=__builtin_amdgcn_exp2f(-dl); if(hi==0)wsf[r32]=f;
        _Pragma("unroll") for(int r=0;r<16;++r){C0[r]*=f;C1[r]*=f;}
        _Pragma("unroll") for(int rep_=0;rep_<RESC_NOPS;++rep_) asm volatile("s_nop 15\n\ts_nop 15\n\ts_nop 15\n\ts_nop 15\n\ts_nop 15\n\ts_nop 15":"+v"(o[0]),"+v"(o[1]),"+v"(o[2]),"+v"(o[3]),"+v"(lacc));
        asm volatile("s_waitcnt lgkmcnt(0)":::"memory");
        _Pragma("unroll") for(int r=0;r<16;++r){ const float fr_=wsf[crow(r,hi)]; o[0][r]*=fr_; o[1][r]*=fr_; o[2][r]*=fr_; o[3][r]*=fr_; lacc[r]*=fr_; } }
      _Pragma("unroll") for(int j=0;j<4;++j){ int w0=0,w1=0;
        w0=__builtin_amdgcn_cvt_pk_fp8_f32(C0[4*j],C0[4*j+1],w0,false); w0=__builtin_amdgcn_cvt_pk_fp8_f32(C0[4*j+2],C0[4*j+3],w0,true);
        w1=__builtin_amdgcn_cvt_pk_fp8_f32(C1[4*j],C1[4*j+1],w1,false); w1=__builtin_amdgcn_cvt_pk_fp8_f32(C1[4*j+2],C1[4*j+3],w1,true);
        pw[j]=w0; pw[4+j]=w1; }
      VFRAG(vp0+sl);
      ROTS();
    }
    asm volatile("s_waitcnt lgkmcnt(0)":::"memory");
    MFPV(o[0],vf0); MFPV(o[1],vf1); MFPV(o[2],vf2); MFPV(o[3],vf3); MFPV(lacc,ones);
  } else {
    WAIT_BAR(2); DMAK(2,sl2);DMAV(2,sl2);
    { KFRAG(kp0); MFQK(C0,kf0); MFQK(C1,kf1); VFRAG(vp0); asm volatile("s_nop 15\n\ts_nop 15":"+v"(C0),"+v"(C1)); SOFTMAX(true,0); }
    MFPV(o[0],vf0); MFPV(o[1],vf1); MFPV(o[2],vf2); MFPV(o[3],vf3); MFPV(lacc,ones);
    ROTS();
    #pragma unroll 1
    for(int t=1;t<NT;++t){
      if(t+1<NT){WAIT_BAR(2);}else{WAIT_BAR(0);}
      if(t+2<NT){DMAK(t+2,sl2);DMAV(t+2,sl2);}
      { KFRAG(kp0+sl); MFQK(C0,kf0); MFQK(C1,kf1); }
      VFRAG(vp0+sl);
      asm volatile("s_nop 15\n\ts_nop 15":"+v"(C0),"+v"(C1));
      SOFTMAX(false,1);
      MFPV(o[0],vf0); MFPV(o[1],vf1); MFPV(o[2],vf2); MFPV(o[3],vf3); MFPV(lacc,ones);
      ROTS();
    }
  }
  asm volatile("s_nop 15\n\ts_nop 15\n\ts_nop 15\n\ts_nop 15\n\ts_nop 15\n\ts_nop 15":"+v"(o[0]),"+v"(o[1]),"+v"(o[2]),"+v"(o[3]),"+v"(lacc));
  #undef MFQK
  #undef MFPV
  #undef KFRAG
  #undef VFRAG
  #undef SOFTMAX
  #undef ROTS
  #undef DRAIN
  float rli[16];
  #pragma unroll
  for(int r=0;r<16;++r)rli[r]=__builtin_amdgcn_rcpf(lacc[r]);
  asm volatile("s_waitcnt lgkmcnt(0)\n\ts_barrier":::"memory");
  int tide_=threadIdx.x; asm volatile("":"+v"(tide_)); const int lane_e=tide_&63;
  __attribute__((address_space(3))) float*xf=(__attribute__((address_space(3))) float*)((lds_ptr)shm+qg*16384)+lane_e;
  if(c==1){
    #pragma unroll
    for(int d_=0;d_<4;++d_)
      #pragma unroll
      for(int r=0;r<16;++r)xf[(d_*16+r)*64]=o[d_][r]*rli[r];
  }
  asm volatile("s_waitcnt lgkmcnt(0)\n\ts_barrier":::"memory");
  if(c==0){
    float ss[16];
    #pragma unroll
    for(int r=0;r<16;++r)ss[r]=0.f;
    #pragma unroll
    for(int d_=0;d_<4;++d_)
      #pragma unroll
      for(int r=0;r<16;++r){const float v=o[d_][r]*rli[r]-lam*xf[(d_*16+r)*64];o[d_][r]=v;ss[r]+=v*v;}
    #pragma unroll
    for(int r=0;r<16;++r){const float s=half_sum(ss[r]);ss[r]=omli/sqrtf(s*(1.f/128.f)+DEPS);}
    __attribute__((address_space(3))) unsigned short*sb=(__attribute__((address_space(3))) unsigned short*)((lds_ptr)shm+65536+qg*8192);
    #pragma unroll
    for(int d_=0;d_<4;++d_){const float g=subg[d_*32+r32];
      #pragma unroll
      for(int r=0;r<16;++r){const float y=o[d_][r]*ss[r]*g; sb[crow(r,hi)*128+d_*32+r32]=(unsigned short)(cvtpk_s(y,y)&0xffffu);}}
    asm volatile("s_waitcnt lgkmcnt(0)":::"memory");
    bf16*Ow=Ob+(long)(q0+qg*QBLK)*OPITCH;
    #pragma unroll
    for(int i=0;i<8;++i){const int row=i*4+(lane_e>>4),ch=lane_e&15; const u32x4 v=*(const __attribute__((address_space(3))) u32x4*)(sb+row*128+ch*8); ATTN_STORE16(Ow+(long)row*OPITCH+ch*8,v);}
  }
  asm volatile("s_waitcnt lgkmcnt(0)\n\ts_barrier":::"memory");
  #undef RFL
  #undef DMAK
  #undef DMAV
}
#undef CAT8A
constexpr int ATTN_LDS_BYTES=LDS_BYTES;
#undef SBAR
#undef WAIT_BAR
}

constexpr size_t MiB = 1u << 20;
constexpr size_t WS_CTL = 0, CTL_ZERO_BYTES = 1 * MiB;
constexpr size_t WS_MOD = 1 * MiB;
constexpr size_t WS_RC = 2 * MiB, WS_RS = 4 * MiB;
constexpr size_t WS_ROUTE = 6 * MiB, ROUTE_LAYER = 1024 * 1024;
constexpr size_t WS_WIN = 8 * MiB, WS_WOUT = 26 * MiB, WS_WGU_D = 34 * MiB, WS_WD_D = 62 * MiB, WS_WGU_M = 76 * MiB, WS_WD_M = 300 * MiB;
constexpr size_t WS_HA = 412 * MiB;
constexpr size_t WS_PROJ = 444 * MiB;
constexpr size_t WS_ATT = 516 * MiB;
constexpr size_t WS_PROJ8 = 548 * MiB;
constexpr size_t WS_VT = 576 * MiB;
constexpr size_t WS_OD = 548 * MiB;
constexpr size_t WS_HMID = 444 * MiB;
constexpr size_t WS_XS = 682 * MiB;
constexpr size_t WS_XB = 682 * MiB;
constexpr size_t WS_YSP = 716 * MiB;
constexpr size_t WS_YS = 750 * MiB;
constexpr size_t WS_END = 818 * MiB;
static_assert(WS_WD_M + (size_t)2 * NE * DM * FF * 2 <= WS_HA && WS_HMID + (size_t)PMAX * FF * 2 <= WS_XS && WS_XS + (size_t)PMAX * DM * 2 <= WS_YS && WS_YS + (size_t)PMAX * DM * 2 <= WS_END, "d_ws map");
static_assert(WS_XB + (size_t)NTOK * DM * 2 <= WS_YSP && WS_YSP + (size_t)6 * pg8::TAILROWS * DM * 2 <= WS_YS, "d_ws map 3");
static_assert(WS_OD + (size_t)2 * NTOK * 512 * 2 <= WS_HMID + (size_t)NTOK * FF * 2 + 200 * MiB, "d_ws map 2");
constexpr int CW_BAR = 4096;
constexpr int CW_IPDONE = 8192 + 1100;
constexpr int CW_QCTR = 8192 + 1024;
constexpr int CW_CNT = 8192;

constexpr int RING_OFF = 0, RING_BYTES = 135168;
constexpr int LDSCTL_OFF = RING_BYTES, MISC_OFF = LDSCTL_OFF + 320;
constexpr int TAB_OFF = MISC_OFF + 128;
constexpr int IDX_OFF = TAB_OFF + 4 * 176, IDX_UNITS = 16;
constexpr int LDS_BYTES = 155648;
static_assert(16 + NCHUNK_MAX <= 160 && IDX_OFF + IDX_UNITS * 1024 <= LDS_BYTES && (NCHUNK_MAX * (2 * FF / 256) + 255) / 256 <= IDX_UNITS && 8 * 64 * 65 * 4 <= RING_BYTES, "LDS map");

#define GAS __attribute__((address_space(1)))
#define LAS __attribute__((address_space(3)))
typedef unsigned short bf16;
typedef unsigned v4u __attribute__((ext_vector_type(4)));
typedef float f32x4 __attribute__((ext_vector_type(4)));
typedef short bf16x8 __attribute__((ext_vector_type(8)));
typedef GAS unsigned gu32;
typedef GAS unsigned long long gu64;
#define RLX_AGENT __ATOMIC_RELAXED, __HIP_MEMORY_SCOPE_AGENT
#define LDS_WAIT() asm volatile("s_waitcnt lgkmcnt(0)" ::: "memory")
#define VM_WAIT() asm volatile("s_waitcnt vmcnt(0)" ::: "memory")
__device__ __forceinline__ unsigned long long rt() { return __builtin_amdgcn_s_memrealtime(); }
__device__ __forceinline__ unsigned f2bf(float f) { unsigned u = __builtin_bit_cast(unsigned, f); return (u + 0x7fffu + ((u >> 16) & 1u)) >> 16; }
__device__ __forceinline__ unsigned pk2(float lo, float hi) { return f2bf(lo) | (f2bf(hi) << 16); }

#define XB_TMO      128
#define XB_XCNT(j)  (256  + 64 * (j))
#define XB_XSUB(j)  (1280 + 64 * (j))
#define XB_XGEN(j)  (2304 + 64 * (j))
#define XB_TOP      3328
#define XB_TOPGEN   3392
#define XCD_BAR_WORDS 3456
#define XB_SPIN_CAP (1u << 18)

__device__ __forceinline__ unsigned xb_ld(GAS unsigned* p)          { return __hip_atomic_load(p, __ATOMIC_RELAXED, __HIP_MEMORY_SCOPE_AGENT); }
__device__ __forceinline__ unsigned xb_add(GAS unsigned* p, unsigned v) { return __hip_atomic_fetch_add(p, v, __ATOMIC_RELAXED, __HIP_MEMORY_SCOPE_AGENT); }
__device__ __forceinline__ unsigned xb_xcc_id() { return (unsigned)__builtin_amdgcn_s_getreg((3 << 11) | 20) & 0xFu; }
#define XB_SPIN(cond, bar) do { unsigned _sp = 0; while (cond) { __builtin_amdgcn_s_sleep(1); \
    if ((++_sp & 255u) == 0u) { if (xb_ld(&(bar)[XB_TMO])) break; if (_sp > XB_SPIN_CAP) { (void)xb_add(&(bar)[XB_TMO], 1u); break; } } } } while (0)

struct XcdBarrier {
    unsigned* bar; unsigned x;
    volatile LAS unsigned* st;
};

__device__ __forceinline__ XcdBarrier xcd_barrier_post(unsigned* bar, volatile LAS unsigned* st) {
    XcdBarrier b; b.bar = bar; b.x = xb_xcc_id(); b.st = st;
    if (threadIdx.x == 0) (void)xb_add((GAS unsigned*)bar + XB_XCNT(b.x), 1u);
    return b;
}
__device__ __forceinline__ void xcd_barrier_complete(GAS unsigned* bar, unsigned x, unsigned& nloc, unsigned& nx) {
    const unsigned G = gridDim.x * gridDim.y * gridDim.z;
    unsigned sum, cnt, mine, sp = 0u;
    for (;;) {
        sum = 0u; cnt = 0u; mine = 0u;
#pragma unroll
        for (unsigned j = 0; j < 16; ++j) { const unsigned c = xb_ld(&bar[XB_XCNT(j)]); sum += c; cnt += (c > 0u) ? 1u : 0u; mine = (j == x) ? c : mine; }
        if (sum == G) break;
        __builtin_amdgcn_s_sleep(1);
        if ((++sp & 255u) == 0u) { if (xb_ld(&bar[XB_TMO])) break; if (sp > XB_SPIN_CAP) { (void)xb_add(&bar[XB_TMO], 1u); break; } }
    }
    nloc = mine > 0u ? mine : 1u; nx = cnt > 0u ? cnt : 1u;
}

__device__ __forceinline__ void xcd_barrier(const XcdBarrier& b) {
    asm volatile("s_waitcnt vmcnt(0)" ::: "memory");
    __syncthreads();
    if (threadIdx.x == 0) {
        GAS unsigned* bar = (GAS unsigned*)b.bar; unsigned bx_ = b.x; asm volatile("" : "+s"(bar), "+s"(bx_));
        __builtin_amdgcn_s_waitcnt(0);
        unsigned nloc = b.st[0], nx = b.st[1];
        if (nloc == 0u) { xcd_barrier_complete(bar, bx_, nloc, nx); b.st[0] = nloc; b.st[1] = nx; }
        const unsigned old = xb_add(&bar[XB_XSUB(bx_)], 1u);
        const unsigned gen = old / nloc;
        if (old + 1u == (gen + 1u) * nloc) {
            __builtin_amdgcn_fence(__ATOMIC_RELEASE, "agent");
            asm volatile("s_waitcnt vmcnt(0)" ::: "memory");
            const unsigned og = xb_add(&bar[XB_TOP], 1u);
            const unsigned tg = og / nx;
            if (og + 1u == (tg + 1u) * nx) xb_add(&bar[XB_TOPGEN], 1u);
            else XB_SPIN(xb_ld(&bar[XB_TOPGEN]) == tg, bar);
            __builtin_amdgcn_fence(__ATOMIC_ACQUIRE, "agent");
            xb_add(&bar[XB_XGEN(bx_)], 1u);
            asm volatile("s_waitcnt vmcnt(0)" ::: "memory");
        } else {
            XB_SPIN(xb_ld(&bar[XB_XGEN(bx_)]) == gen, bar);
            __builtin_amdgcn_fence(__ATOMIC_ACQUIRE, "agent");
            asm volatile("s_waitcnt vmcnt(0)" ::: "memory");
        }
    }
    __syncthreads();
}


constexpr int NWAVES = 8;
struct Frame {
    LAS unsigned char* lds;
    volatile LAS unsigned* MISC;
    gu32* ctl;
    int tid, lane, wave;
    int vcu, G;
};
__device__ __forceinline__ float wave_sum(float v) {
#define WS_DPP(ctrl) v += __builtin_bit_cast(float, __builtin_amdgcn_update_dpp(0, __builtin_bit_cast(int, v), ctrl, 0xF, 0xF, true))
    WS_DPP(0xB1); WS_DPP(0x4E); WS_DPP(0x141); WS_DPP(0x140);
#undef WS_DPP
    v += __builtin_bit_cast(float, __builtin_amdgcn_ds_swizzle(__builtin_bit_cast(int, v), 0x401F));
    const auto rr = __builtin_amdgcn_permlane32_swap(__builtin_bit_cast(unsigned, v), __builtin_bit_cast(unsigned, v), false, false);
    return __uint_as_float(rr[0]) + __uint_as_float(rr[1]);
}
__device__ __forceinline__ void sincos_acc(float angf, float& s, float& c) {
    const double a = (double)angf;
    const double k = rint(a * 0.63661977236758134308);
    double r = fma(-k, 1.57079632679489655800e+00, a); r = fma(-k, 6.12323399573676603587e-17, r);
    const double r2 = r * r;
    double sp = -2.5052108385441718775e-08; sp = sp * r2 + 2.7557319223985890653e-06; sp = sp * r2 - 1.9841269841269841253e-04; sp = sp * r2 + 8.3333333333333332177e-03; sp = sp * r2 - 1.6666666666666665741e-01;
    const double sn = r + r * r2 * sp;
    double cp = 2.0876756987868098979e-09; cp = cp * r2 - 2.7557319223985888e-07; cp = cp * r2 + 2.4801587301587301566e-05; cp = cp * r2 - 1.3888888888888889419e-03; cp = cp * r2 + 4.1666666666666664354e-02; cp = cp * r2 - 0.5;
    const double cs = 1.0 + r2 * cp;
    const int q = ((int)k) & 3;
    const double ss = (q == 0) ? sn : (q == 1) ? cs : (q == 2) ? -sn : -cs;
    const double cc = (q == 0) ? cs : (q == 1) ? -sn : (q == 2) ? -cs : sn;
    s = (float)ss; c = (float)cc;
}

template <int MAP> __device__ __forceinline__ int rowmap(int n) {
    if (MAP == 1) { const bool rope = (n < COL_VA) || (n >= COL_QD && n < COL_VD); if (!rope) return n; const int d = n & 63; return (n & ~63) + ((d < 32) ? 2 * d : 2 * (d - 32) + 1); }
    if (MAP == 2) return ((n >> 7) << 8) + (n & 127);
    if (MAP == 3) return ((n >> 7) << 8) + 128 + (n & 127);
    return n;
}
template <int MAP, bool F8 = false> __device__ __forceinline__ void cvt_item(const float* W, int K, int N, bf16* WT, LAS float* scr, int item, int lane, float f8s = 1.f) {
    const int kblk = K >> 6, nb = item / kblk, kb = item - nb * kblk, k0 = kb * 64, n0 = nb * 64;
    const GAS float* src = (const GAS float*)W + (size_t)k0 * N + n0 + lane;
    float tv[64];
#pragma unroll
    for (int kk = 0; kk < 64; ++kk) tv[kk] = __builtin_nontemporal_load(src + (size_t)kk * N);
#pragma unroll
    for (int kk = 0; kk < 64; ++kk) scr[kk * 65 + lane] = tv[kk];
    LDS_WAIT(); asm volatile("" ::: "memory");
    const int c = lane & 7;
#pragma unroll
    for (int j = 0; j < 8; ++j) { const int n = (lane >> 3) + 8 * j; const LAS float* s = scr + (8 * c) * 65 + n;
        if (F8) { const unsigned long long o8 = (unsigned long long)pg8::pack4_fp8(s[0 * 65] * f8s, s[1 * 65] * f8s, s[2 * 65] * f8s, s[3 * 65] * f8s) | ((unsigned long long)pg8::pack4_fp8(s[4 * 65] * f8s, s[5 * 65] * f8s, s[6 * 65] * f8s, s[7 * 65] * f8s) << 32);
            *(GAS unsigned long long*)((GAS unsigned char*)WT + (size_t)rowmap<MAP>(n0 + n) * K + k0 + 8 * c) = o8; }
        else { v4u o; o.x = pk2(s[0 * 65], s[1 * 65]); o.y = pk2(s[2 * 65], s[3 * 65]); o.z = pk2(s[4 * 65], s[5 * 65]); o.w = pk2(s[6 * 65], s[7 * 65]);
            *(GAS v4u*)(WT + (size_t)rowmap<MAP>(n0 + n) * K + k0 + 8 * c) = o; } }
    LDS_WAIT(); asm volatile("" ::: "memory");
}
constexpr int IT_IN = (DM / 64) * (INC / 64)  , IT_OUT = (DM / 64) * (DM / 64)  , IT_FF = (DM / 64) * (FF / 64)  ;
constexpr int IT_A = DEPTH * IT_IN, IT_B = IT_A + DEPTH * IT_OUT, IT_SET = 3 * IT_FF, NITEMS = IT_B + 18 * IT_SET;
struct Ptrs {
    const float* in[23]; float* out; unsigned char* ws;
};
struct RopeFreq { float inv[32]; };
struct Args { Ptrs p; RopeFreq rf; float lam_init[4]; int ph_lo, ph_hi; };
typedef const __attribute__((address_space(4))) Args* CArgs;
__device__ __forceinline__ CArgs kargs() { CArgs a = (CArgs)__builtin_amdgcn_kernarg_segment_ptr(); asm volatile("" : "+s"(a)); return a; }
__device__ __forceinline__ void convert_item(CArgs ka, int it, LAS float* scr, int lane) {
    const auto& P = ka->p; unsigned char* ws = P.ws;
    if (it < IT_A) { const int l = it / IT_IN, r = it - l * IT_IN; if (pg8::F8_IN) cvt_item<1, true>(P.in[7] + (size_t)l * DM * INC, DM, INC, (bf16*)(ws + WS_WIN + (size_t)l * INC * DM), scr, r, lane, pg8::F8_SW1); else cvt_item<1>(P.in[7] + (size_t)l * DM * INC, DM, INC, (bf16*)(ws + WS_WIN) + (size_t)l * INC * DM, scr, r, lane); return; }
    if (it < IT_B) { it -= IT_A; const int l = it / IT_OUT, r = it - l * IT_OUT; cvt_item<0>(P.in[8] + (size_t)l * DM * DM, DM, DM, (bf16*)(ws + WS_WOUT) + (size_t)l * DM * DM, scr, r, lane); return; }
    it -= IT_B; const int set = it / IT_SET; int r = it - set * IT_SET; const int kind = r / IT_FF; r -= kind * IT_FF;
    const float *wg, *wu, *wd; bf16 *dgu, *dd;
    bool f1, f2;
    if (set < 2) { f1 = pg8::F8_D1; f2 = pg8::F8_D2; const size_t o = (size_t)set * DM * FF; wg = P.in[15] + o; wu = P.in[16] + o; wd = P.in[17] + o; dgu = (bf16*)(ws + WS_WGU_D + (size_t)set * 2 * FF * DM * (f1 ? 1 : 2)); dd = (bf16*)(ws + WS_WD_D + (size_t)set * DM * FF * (f2 ? 1 : 2)); }
    else { f1 = pg8::F8_M1; f2 = pg8::F8_M2; const size_t o = (size_t)(set - 2) * DM * FF; wg = P.in[19] + o; wu = P.in[20] + o; wd = P.in[21] + o; dgu = (bf16*)(ws + WS_WGU_M + (size_t)(set - 2) * 2 * FF * DM * (f1 ? 1 : 2)); dd = (bf16*)(ws + WS_WD_M + (size_t)(set - 2) * DM * FF * (f2 ? 1 : 2)); }
    if (kind == 0) { if (f1) cvt_item<2, true>(wg, DM, FF, dgu, scr, r, lane, pg8::F8_SW1); else cvt_item<2>(wg, DM, FF, dgu, scr, r, lane); }
    else if (kind == 1) { if (f1) cvt_item<3, true>(wu, DM, FF, dgu, scr, r, lane, pg8::F8_SW1); else cvt_item<3>(wu, DM, FF, dgu, scr, r, lane); }
    else { if (f2) cvt_item<0, true>(wd, FF, DM, dd, scr, r, lane, pg8::F8_SW2); else cvt_item<0>(wd, FF, DM, dd, scr, r, lane); }
}
__device__ __forceinline__ void mod_item(const Frame& F, CArgs ka, int it) {
    const auto& P = ka->p;
    const int l = it / (MODB / 64), cg = it - l * (MODB / 64), col = cg * 64 + F.lane, k0 = F.wave * 128;
    const GAS float* w = (const GAS float*)P.in[3] + (size_t)l * DM * MODB + (size_t)k0 * MODB + col; const float* c = P.in[1] + k0;
    float a0 = 0.f, a1 = 0.f;
#pragma unroll 32
    for (int k = 0; k < 128; ++k) { const float wv = w[(size_t)k * MODB]; const float c0 = c[k], c1 = c[DM + k];
        a0 += (c0 / (1.f + __expf(-c0))) * wv; a1 += (c1 / (1.f + __expf(-c1))) * wv; }
    LAS float* red = (LAS float*)(F.lds + RING_OFF);
    red[(F.wave * 2 + 0) * 64 + F.lane] = a0; red[(F.wave * 2 + 1) * 64 + F.lane] = a1;
    __syncthreads();
    if (F.wave < 2) { float t = P.in[4][l * MODB + col];
#pragma unroll
        for (int w8 = 0; w8 < 8; ++w8) t += red[(w8 * 2 + F.wave) * 64 + F.lane];
        ((float*)(P.ws + WS_MOD))[((size_t)l * 2 + F.wave) * MODB + col] = t; }
    __syncthreads();
}
constexpr int PRO_ITEMS = IT_IN + IT_OUT + IT_SET;
constexpr int Q1 = IT_IN, Q2 = Q1 + IT_OUT, Q3 = Q2 + 8 * IT_SET, Q4 = Q3 + IT_IN, Q5 = Q4 + IT_OUT, Q6 = Q5 + IT_SET, Q7 = Q6 + IT_IN, Q8 = Q7 + IT_OUT, QEND = Q8 + 8 * IT_SET;
constexpr int Q3A = Q2 + 8 * 2 * IT_FF, Q8A = Q8 + 8 * 2 * IT_FF;
static_assert(QEND + PRO_ITEMS == NITEMS, "queue covers every item once");
__device__ __forceinline__ int pro_item(int p) { return p < IT_IN ? p : (p < IT_IN + IT_OUT ? IT_A + (p - IT_IN) : IT_B + (p - IT_IN - IT_OUT)); }
__device__ __forceinline__ int qitem(int q) {
    if (q < Q1) return 1 * IT_IN + q;
    if (q < Q2) return IT_A + 1 * IT_OUT + (q - Q1);
    if (q < Q3) { const int m = q - Q2; if (m < 8 * 2 * IT_FF) return IT_B + (2 + m / (2 * IT_FF)) * IT_SET + m % (2 * IT_FF);
        const int d = m - 8 * 2 * IT_FF; return IT_B + (2 + d / IT_FF) * IT_SET + 2 * IT_FF + d % IT_FF; }
    if (q < Q4) return 2 * IT_IN + (q - Q3);
    if (q < Q5) return IT_A + 2 * IT_OUT + (q - Q4);
    if (q < Q6) return IT_B + 1 * IT_SET + (q - Q5);
    if (q < Q7) return 3 * IT_IN + (q - Q6);
    if (q < Q8) return IT_A + 3 * IT_OUT + (q - Q7);
    { const int m = q - Q8; if (m < 8 * 2 * IT_FF) return IT_B + (10 + m / (2 * IT_FF)) * IT_SET + m % (2 * IT_FF);
      const int d = m - 8 * 2 * IT_FF; return IT_B + (10 + d / IT_FF) * IT_SET + 2 * IT_FF + d % IT_FF; }
}
struct CvtJob { const float* src; bf16* WT; int K, N, n0, k0, map; bool valid; float f8s; };
__device__ __forceinline__ CvtJob make_job(CArgs ka, int q) {
    CvtJob j; j.valid = q < QEND; j.src = nullptr; j.WT = nullptr; j.K = DM; j.N = DM; j.n0 = 0; j.k0 = 0; j.map = 0; j.f8s = 0.f; if (!j.valid) return j;
    const auto& P = ka->p; unsigned char* ws = P.ws; int it = qitem(q), r;
    if (it < IT_A) { const int l = it / IT_IN; r = it - l * IT_IN; j.src = P.in[7] + (size_t)l * DM * INC; j.K = DM; j.N = INC; j.WT = (bf16*)(ws + WS_WIN + (size_t)l * INC * DM * (pg8::F8_IN ? 1 : 2)); j.map = 1; j.f8s = pg8::F8_IN ? pg8::F8_SW1 : 0.f; }
    else if (it < IT_B) { it -= IT_A; const int l = it / IT_OUT; r = it - l * IT_OUT; j.src = P.in[8] + (size_t)l * DM * DM; j.K = DM; j.N = DM; j.WT = (bf16*)(ws + WS_WOUT) + (size_t)l * DM * DM; j.map = 0; }
    else { it -= IT_B; const int set = it / IT_SET; r = it - set * IT_SET; const int kind = r / IT_FF; r -= kind * IT_FF;
        const float *wg, *wu, *wd; bf16 *dgu, *dd;
        bool f1, f2;
        if (set < 2) { f1 = pg8::F8_D1; f2 = pg8::F8_D2; const size_t o = (size_t)set * DM * FF; wg = P.in[15] + o; wu = P.in[16] + o; wd = P.in[17] + o; dgu = (bf16*)(ws + WS_WGU_D + (size_t)set * 2 * FF * DM * (f1 ? 1 : 2)); dd = (bf16*)(ws + WS_WD_D + (size_t)set * DM * FF * (f2 ? 1 : 2)); }
        else { f1 = pg8::F8_M1; f2 = pg8::F8_M2; const size_t o = (size_t)(set - 2) * DM * FF; wg = P.in[19] + o; wu = P.in[20] + o; wd = P.in[21] + o; dgu = (bf16*)(ws + WS_WGU_M + (size_t)(set - 2) * 2 * FF * DM * (f1 ? 1 : 2)); dd = (bf16*)(ws + WS_WD_M + (size_t)(set - 2) * DM * FF * (f2 ? 1 : 2)); }
        if (kind == 0) { j.src = wg; j.K = DM; j.N = FF; j.WT = dgu; j.map = 2; j.f8s = f1 ? pg8::F8_SW1 : 0.f; } else if (kind == 1) { j.src = wu; j.K = DM; j.N = FF; j.WT = dgu; j.map = 3; j.f8s = f1 ? pg8::F8_SW1 : 0.f; } else { j.src = wd; j.K = FF; j.N = DM; j.WT = dd; j.map = 0; j.f8s = f2 ? pg8::F8_SW2 : 0.f; } }
    const int kblk = j.K >> 6, nb = r / kblk, kb = r - nb * kblk; j.k0 = kb * 64; j.n0 = nb * 64;
    return j;
}
__device__ __forceinline__ int rowmap_rt(int map, int n) { return map == 1 ? rowmap<1>(n) : (map == 2 ? rowmap<2>(n) : (map == 3 ? rowmap<3>(n) : n)); }
#define CVT_LOAD(J, tv) do { const GAS float* src_ = (const GAS float*)(J).src + (size_t)(J).k0 * (J).N + (J).n0 + F.lane; const size_t N_ = (size_t)(J).N; \
        _Pragma("unroll") for (int kk = 0; kk < 64; ++kk) tv[kk] = __builtin_nontemporal_load(src_ + (size_t)kk * N_); } while (0)
__device__ __forceinline__ void queue_convert(const Frame& F0, CArgs ka, int limit, int batches, const gu32* stop = nullptr, unsigned stop_at = 0u) {
    Frame F = F0; asm volatile("" : "+v"(F.tid)); F.lane = F.tid & 63;
    gu32* qc = F.ctl + CW_QCTR;
    LAS float* scr = (LAS float*)(F.lds + RING_OFF + F.wave * (64 * 65 * 4));
    volatile LAS int* slot = (volatile LAS int*)(F.lds + LDSCTL_OFF + 16);
    constexpr int SENT = 0x7fffffff;
    __syncthreads();
    if (F.tid == 0) *slot = (int)__hip_atomic_load(qc, __ATOMIC_RELAXED, __HIP_MEMORY_SCOPE_AGENT);
    __syncthreads();
    if (*slot >= limit) return;
#define QC_CLAIM(dst) do { __syncthreads(); \
        if (F.tid == 0) *slot = (stop && __hip_atomic_load(stop, __ATOMIC_RELAXED, __HIP_MEMORY_SCOPE_AGENT) >= stop_at) ? SENT : (int)__hip_atomic_fetch_add(qc, 8u, __ATOMIC_RELAXED, __HIP_MEMORY_SCOPE_AGENT); \
        __syncthreads(); dst = *slot; } while (0)
    int base; QC_CLAIM(base);
    if (base != SENT) {
        CvtJob job = make_job(ka, base + F.wave);
        float tv[64];
        if (job.valid) CVT_LOAD(job, tv);
        for (int nb = 1;; ++nb) {
            int nbase = SENT;
            if (nb < batches && base + 8 < limit) QC_CLAIM(nbase);
            CvtJob nj; nj.valid = false; if (nbase != SENT) nj = make_job(ka, nbase + F.wave);
            if (job.valid) {
#pragma unroll
                for (int kk = 0; kk < 64; ++kk) scr[kk * 65 + F.lane] = tv[kk];
                LDS_WAIT(); asm volatile("" ::: "memory"); }
            if (nj.valid) CVT_LOAD(nj, tv);
            if (job.valid) {
                const int c = F.lane & 7;
#pragma unroll
                for (int j = 0; j < 8; ++j) { const int n = (F.lane >> 3) + 8 * j; const LAS float* sp = scr + (8 * c) * 65 + n;
                    if (job.f8s != 0.f) { const float fs = job.f8s;
                        const unsigned long long o8 = (unsigned long long)pg8::pack4_fp8(sp[0 * 65] * fs, sp[1 * 65] * fs, sp[2 * 65] * fs, sp[3 * 65] * fs) | ((unsigned long long)pg8::pack4_fp8(sp[4 * 65] * fs, sp[5 * 65] * fs, sp[6 * 65] * fs, sp[7 * 65] * fs) << 32);
                        *(GAS unsigned long long*)((GAS unsigned char*)job.WT + (size_t)rowmap_rt(job.map, job.n0 + n) * job.K + job.k0 + 8 * c) = o8; }
                    else { v4u o; o.x = pk2(sp[0 * 65], sp[1 * 65]); o.y = pk2(sp[2 * 65], sp[3 * 65]); o.z = pk2(sp[4 * 65], sp[5 * 65]); o.w = pk2(sp[6 * 65], sp[7 * 65]);
                        *(GAS v4u*)(job.WT + (size_t)rowmap_rt(job.map, job.n0 + n) * job.K + job.k0 + 8 * c) = o; } }
                LDS_WAIT(); asm volatile("" ::: "memory"); }
            if (nbase == SENT) break;
            base = nbase; job = nj;
        }
    }
#undef QC_CLAIM
    __syncthreads();
}
__device__ __forceinline__ void p0_prologue(const Frame& F0, CArgs ka) {
    Frame F = F0; asm volatile("" : "+v"(F.tid)); F.lane = F.tid & 63; const auto& P = ka->p;
    { const int* pos = (const int*)P.in[2]; float* rc = (float*)(P.ws + WS_RC); float* rs = (float*)(P.ws + WS_RS);
      for (int idx = F.vcu * 512 + F.tid; idx < NTOK * 32; idx += F.G * 512) { const int tok = idx >> 5, i = idx & 31; float s, c; sincos_acc((float)pos[tok] * ka->rf.inv[i], s, c); rc[idx] = c; rs[idx] = s; } }
    for (int it = (int)blockIdx.x; it < DEPTH * (MODB / 64); it += F.G) mod_item(F, ka, it);
    LAS float* scr = (LAS float*)(F.lds + RING_OFF + F.wave * (64 * 65 * 4));
    LAS int* ctr = (LAS int*)(F.lds + LDSCTL_OFF);
    const int ipb = (PRO_ITEMS + F.G - 1) / F.G, lo = (int)blockIdx.x * ipb, hi = (lo + ipb < PRO_ITEMS) ? lo + ipb : PRO_ITEMS;
    for (;;) {
        int it = 0; if (F.lane == 0) it = __hip_atomic_fetch_add(ctr, 1, __ATOMIC_RELAXED, __HIP_MEMORY_SCOPE_WORKGROUP);
        it = lo + __builtin_amdgcn_readfirstlane(it);
        if (it >= hi) break;
        convert_item(ka, pro_item(it), scr, F.lane);
    }
    __syncthreads();
}

struct NormArgs {
    const float* xin; float* xout;
    const bf16* xinb; bf16* xoutb;
    const float* g; const float* sh; const float* sc;
    bf16* ha; float* of32;
    const bf16* ys; const float* slot_w; const float* cgate;
    const bf16* ysp; int tail0, tails;
    const float* rw; int* slot_e; int* slot_pos; float* slot_w_out; unsigned* cnt; int* row_list;
    const int* cslot_e; const int* cslot_pos;
    float oscale;
};
template <bool COMBINE, bool MODULATE, bool ROUTER, bool OUT_F32, bool XBF, bool TAILK = false, bool OUT_F8 = false>
__device__ __forceinline__ void norm_phase(const Frame& F0, const NormArgs& A) {
    Frame F = F0; asm volatile("" : "+v"(F.tid)); F.lane = F.tid & 63;
    LAS int* sE = (LAS int*)(F.lds + RING_OFF); LAS int* sR = sE + 128; LAS int* sB = sE + 256;
    for (int rb = F.vcu; rb < NTOK / 64; rb += F.G) {
        const int b = (rb * 64) / SEQ;
        f32x4 gs[4], shv[4], cg[4];
#pragma unroll
        for (int q = 0; q < 4; ++q) { const int col = 4 * F.lane + 256 * q; gs[q] = *(const f32x4*)(A.g + col);
            if (MODULATE) { gs[q] = gs[q] * (1.f + *(const f32x4*)(A.sc + (size_t)b * MODB + col)); shv[q] = *(const f32x4*)(A.sh + (size_t)b * MODB + col); }
            if (COMBINE) cg[q] = *(const f32x4*)(A.cgate + (size_t)b * MODB + col); }
        f32x4 rwv[ROUTER ? 16 : 1][2];
        if (ROUTER) {
#pragma unroll
            for (int q = 0; q < 4; ++q)
#pragma unroll
                for (int t = 0; t < 4; ++t) { const float* wp = A.rw + (size_t)(4 * F.lane + 256 * q + t) * 8; rwv[q * 4 + t][0] = *(const f32x4*)wp; rwv[q * 4 + t][1] = *(const f32x4*)(wp + 4); }
        }
#pragma unroll 1
        for (int j = 0; j < 8; j += 2) {
            const int row0 = rb * 64 + F.wave * 8 + j;
            f32x4 v[2][4];
#pragma unroll
            for (int u = 0; u < 2; ++u) {
                if (XBF) { const GAS unsigned long long* xr = (const GAS unsigned long long*)(A.xinb + (size_t)(row0 + u) * DM) + F.lane;
#pragma unroll
                    for (int q = 0; q < 4; ++q) { const unsigned long long w = xr[64 * q]; const unsigned wl = (unsigned)w, wh = (unsigned)(w >> 32);
                        v[u][q] = (f32x4){__uint_as_float(wl << 16), __uint_as_float(wl & 0xffff0000u), __uint_as_float(wh << 16), __uint_as_float(wh & 0xffff0000u)}; }
                } else { const GAS f32x4* xr = (const GAS f32x4*)(A.xin + (size_t)(row0 + u) * DM) + F.lane;
#pragma unroll
                    for (int q = 0; q < 4; ++q) v[u][q] = xr[64 * q]; } }
            if (COMBINE) {
                unsigned long long ya[2][4], yb[2][4]; float w0[2], w1[2]; int dd0[2], dd1[2];
#pragma unroll
                for (int u = 0; u < 2; ++u) { const int row = row0 + u; const LAS int* tab_ = (const LAS int*)(F.lds + TAB_OFF);
                    const int d0 = tab_[A.cslot_e[row * 2]] + A.cslot_pos[row * 2], d1 = tab_[A.cslot_e[row * 2 + 1]] + A.cslot_pos[row * 2 + 1]; w0[u] = A.slot_w[row * 2]; w1[u] = A.slot_w[row * 2 + 1];
                    dd0[u] = d0; dd1[u] = d1;
                    const GAS unsigned long long* y0 = (const GAS unsigned long long*)(A.ys + (size_t)d0 * DM) + F.lane; const GAS unsigned long long* y1 = (const GAS unsigned long long*)(A.ys + (size_t)d1 * DM) + F.lane;
#pragma unroll
                    for (int q = 0; q < 4; ++q) { ya[u][q] = y0[64 * q]; yb[u][q] = y1[64 * q]; } }
#pragma unroll
                for (int u = 0; u < 2; ++u) { GAS f32x4* xo = (GAS f32x4*)(A.xout + (size_t)(row0 + u) * DM) + F.lane; GAS unsigned long long* xob = (GAS unsigned long long*)(A.xoutb + (size_t)(row0 + u) * DM) + F.lane;
                    f32x4 ta[4], tb[4];
                    if (TAILK) {
#pragma unroll
                        for (int q = 0; q < 4; ++q) { ta[q] = (f32x4){0.f, 0.f, 0.f, 0.f}; tb[q] = ta[q]; }
                        const int t0 = __builtin_amdgcn_readfirstlane(dd0[u]) - A.tail0, t1 = __builtin_amdgcn_readfirstlane(dd1[u]) - A.tail0;
                        if (t0 >= 0) {
#pragma unroll 1
                            for (int k = 0; k < A.tails - 1; ++k) { const GAS unsigned long long* yp = (const GAS unsigned long long*)(A.ysp + ((size_t)k * pg8::TAILROWS + t0) * DM) + F.lane;
#pragma unroll
                                for (int q = 0; q < 4; ++q) { const unsigned long long w = yp[64 * q]; const unsigned wl = (unsigned)w, wh = (unsigned)(w >> 32);
                                    ta[q] = ta[q] + (f32x4){__uint_as_float(wl << 16), __uint_as_float(wl & 0xffff0000u), __uint_as_float(wh << 16), __uint_as_float(wh & 0xffff0000u)}; } } }
                        if (t1 >= 0) {
#pragma unroll 1
                            for (int k = 0; k < A.tails - 1; ++k) { const GAS unsigned long long* yp = (const GAS unsigned long long*)(A.ysp + ((size_t)k * pg8::TAILROWS + t1) * DM) + F.lane;
#pragma unroll
                                for (int q = 0; q < 4; ++q) { const unsigned long long w = yp[64 * q]; const unsigned wl = (unsigned)w, wh = (unsigned)(w >> 32);
                                    tb[q] = tb[q] + (f32x4){__uint_as_float(wl << 16), __uint_as_float(wl & 0xffff0000u), __uint_as_float(wh << 16), __uint_as_float(wh & 0xffff0000u)}; } } }
                    }
#pragma unroll
                    for (int q = 0; q < 4; ++q) {
                        const unsigned al = (unsigned)ya[u][q], ah = (unsigned)(ya[u][q] >> 32), cl = (unsigned)yb[u][q], ch = (unsigned)(yb[u][q] >> 32);
                        f32x4 fa = {__uint_as_float(al << 16), __uint_as_float(al & 0xffff0000u), __uint_as_float(ah << 16), __uint_as_float(ah & 0xffff0000u)};
                        f32x4 fb = {__uint_as_float(cl << 16), __uint_as_float(cl & 0xffff0000u), __uint_as_float(ch << 16), __uint_as_float(ch & 0xffff0000u)};
                        if (TAILK) { fa = fa + ta[q]; fb = fb + tb[q]; }
                        v[u][q] = v[u][q] + cg[q] * (fa * w0[u] + fb * w1[u]);
                        if (!OUT_F32) { if (XBF) xob[64 * q] = (unsigned long long)pk2(v[u][q].x, v[u][q].y) | ((unsigned long long)pk2(v[u][q].z, v[u][q].w) << 32); else xo[64 * q] = v[u][q]; }
                    } }
            }
#pragma unroll
            for (int u = 0; u < 2; ++u) {
                const int row = row0 + u;
                float s = 0.f;
#pragma unroll
                for (int q = 0; q < 4; ++q) s += (v[u][q].x * v[u][q].x + v[u][q].y * v[u][q].y) + (v[u][q].z * v[u][q].z + v[u][q].w * v[u][q].w);
                const float r = 1.f / sqrtf(wave_sum(s) * (1.f / DM) + EPS);
#pragma unroll
                for (int q = 0; q < 4; ++q) {
                    const int col = 4 * F.lane + 256 * q;
                    v[u][q] = v[u][q] * r * gs[q];
                    if (MODULATE) v[u][q] = v[u][q] + shv[q];
                    if (OUT_F32) *(GAS f32x4*)(A.of32 + (size_t)row * DM + col) = (PROBE >= 30) ? v[u][q] * A.oscale : v[u][q];
                    else if (OUT_F8) *(GAS unsigned*)((GAS unsigned char*)A.ha + (size_t)row * DM + col) = pg8::pack4_fp8(v[u][q].x * pg8::F8_SA, v[u][q].y * pg8::F8_SA, v[u][q].z * pg8::F8_SA, v[u][q].w * pg8::F8_SA);
                    else *(GAS unsigned long long*)(A.ha + (size_t)row * DM + col) = (unsigned long long)pk2(v[u][q].x, v[u][q].y) | ((unsigned long long)pk2(v[u][q].z, v[u][q].w) << 32);
                }
                if (ROUTER) {
                    float lg[8];
#pragma unroll
                    for (int e = 0; e < 8; ++e) lg[e] = 0.f;
#pragma unroll
                    for (int q = 0; q < 4; ++q)
#pragma unroll
                        for (int t = 0; t < 4; ++t) { const float hv = v[u][q][t]; const f32x4 w0 = rwv[q * 4 + t][0], w1 = rwv[q * 4 + t][1];
                            lg[0] += hv * w0.x; lg[1] += hv * w0.y; lg[2] += hv * w0.z; lg[3] += hv * w0.w; lg[4] += hv * w1.x; lg[5] += hv * w1.y; lg[6] += hv * w1.z; lg[7] += hv * w1.w; }
#pragma unroll
                    for (int e = 0; e < 8; ++e) lg[e] = wave_sum(lg[e]);
                    if (F.lane == 0) {
                        int e0 = 0; float v0 = lg[0];
#pragma unroll
                        for (int e = 1; e < 8; ++e) if (lg[e] > v0) { v0 = lg[e]; e0 = e; }
                        int e1 = 0; float v1 = -INFINITY;
#pragma unroll
                        for (int e = 0; e < 8; ++e) if (e != e0 && lg[e] > v1) { v1 = lg[e]; e1 = e; }
                        const float p1 = __expf(v1 - v0), inv = 1.f / (1.f + p1);
                        A.slot_w_out[row * 2] = inv; A.slot_w_out[row * 2 + 1] = p1 * inv;
                        sE[(F.wave * 8 + j + u) * 2] = e0; sE[(F.wave * 8 + j + u) * 2 + 1] = e1;
                    }
                }
            }
        }
        if (ROUTER) {
            __syncthreads();
            if (F.tid < 8) { const int e = F.tid; int n = 0; for (int s = 0; s < 128; ++s) if (sE[s] == e) sR[s] = n++;
                sB[e] = n ? (int)__hip_atomic_fetch_add(A.cnt + e, (unsigned)n, __ATOMIC_RELAXED, __HIP_MEMORY_SCOPE_AGENT) : 0; }
            __syncthreads();
            if (F.tid < 128) { const int s = F.tid, tok = rb * 64 + (s >> 1), slot = tok * 2 + (s & 1), e = sE[s], pos = sB[e] + sR[s]; A.slot_e[slot] = e; A.slot_pos[slot] = pos; A.row_list[e * 16384 + pos] = tok; }
            __syncthreads();
        }
    }
}
__device__ __forceinline__ void moe_table(const Frame& F0, const unsigned* cnt) {
    Frame F = F0; asm volatile("" : "+v"(F.tid)); F.lane = F.tid & 63;
    LAS int* tab = (LAS int*)(F.lds + TAB_OFF);
    if (F.tid == 0) { int acc = 0;
        for (int e = 0; e < NE; ++e) { const int c = (int)__hip_atomic_load(cnt + e, __ATOMIC_RELAXED, __HIP_MEMORY_SCOPE_AGENT); tab[e] = acc; tab[160 + e] = c; const int pd = (c + 255) / 256 * 256; for (int ch = acc / 256; ch < (acc + pd) / 256 && ch < NCHUNK_MAX; ++ch) tab[16 + ch] = e; acc += pd; }
        tab[8] = acc / 256 < NCHUNK_MAX ? acc / 256 : NCHUNK_MAX; }
    __syncthreads();
}
__device__ __forceinline__ void gather_phase(const Frame& F0, const bf16* ha, bf16* xs, const int* slot_e, const int* slot_pos, int* dest_of) {
    Frame F = F0; asm volatile("" : "+v"(F.tid)); F.lane = F.tid & 63;
    const LAS int* tab = (const LAS int*)(F.lds + TAB_OFF);
    for (int s = F.vcu * NWAVES + F.wave; s < NTOK * 2; s += F.G * NWAVES) {
        const int tok = s >> 1, e = slot_e[s], dest = tab[e] + slot_pos[s];
        const GAS v4u* src = (const GAS v4u*)(ha + (size_t)tok * DM); GAS v4u* dst = (GAS v4u*)(xs + (size_t)dest * DM);
        const v4u a = src[F.lane], b = src[F.lane + 64]; dst[F.lane] = a; dst[F.lane + 64] = b;
        if (F.lane == 0) dest_of[s] = dest;
    }
}
__device__ __forceinline__ void vt_phase(const Frame& F0, const unsigned char* p8, unsigned char* vt) {
    Frame F = F0; asm volatile("" : "+v"(F.tid)); F.lane = F.tid & 63;
    constexpr int LP = 528;
    LAS unsigned char* tile = (LAS unsigned char*)(F.lds + RING_OFF);
    for (int rb = F.vcu; rb < NTOK / 64; rb += F.G) {
        const int tok0 = rb * 64, b = tok0 / SEQ, t0 = tok0 - b * SEQ;
        __syncthreads();
#pragma unroll
        for (int pss = 0; pss < 4; ++pss) { const int tk = pss * 16 + (F.tid >> 5), ch = F.tid & 31;
            const v4u v = *(const GAS v4u*)(p8 + (size_t)(tok0 + tk) * 1536 + 1024 + ch * 16); *(LAS v4u*)(tile + tk * LP + ch * 16) = v; }
        __syncthreads();
        const int col = F.tid, hh = col >> 7, d = col & 127;
        unsigned w[16];
#pragma unroll
        for (int j = 0; j < 16; ++j) { unsigned acc = 0u;
#pragma unroll
            for (int e = 0; e < 4; ++e) { const int pos = 4 * j + e, hi_ = pos >> 5, tl = (pos >> 4) & 1, r = pos & 15, key = 32 * tl + (r & 3) + 8 * (r >> 2) + 4 * hi_;
                acc |= (unsigned)tile[key * LP + col] << (8 * e); }
            w[j] = acc; }
        GAS v4u* dst = (GAS v4u*)(vt + ((size_t)((b * 4 + hh) * 128 + d)) * SEQ + t0);
#pragma unroll
        for (int q = 0; q < 4; ++q) { v4u o; o.x = w[4 * q]; o.y = w[4 * q + 1]; o.z = w[4 * q + 2]; o.w = w[4 * q + 3]; dst[q] = o; }
    }
    __syncthreads();
}
__device__ __forceinline__ void diff_combine(const Frame& F0, const bf16* od, bf16* att, int b, int h, int q0, float lam, float omli, const float* subg) {
    Frame F = F0; asm volatile("" : "+v"(F.tid)); F.lane = F.tid & 63;
    const float g0 = subg[2 * F.lane], g1 = subg[2 * F.lane + 1];
    for (int j = 0; j < 32; ++j) {
        const int tok = b * SEQ + q0 + F.wave * 32 + j;
        const unsigned w1 = __hip_atomic_load((const unsigned*)(od + (size_t)tok * 512 + h * 128) + F.lane, __ATOMIC_RELAXED, __HIP_MEMORY_SCOPE_AGENT);
        const unsigned w2 = __hip_atomic_load((const unsigned*)(od + ((size_t)NTOK + tok) * 512 + h * 128) + F.lane, __ATOMIC_RELAXED, __HIP_MEMORY_SCOPE_AGENT);
        const float v0 = __uint_as_float(w1 << 16) - lam * __uint_as_float(w2 << 16), v1 = __uint_as_float(w1 & 0xffff0000u) - lam * __uint_as_float(w2 & 0xffff0000u);
        const float r = 1.f / sqrtf(wave_sum(v0 * v0 + v1 * v1) * (1.f / 128.f) + EPS);
        *((GAS unsigned*)(att + (size_t)tok * DM + 512 + h * 128) + F.lane) = pk2(v0 * r * g0 * omli, v1 * r * g1 * omli);
    }
}

#ifndef CONV_NB
#define CONV_NB 64
#endif
#define REP(k) _Pragma("unroll 1") for (int rep_ = 0; rep_ < ((PROBE == (k)) ? 2 : 1); ++rep_)
constexpr int PH_PRO = 0, PH_FINAL = 1 + DEPTH * 10, PH_END = PH_FINAL + 1;
#define WSP(T, off) ((T*)(ws + (off)))
#define IN(k) (lo <= (k) && (k) < hi)
#define SEAM(k) do { if ((k) + 1 < hi) { xcd_barrier(bar); if (PROBE == 12) xcd_barrier(bar); } } while (0)
#define PH() Frame Fp = F; int bx = (int)blockIdx.x; asm volatile("" : "+s"(Fp.G), "+s"(Fp.vcu), "+s"(bx)); constexpr int l = l_, i2 = l_ >> 1; (void)l; (void)i2; (void)bx
template <int L> __device__ __forceinline__ void run_layer(const Frame& F, const XcdBarrier& bar, const int lo, const int hi, unsigned char* lds) {
    constexpr int l_ = L; constexpr int pb = 1 + L * 10; constexpr bool moe = (L & 1) != 0;
        if (IN(pb + 0)) { PH();
            CArgs ka = kargs(); unsigned char* ws = ka->p.ws; const float* ml = WSP(float, WS_MOD) + (size_t)l * 2 * MODB;
            if (l > 0) queue_convert(Fp, ka, l == 1 ? Q2 : (l == 2 ? Q6 : Q8), 1 << 20);
            NormArgs A; A.g = ka->p.in[5] + l * DM; A.sh = ml + 0 * DM; A.sc = ml + 1 * DM; A.ha = WSP(bf16, WS_HA); A.of32 = nullptr;
            A.rw = nullptr; A.slot_e = nullptr; A.slot_pos = nullptr; A.slot_w_out = nullptr; A.cnt = nullptr; A.row_list = nullptr;
            if (l > 0 && ((l - 1) & 1)) {
                unsigned char* pr = ws + WS_ROUTE + (size_t)((l - 1) >> 1) * ROUTE_LAYER;
                A.xin = nullptr; A.xout = nullptr; A.xinb = WSP(bf16, WS_XB); A.xoutb = WSP(bf16, WS_XB); A.ys = WSP(bf16, WS_YS); A.cslot_e = (const int*)pr; A.cslot_pos = (const int*)(pr + 128 * 1024); A.slot_w = (const float*)(pr + 256 * 1024); A.cgate = WSP(float, WS_MOD) + (size_t)(l - 1) * 2 * MODB + 5 * DM;
                moe_table(Fp, (const unsigned*)(F.ctl + CW_CNT + 64 * ((l - 1) >> 1)));
                norm_phase<true, true, false, false, true, false, pg8::F8_IN>(Fp, A);
            } else {
                A.xin = ka->p.in[0]; A.xout = nullptr; A.xinb = WSP(bf16, WS_XB); A.xoutb = nullptr; A.ys = nullptr; A.cslot_e = nullptr; A.cslot_pos = nullptr; A.slot_w = nullptr; A.cgate = nullptr;
                REP(7) norm_phase<false, true, false, false, (L > 0), false, pg8::F8_IN>(Fp, A);
            }
            SEAM(pb + 0);
        }
        if (IN(pb + 1)) { PH();
            CArgs ka = kargs(); unsigned char* ws = ka->p.ws;
            constexpr int nwg = (NTOK / 256) * (INC / 256); const int rounds = (nwg + Fp.G - 1) / Fp.G; int GW = (((nwg + rounds - 1) / rounds) + 7) & ~7; if ((Fp.G & 7) || GW > Fp.G) GW = Fp.G;
            if (bx < GW) {
                constexpr bool FI = pg8::F8_IN;
                pg8::Gemm g{WSP(bf16, WS_HA), (const bf16*)(ws + WS_WIN + (size_t)l * INC * DM * (FI ? 1 : 2)), NTOK, INC, DM}; pg8::StaticOrder S; S.init(NTOK, INC, GW, bx);
                pg8::EpiRope E{WSP(bf16, WS_PROJ), WSP(const float, WS_RC), WSP(const float, WS_RS), FI ? pg8::F8_INV1 : 1.f, pg8::F8_ATT ? ws + WS_PROJ8 : nullptr};
                REP(2) pg8::gemm_phase<pg8::EpiRope, pg8::StaticOrder, true, true, pg8::NoGather, FI>(F.lds + RING_OFF, g, S, E);
                if (GW == Fp.G && (rounds - 1) * Fp.G + bx >= nwg) queue_convert(Fp, kargs(), QEND, 2);
                __syncthreads(); if (threadIdx.x == 0) __hip_atomic_fetch_add(F.ctl + CW_IPDONE + l, 1u, __ATOMIC_RELAXED, __HIP_MEMORY_SCOPE_AGENT);
            } else queue_convert(Fp, kargs(), QEND, CONV_NB, F.ctl + CW_IPDONE + l, (unsigned)GW);
            SEAM(pb + 1);
        }
        if (IN(pb + 2)) { PH();
            if constexpr (pg8::F8_ATT) { CArgs ka = kargs(); unsigned char* ws = ka->p.ws; vt_phase(Fp, ws + WS_PROJ8, ws + WS_VT); if (hi - lo > 1) xcd_barrier(bar); }
            REP(3) for (int su = Fp.vcu; su < 256; su += Fp.G) {
                const int bh = su >> 5, b = bh >> 2, h = bh & 3, q0 = (su & 31) * 256;
#pragma unroll 1
                for (int u2 = 0; u2 < 2; ++u2) {
                    CArgs ka = kargs(); unsigned char* ws = ka->p.ws; const attn_body::bf16* pj = WSP(const attn_body::bf16, WS_PROJ) + (size_t)b * SEQ * INC;
                    const int ln = (int)(threadIdx.x & 63); const float li = ka->lam_init[l];
                    const float lam = __expf(wave_sum(ka->p.in[10][l * 64 + ln] * ka->p.in[11][l * 64 + ln])) - __expf(wave_sum(ka->p.in[12][l * 64 + ln] * ka->p.in[13][l * 64 + ln])) + li;
                    if constexpr (pg8::F8_ATT) attn_body::dattn_unit_f8<8>(ws + WS_PROJ8 + (size_t)b * SEQ * 1536, ws + WS_VT + (size_t)(b * 4 + h) * 128 * SEQ, h,
                        WSP(attn_body::bf16, WS_ATT) + (size_t)b * SEQ * DM + 512 + h * 128, q0 + u2 * 128, lam, 1.f - li, ka->p.in[14] + l * 128, (char*)lds + RING_OFF);
                    else attn_body::dattn_unit<8>(pj + COL_QD + h * 128, pj + COL_KD + h * 128, pj + COL_VD + h * 128,
                        WSP(attn_body::bf16, WS_ATT) + (size_t)b * SEQ * DM + 512 + h * 128, q0 + u2 * 128, lam, 1.f - li, ka->p.in[14] + l * 128, (char*)lds + RING_OFF);
                }
#pragma unroll 1
                for (int i_ = 0; i_ < ((PROBE == 13) ? 6 : 2); ++i_) { const int i = i_ & 1;
                    CArgs ka = kargs(); unsigned char* ws = ka->p.ws; const attn_body::bf16* pj = WSP(const attn_body::bf16, WS_PROJ) + (size_t)b * SEQ * INC;
                    const int hq = 2 * h + i, hkv = hq >> 2;
                    attn_body::attn_unit<8, true>(pj + COL_QA + hq * 64, pj + COL_KA + hkv * 64, pj + COL_VA + hkv * 64,
                        WSP(attn_body::bf16, WS_ATT) + (size_t)b * SEQ * DM + hq * 64, DM, q0, ka->p.in[9][l * 8 + hq] * 1.4426950408889634f, (char*)lds + RING_OFF);
                }
            }
            SEAM(pb + 2);
        }
        if (IN(pb + 3)) { PH();
            CArgs ka = kargs(); unsigned char* ws = ka->p.ws; const float* ml = WSP(float, WS_MOD) + (size_t)l * 2 * MODB;
            pg8::Gemm g{WSP(bf16, WS_ATT), WSP(const bf16, WS_WOUT) + (size_t)l * DM * DM, NTOK, DM, DM}; pg8::StaticOrder S; S.init(NTOK, DM, Fp.G, bx);
            using EpiO = pg8::EpiResGateB<(L == 0)>;
            EpiO E{(l == 0) ? (const void*)ka->p.in[0] : (const void*)WSP(bf16, WS_XB), WSP(pg8::bf16_t, WS_XB), ml + 2 * DM};
            pg8::gemm_phase<EpiO, pg8::StaticOrder, true, true>(F.lds + RING_OFF, g, S, E);
            SEAM(pb + 3);
        }
        if (IN(pb + 4)) { PH();
            CArgs ka = kargs(); unsigned char* ws = ka->p.ws; const float* ml = WSP(float, WS_MOD) + (size_t)l * 2 * MODB;
            unsigned char* route = ws + WS_ROUTE + (size_t)i2 * ROUTE_LAYER;
            NormArgs A; A.xin = nullptr; A.xout = nullptr; A.xinb = WSP(bf16, WS_XB); A.xoutb = nullptr; A.g = ka->p.in[6] + l * DM; A.sh = ml + 3 * DM; A.sc = ml + 4 * DM; A.ha = WSP(bf16, WS_HA); A.of32 = nullptr;
            A.ys = nullptr; A.cslot_e = nullptr; A.cslot_pos = nullptr; A.slot_w = nullptr; A.cgate = nullptr; A.row_list = nullptr;
            if (moe) { A.rw = ka->p.in[18] + (size_t)i2 * DM * NE; A.slot_e = (int*)route; A.slot_pos = (int*)(route + 128 * 1024); A.slot_w_out = (float*)(route + 256 * 1024); A.cnt = (unsigned*)(F.ctl + CW_CNT + 64 * i2); A.row_list = (int*)(route + 512 * 1024); norm_phase<false, true, true, false, true, false, pg8::F8_M1>(Fp, A);
                queue_convert(Fp, ka, l == 1 ? Q3A : Q8A, 1 << 20); }
            else { A.rw = nullptr; A.slot_e = nullptr; A.slot_pos = nullptr; A.slot_w_out = nullptr; A.cnt = nullptr; REP(11) norm_phase<false, true, false, false, true, false, pg8::F8_D1>(Fp, A); }
            SEAM(pb + 4);
        }
        if constexpr (!moe) {
            if (IN(pb + 5)) { PH();
                CArgs ka = kargs(); unsigned char* ws = ka->p.ws;
                constexpr bool F1 = pg8::F8_D1, F2 = pg8::F8_D2;
                pg8::Gemm g{WSP(bf16, WS_HA), (const bf16*)(ws + WS_WGU_D + (size_t)i2 * 2 * FF * DM * (F1 ? 1 : 2)), NTOK, 2 * FF, DM}; pg8::StaticOrder S; S.init(NTOK, 2 * FF, Fp.G, bx);
                if constexpr (F2) { pg8::EpiSwigluF8 E{ws + WS_HMID, FF, F1 ? pg8::F8_INV1 : 1.f, pg8::F8_SH}; REP(4) pg8::gemm_phase<pg8::EpiSwigluF8, pg8::StaticOrder, true, true, pg8::NoGather, F1>(F.lds + RING_OFF, g, S, E); }
                else { pg8::EpiSwiglu E{WSP(bf16, WS_HMID), FF, F1 ? pg8::F8_INV1 : 1.f}; REP(4) pg8::gemm_phase<pg8::EpiSwiglu, pg8::StaticOrder, true, true, pg8::NoGather, F1>(F.lds + RING_OFF, g, S, E); }
                SEAM(pb + 5);
            }
            if (IN(pb + 6)) { PH();
                CArgs ka = kargs(); unsigned char* ws = ka->p.ws; const float* ml = WSP(float, WS_MOD) + (size_t)l * 2 * MODB;
                constexpr bool F2 = pg8::F8_D2;
                pg8::Gemm g{WSP(bf16, WS_HMID), (const bf16*)(ws + WS_WD_D + (size_t)i2 * DM * FF * (F2 ? 1 : 2)), NTOK, DM, FF}; pg8::StaticOrder S; S.init(NTOK, DM, Fp.G, bx);
                using EpiF = pg8::EpiResGateB<false>;
                EpiF E{(const void*)WSP(bf16, WS_XB), WSP(pg8::bf16_t, WS_XB), ml + 5 * DM, F2 ? pg8::F8_INV2 : 1.f};
                pg8::gemm_phase<EpiF, pg8::StaticOrder, true, true, pg8::NoGather, F2>(F.lds + RING_OFF, g, S, E);
                SEAM(pb + 6);
            }
        } else {
            const int* tabp = (const int*)(lds + TAB_OFF);
            if (IN(pb + 6)) { PH();
                CArgs ka = kargs(); unsigned char* ws = ka->p.ws;
                moe_table(Fp, (const unsigned*)(F.ctl + CW_CNT + 64 * i2)); const int nch = tabp[8];
                constexpr bool F1 = pg8::F8_M1, F2 = pg8::F8_M2;
                pg8::Gemm g{WSP(bf16, WS_HA), (const bf16*)(ws + WS_WGU_M + (size_t)i2 * NE * 2 * FF * DM * (F1 ? 1 : 2)), nch * 256, 2 * FF, DM}; pg8::StaticOrder S; S.init(nch * 256, 2 * FF, Fp.G, bx, tabp + 16);
                { const int* rl = (const int*)(ws + WS_ROUTE + (size_t)i2 * ROUTE_LAYER + 512 * 1024); LAS int* idx = (LAS int*)(F.lds + IDX_OFF); const LAS int* tb = (const LAS int*)(F.lds + TAB_OFF);
                  pg8::Unit uu; int tl_ = (int)threadIdx.x; asm volatile("" : "+v"(tl_));
                  for (int i = 0; i < IDX_UNITS && S.next(i, uu); ++i) {
                      const int e = tb[16 + uu.pm], rbase = (uu.pm << 8) - tb[e], cnt_e = tb[160 + e];
                      if (tl_ < 256) { const int rr = rbase + tl_; idx[i * 256 + tl_] = rr < cnt_e ? rl[e * 16384 + rr] : 0; } }
                  __syncthreads(); }
                pg8::LdsGather GA{(const LAS int*)(F.lds + IDX_OFF)};
                if constexpr (F2) { pg8::EpiSwigluF8 E{ws + WS_HMID, FF, F1 ? pg8::F8_INV1 : 1.f, pg8::F8_SH}; REP(5) pg8::gemm_phase<pg8::EpiSwigluF8, pg8::StaticOrder, true, true, pg8::LdsGather, F1>(F.lds + RING_OFF, g, S, E, GA); }
                else { pg8::EpiSwiglu E{WSP(bf16, WS_HMID), FF, F1 ? pg8::F8_INV1 : 1.f}; REP(5) pg8::gemm_phase<pg8::EpiSwiglu, pg8::StaticOrder, true, true, pg8::LdsGather, F1>(F.lds + RING_OFF, g, S, E, GA); }
                queue_convert(Fp, kargs(), l == 1 ? Q3 : QEND, 1 << 20);
                SEAM(pb + 6);
            }
            if (IN(pb + 7)) { PH();
                CArgs ka = kargs(); unsigned char* ws = ka->p.ws;
                moe_table(Fp, (const unsigned*)(F.ctl + CW_CNT + 64 * i2)); const int nch = tabp[8];
                constexpr bool F2 = pg8::F8_M2; constexpr int KT = F2 ? 128 : 64;
                pg8::Gemm g{WSP(bf16, WS_HMID), (const bf16*)(ws + WS_WD_M + (size_t)i2 * NE * DM * FF * (F2 ? 1 : 2)), nch * 256, DM, FF};
                if constexpr (L == DEPTH - 1) {
                    pg8::TailOrder S; S.init(nch, DM, FF * 64 / KT, Fp.G, bx, Fp.vcu, tabp + 16);
                    pg8::EpiBf16T E{WSP(pg8::bf16_t, WS_YS), DM, WSP(pg8::bf16_t, WS_YSP), S.pm0, F2 ? pg8::F8_INV2 : 1.f};
                    pg8::gemm_phase<pg8::EpiBf16T, pg8::TailOrder, true, true, pg8::NoGather, F2>(F.lds + RING_OFF, g, S, E);
                } else {
                    pg8::StaticOrder S; S.init(nch * 256, DM, Fp.G, bx, tabp + 16);
                    pg8::EpiBf16 E{WSP(bf16, WS_YS), DM, F2 ? pg8::F8_INV2 : 1.f};
                    REP(6) pg8::gemm_phase<pg8::EpiBf16, pg8::StaticOrder, true, true, pg8::NoGather, F2>(F.lds + RING_OFF, g, S, E);
                    { const int nwg = nch * (DM / 256), rounds = (nwg + Fp.G - 1) / Fp.G; if ((rounds - 1) * Fp.G + bx >= nwg) queue_convert(Fp, kargs(), QEND, 7); }
                }
                SEAM(pb + 7);
            }
        }
}

__global__ void __launch_bounds__(NWAVES * 64, 2) mk_fwd(Args args_by_value_unused) {
    extern __shared__ __attribute__((aligned(16))) unsigned char lds[];
    Frame F;
    F.lds = (LAS unsigned char*)lds;
    F.MISC = (volatile LAS unsigned*)(F.lds + MISC_OFF);
    F.tid = threadIdx.x; F.lane = F.tid & 63; F.wave = __builtin_amdgcn_readfirstlane(F.tid >> 6);
    F.G = gridDim.x; { const int bx = blockIdx.x; F.vcu = (F.G % 8 == 0) ? (bx % 8) * (F.G / 8) + bx / 8 : bx; }
    int lo, hi_full; { CArgs ka = kargs(); lo = ka->ph_lo; hi_full = ka->ph_hi; F.ctl = (gu32*)(ka->p.ws + WS_CTL); }
    { const int hi = hi_full; (void)hi; }
    for (int u = F.tid; u < (LDS_BYTES - LDSCTL_OFF) / 4; u += NWAVES * 64) ((LAS unsigned*)(F.lds + LDSCTL_OFF))[u] = 0u;
    __syncthreads();
    XcdBarrier bar; bar.bar = (unsigned*)(F.ctl + CW_BAR); bar.x = 0; bar.st = nullptr;
    if (hi_full - lo > 1) bar = xcd_barrier_post((unsigned*)(F.ctl + CW_BAR), F.MISC + 8);
#if PROBE >= 100
    { constexpr int hi = PROBE - 100;
      if (IN(PH_PRO)) { p0_prologue(F, kargs()); SEAM(PH_PRO); }
      run_layer<0>(F, bar, lo, hi, lds); run_layer<1>(F, bar, lo, hi, lds); run_layer<2>(F, bar, lo, hi, lds); run_layer<3>(F, bar, lo, hi, lds);
      xcd_barrier(bar); if (blockIdx.x == 0 && F.tid < 128) F.ctl[CW_CNT + F.tid] = 0u; __syncthreads(); if (F.tid == 0) *(LAS int*)(F.lds + LDSCTL_OFF) = 0; __syncthreads(); }
#endif
    { const int hi = hi_full;
    if (IN(PH_PRO)) { REP(1) { p0_prologue(F, kargs()); if (PROBE == 1) { __syncthreads(); if (F.tid == 0) *(LAS int*)(F.lds + LDSCTL_OFF) = 0; __syncthreads(); } } SEAM(PH_PRO); }

    run_layer<0>(F, bar, lo, hi, lds); run_layer<1>(F, bar, lo, hi, lds); run_layer<2>(F, bar, lo, hi, lds); run_layer<3>(F, bar, lo, hi, lds);
    if (IN(PH_FINAL)) {
        constexpr int l_ = DEPTH; PH();
        CArgs ka = kargs(); unsigned char* ws = ka->p.ws;
        unsigned char* pr = ws + WS_ROUTE + (size_t)((DEPTH - 1) >> 1) * ROUTE_LAYER;
        NormArgs A; A.xin = nullptr; A.xout = nullptr; A.xinb = WSP(bf16, WS_XB); A.xoutb = nullptr; A.g = ka->p.in[22]; A.sh = nullptr; A.sc = nullptr; A.ha = nullptr; A.of32 = ka->p.out;
        A.ys = WSP(bf16, WS_YS); A.cslot_e = (const int*)pr; A.cslot_pos = (const int*)(pr + 128 * 1024); A.slot_w = (const float*)(pr + 256 * 1024); A.cgate = WSP(float, WS_MOD) + (size_t)(DEPTH - 1) * 2 * MODB + 5 * DM;
        moe_table(Fp, (const unsigned*)(F.ctl + CW_CNT + 64 * ((DEPTH - 1) >> 1)));
        A.rw = nullptr; A.slot_e = nullptr; A.slot_pos = nullptr; A.slot_w_out = nullptr; A.cnt = nullptr; A.row_list = nullptr;
        A.oscale = 1.f;
        { int MC, ts; pg8::tail_params(((const LAS int*)(F.lds + TAB_OFF))[8], DM / 256, FF / (pg8::F8_M2 ? 128 : 64), Fp.G, MC, ts); A.ysp = WSP(bf16, WS_YSP); A.tail0 = MC * 256; A.tails = ts; }
        norm_phase<true, false, false, true, true, true>(Fp, A);
    }
    }
#undef IN
#undef SEAM
}

#ifndef MK_PER_PHASE
#define MK_PER_PHASE 0
#endif
extern "C" void kernel_launch(void* const* d_in, const int* in_sizes, int n_in, void* d_out, int out_size, void* d_ws, size_t ws_size, hipStream_t stream) {
    static int grid = 0;
    if (grid == 0) {
        if (n_in != 23 || out_size != NTOK * DM || ws_size < WS_END) { fprintf(stderr, "kernel_launch: unexpected problem (n_in %d out %d ws %zu)\n", n_in, out_size, ws_size); grid = -1; return; }
        int dev = 0, cus = 0, per_cu = 0;
        if (hipGetDevice(&dev) != hipSuccess || hipDeviceGetAttribute(&cus, hipDeviceAttributeMultiprocessorCount, dev) != hipSuccess) { grid = -1; return; }
        if (hipFuncSetAttribute((const void*)mk_fwd, hipFuncAttributeMaxDynamicSharedMemorySize, LDS_BYTES) != hipSuccess) { grid = -1; return; }
        if (hipOccupancyMaxActiveBlocksPerMultiprocessor(&per_cu, (const void*)mk_fwd, NWAVES * 64, LDS_BYTES) != hipSuccess || per_cu < 1) { fprintf(stderr, "kernel_launch: occupancy query reports %d\n", per_cu); }
        (void)hipGetLastError();
        grid = cus;
    }
    if (grid < 0) return;
    if (hipMemsetAsync((char*)d_ws + WS_CTL, 0, CTL_ZERO_BYTES, stream) != hipSuccess) return;
    Args a; memset(&a, 0, sizeof(a));
    for (int i = 0; i < 23; ++i) a.p.in[i] = (const float*)d_in[i];
    a.p.out = (float*)d_out; a.p.ws = (unsigned char*)d_ws;
    for (int i = 0; i < 32; ++i) a.rf.inv[i] = (float)(1.0 / pow(10000.0, (double)((float)(2 * i) / 64.0f)));
    for (int l = 0; l < DEPTH; ++l) a.lam_init[l] = (float)(0.8 - 0.6 * exp(-0.3 * (double)l));
#if MK_PER_PHASE
    for (int ph = 0; ph < PH_END; ++ph) { a.ph_lo = ph; a.ph_hi = ph + 1; hipLaunchKernelGGL(mk_fwd, dim3(grid), dim3(NWAVES * 64), LDS_BYTES, stream, a); }
#else
    a.ph_lo = 0; a.ph_hi = PH_END;
    hipLaunchKernelGGL(mk_fwd, dim3(grid), dim3(NWAVES * 64), LDS_BYTES, stream, a);
#endif
}
```

```cpp
#define LEAD_WAVES 8
#define RESC_DRAIN 1
#include <hip/hip_runtime.h>
#ifndef PROBE
#define PROBE 0
#endif
#ifndef RESC_DRAIN
#define RESC_DRAIN 0
#endif
#ifndef RESC_NOPS
#define RESC_NOPS 10
#endif
#ifndef LEAD_WAVES
#define LEAD_WAVES 4
#endif
#include <hip/hip_bf16.h>
#include <cstdio>
#include <cstdint>
#include <cmath>
#include <cstring>

constexpr int BATCH = 2, SEQ = 8192, DM = 1024, NTOK = BATCH * SEQ, DEPTH = 4;
constexpr int INC = 2304, FF = 3584, NE = 8, NMOD = 6;
constexpr int COL_QA = 0, COL_KA = 512, COL_VA = 640, COL_QD = 768, COL_KD = 1280, COL_VD = 1792;
constexpr int PMAX = NTOK * 2 + NE * 256;
constexpr int NCHUNK_MAX = PMAX / 256;
constexpr float EPS = 1e-6f;
constexpr float QK_C2 = 0.125f * 1.4426950408889634f;
constexpr int MODB = NMOD * DM;

namespace pg8 {
#define PG8_LAS __attribute__((address_space(3)))
typedef unsigned short bf16_t;
typedef short bf16x8 __attribute__((ext_vector_type(8)));
typedef float f32x4 __attribute__((ext_vector_type(4)));
typedef unsigned u32x4 __attribute__((ext_vector_type(4)));
constexpr int BM = 256, BK = 64, HALF = 128, HTB = HALF * BK * 2  , STAGE_BYTES = 8 * HTB, NXCD = 8, WGM = 8;

__host__ __device__ __forceinline__ int lds_byte(int r, int c) { const int st = (r >> 4) * 2 + (c >> 5), rr = r & 15, cc = c & 31, ob = rr * 64 + cc * 2; return st * 1024 + (ob ^ (((ob >> 9) & 1) << 5)); }
__host__ __device__ __forceinline__ void stage_rc(int b, int& R, int& C) { const int st = b / 1024, sb = b % 1024, swz = sb ^ (((sb >> 9) & 1) << 5); R = (st >> 1) * 16 + swz / 64; C = (st & 1) * 32 + (swz % 64) / 2; }
__host__ __device__ __forceinline__ int perm32(int rho) { const int n = rho >> 4, i = rho & 15; return 8 * (i >> 2) + 4 * n + (i & 3); }

struct Unit { int pm, pn, pnb; int koff, nt, ks; };
struct Gemm { const bf16_t* A; const bf16_t* Bt; int M, N, K; };

struct StaticOrder {
    static constexpr bool VARK = false;
    int nM, nN, nwg, G, c; const int* chunk_e;
    __device__ __forceinline__ void init(int M, int N, int G_, int c_, const int* ce = nullptr) { nM = M / BM; nN = N / BM; nwg = nM * nN; G = G_; c = c_; chunk_e = ce; }
    __device__ __forceinline__ bool next(int i, Unit& u) const {
        const long L = (long)i * G + c; if (L >= nwg) return false;
        int wgid = (int)L; { const int q = nwg / NXCD, r = nwg % NXCD, xcd = wgid % NXCD, off = wgid / NXCD; wgid = (xcd < r ? xcd * (q + 1) : r * (q + 1) + (xcd - r) * q) + off; }
        const int nig = WGM * nN, gid = wgid / nig, fm = gid * WGM, gsz = (nM - fm) < WGM ? (nM - fm) : WGM;
        u.pm = fm + ((wgid % nig) % gsz); u.pn = (wgid % nig) / gsz; u.pnb = chunk_e ? chunk_e[u.pm] * nN + u.pn : u.pn; return true;
    }
    __device__ __forceinline__ void a_ready(const Unit&) const {}
    __device__ __forceinline__ void done(const Unit&) const {}
};
__host__ __device__ __forceinline__ void tail_params(int nch, int nN, int nt_all, int G, int& MC, int& s) {
    MC = ((nch * nN) / G) * G / nN; const int T = nch - MC;
    s = (T * nN * 7 <= G && nt_all % 14 == 0) ? 7 : (T * nN * 4 <= G && nt_all % 8 == 0) ? 4 : (T * nN * 2 <= G && nt_all % 4 == 0) ? 2 : 1;
}
struct TailOrder {
    static constexpr bool VARK = true;
    StaticOrder main; int G, vcu, nmine, npieces, s, kt, pm0, nN; const int* chunk_e;
    __device__ __forceinline__ void init(int nch, int N, int K, int G_, int c_, int vcu_, const int* ce) {
        nN = N / BM; G = G_; vcu = vcu_; chunk_e = ce; int MC; tail_params(nch, nN, K / BK, G, MC, s);
        main.init(MC * BM, N, G, c_, ce); const int nmain = MC * nN; nmine = c_ < nmain ? (nmain - c_ + G - 1) / G : 0;
        pm0 = MC; kt = (K / BK) / s; npieces = (nch - MC) * nN * s;
    }
    __device__ __forceinline__ bool next(int i, Unit& u) const {
        if (i < nmine) { main.next(i, u); u.koff = 0; u.nt = kt * s; u.ks = 0; return true; }
        const int q = (i - nmine) * G + vcu; if (q >= npieces) return false;
        const int pn = q % nN, r = q / nN, ks = r % s, ch = r / s;
        u.pm = pm0 + ch; u.pn = pn; u.pnb = chunk_e[u.pm] * nN + pn; u.koff = ks * kt * BK * 2; u.nt = kt; u.ks = ks; return true;
    }
    __device__ __forceinline__ void a_ready(const Unit&) const {}
    __device__ __forceinline__ void done(const Unit&) const {}
};
constexpr int TAILROWS = 8 * 256;

#ifndef F8CFG
#define F8CFG 62
#endif
constexpr bool F8_D1 = (F8CFG & 1) != 0, F8_D2 = (F8CFG & 2) != 0, F8_M1 = (F8CFG & 4) != 0, F8_M2 = (F8CFG & 8) != 0, F8_IN = (F8CFG & 16) != 0, F8_ATT = (F8CFG & 32) != 0;
constexpr float F8_SA = 8.f, F8_SW1 = 128.f, F8_SH = 4.f, F8_SW2 = 256.f;
constexpr float F8_INV1 = 1.f / (F8_SA * F8_SW1), F8_INV2 = 1.f / (F8_SH * F8_SW2);
__device__ __forceinline__ unsigned pack4_fp8(float a, float b, float c, float d) {
    a = __builtin_amdgcn_fmed3f(a, -448.f, 448.f); b = __builtin_amdgcn_fmed3f(b, -448.f, 448.f); c = __builtin_amdgcn_fmed3f(c, -448.f, 448.f); d = __builtin_amdgcn_fmed3f(d, -448.f, 448.f);
    unsigned r = 0u; r = (unsigned)__builtin_amdgcn_cvt_pk_fp8_f32(a, b, (int)r, false); r = (unsigned)__builtin_amdgcn_cvt_pk_fp8_f32(c, d, (int)r, true); return r; }
__device__ __forceinline__ unsigned cvt_pk_bf16(float lo, float hi) { unsigned r; asm volatile("v_cvt_pk_bf16_f32 %0, %1, %2" : "=v"(r) : "v"(lo), "v"(hi)); return r; }

struct EpiBf16 {
    static constexpr bool PERM = true, AFTER_DRAIN = false;
    bf16_t* O; int ldc; float ascale = 1.f;
    __device__ __forceinline__ void operator()(const f32x4 (&acc)[2][2][4][2], const Unit& u, int wr, int wc, int fr, int fq) const {
        const int row0 = u.pm * BM + wr * 64 + fr, col0 = u.pn * BM + wc * 32 + 8 * fq;
#pragma unroll
        for (int ai = 0; ai < 2; ++ai)
#pragma unroll
            for (int m = 0; m < 4; ++m) { bf16_t* rowp = O + (size_t)(row0 + ai * HALF + m * 16) * ldc + col0;
#pragma unroll
                for (int bj = 0; bj < 2; ++bj) { const f32x4 v0 = acc[ai][bj][m][0] * ascale, v1 = acc[ai][bj][m][1] * ascale;
                    u32x4 w; w.x = cvt_pk_bf16(v0[0], v0[1]); w.y = cvt_pk_bf16(v0[2], v0[3]); w.z = cvt_pk_bf16(v1[0], v1[1]); w.w = cvt_pk_bf16(v1[2], v1[3]);
                    *(u32x4*)(rowp + bj * HALF) = w; } }
    }
};
struct EpiBf16T {
    static constexpr bool PERM = true, AFTER_DRAIN = false;
    bf16_t* O; int ldc; bf16_t* P; int pm0; float ascale = 1.f;
    __device__ __forceinline__ void operator()(const f32x4 (&acc)[2][2][4][2], const Unit& u, int wr, int wc, int fr, int fq) const {
        bf16_t* base = O; int rowb = u.pm * BM;
        if (u.ks != 0) { base = P + (size_t)(u.ks - 1) * TAILROWS * ldc; rowb = (u.pm - pm0) * BM; }
        const int row0 = rowb + wr * 64 + fr, col0 = u.pn * BM + wc * 32 + 8 * fq;
#pragma unroll
        for (int ai = 0; ai < 2; ++ai)
#pragma unroll
            for (int m = 0; m < 4; ++m) { bf16_t* rowp = base + (size_t)(row0 + ai * HALF + m * 16) * ldc + col0;
#pragma unroll
                for (int bj = 0; bj < 2; ++bj) { const f32x4 v0 = acc[ai][bj][m][0] * ascale, v1 = acc[ai][bj][m][1] * ascale;
                    u32x4 w; w.x = cvt_pk_bf16(v0[0], v0[1]); w.y = cvt_pk_bf16(v0[2], v0[3]); w.z = cvt_pk_bf16(v1[0], v1[1]); w.w = cvt_pk_bf16(v1[2], v1[3]);
                    *(u32x4*)(rowp + bj * HALF) = w; } }
    }
};
struct EpiRope {
    static constexpr bool PERM = true, AFTER_DRAIN = false;
    bf16_t* O; const float* rc; const float* rs; float ascale = 1.f; unsigned char* O8 = nullptr;
    __device__ __forceinline__ void operator()(const f32x4 (&acc)[2][2][4][2], const Unit& u, int wr, int wc, int fr, int fq) const {
        const int row0 = u.pm * BM + wr * 64 + fr;
#pragma unroll
        for (int bj = 0; bj < 2; ++bj) {
            const int cbase = u.pn * BM + bj * HALF;
            const bool rope = (cbase < COL_VA) || (cbase >= COL_QD && cbase < COL_VD);
            const bool f8o = O8 != nullptr && cbase >= COL_QD;
            const float sc = (((cbase < COL_KA) || (cbase >= COL_QD && cbase < COL_KD)) ? QK_C2 : 1.0f) * ascale * (f8o ? (cbase < COL_KD ? 8.f : (cbase < COL_VD ? 0.125f : 1.f)) : 1.f);
            const int col0 = cbase + wc * 32 + 8 * fq, i0 = (col0 & 63) >> 1;
#pragma unroll
            for (int ai = 0; ai < 2; ++ai)
#pragma unroll
                for (int m = 0; m < 4; ++m) {
                    const int row = row0 + ai * HALF + m * 16;
                    f32x4 v0 = acc[ai][bj][m][0], v1 = acc[ai][bj][m][1];
                    if (rope) {
                        const f32x4 c4 = *(const f32x4*)(rc + (size_t)row * 32 + i0), s4 = *(const f32x4*)(rs + (size_t)row * 32 + i0);
                        const f32x4 a0 = v0, a1 = v1;
                        v0[0] = a0[0] * c4[0] - a0[1] * s4[0]; v0[1] = a0[1] * c4[0] + a0[0] * s4[0];
                        v0[2] = a0[2] * c4[1] - a0[3] * s4[1]; v0[3] = a0[3] * c4[1] + a0[2] * s4[1];
                        v1[0] = a1[0] * c4[2] - a1[1] * s4[2]; v1[1] = a1[1] * c4[2] + a1[0] * s4[2];
                        v1[2] = a1[2] * c4[3] - a1[3] * s4[3]; v1[3] = a1[3] * c4[3] + a1[2] * s4[3];
                    }
                    v0 = v0 * sc; v1 = v1 * sc;
                    if (f8o) { *(unsigned long long*)(O8 + (size_t)row * (INC - COL_QD) + (col0 - COL_QD)) = (unsigned long long)pack4_fp8(v0[0], v0[1], v0[2], v0[3]) | ((unsigned long long)pack4_fp8(v1[0], v1[1], v1[2], v1[3]) << 32); }
                    else { u32x4 w; w.x = cvt_pk_bf16(v0[0], v0[1]); w.y = cvt_pk_bf16(v0[2], v0[3]); w.z = cvt_pk_bf16(v1[0], v1[1]); w.w = cvt_pk_bf16(v1[2], v1[3]);
                        *(u32x4*)(O + (size_t)row * INC + col0) = w; }
                }
        }
    }
};
struct EpiSwiglu {
    static constexpr bool PERM = true, AFTER_DRAIN = false;
    bf16_t* O; int ldc; float ain = 1.f;
    __device__ __forceinline__ static float silu_mul(float g, float u) { return g * u * __builtin_amdgcn_rcpf(1.0f + __builtin_amdgcn_exp2f(-1.4426950408889634f * g)); }
    __device__ __forceinline__ void operator()(const f32x4 (&acc)[2][2][4][2], const Unit& u, int wr, int wc, int fr, int fq) const {
        const int row0 = u.pm * BM + wr * 64 + fr, col0 = u.pn * HALF + wc * 32 + 8 * fq;
#pragma unroll
        for (int ai = 0; ai < 2; ++ai)
#pragma unroll
            for (int m = 0; m < 4; ++m) {
                const f32x4 g0 = acc[ai][0][m][0] * ain, g1 = acc[ai][0][m][1] * ain, u0 = acc[ai][1][m][0] * ain, u1 = acc[ai][1][m][1] * ain;
                u32x4 w; w.x = cvt_pk_bf16(silu_mul(g0[0], u0[0]), silu_mul(g0[1], u0[1])); w.y = cvt_pk_bf16(silu_mul(g0[2], u0[2]), silu_mul(g0[3], u0[3]));
                w.z = cvt_pk_bf16(silu_mul(g1[0], u1[0]), silu_mul(g1[1], u1[1])); w.w = cvt_pk_bf16(silu_mul(g1[2], u1[2]), silu_mul(g1[3], u1[3]));
                *(u32x4*)(O + (size_t)(row0 + ai * HALF + m * 16) * ldc + col0) = w;
            }
    }
};
struct EpiSwigluF8 {
    static constexpr bool PERM = true, AFTER_DRAIN = false;
    unsigned char* O; int ldc; float ain, oscale;
    __device__ __forceinline__ void operator()(const f32x4 (&acc)[2][2][4][2], const Unit& u, int wr, int wc, int fr, int fq) const {
        const int row0 = u.pm * BM + wr * 64 + fr, col0 = u.pn * HALF + wc * 32 + 8 * fq;
#pragma unroll
        for (int ai = 0; ai < 2; ++ai)
#pragma unroll
            for (int m = 0; m < 4; ++m) {
                const f32x4 g0 = acc[ai][0][m][0] * ain, g1 = acc[ai][0][m][1] * ain, u0 = acc[ai][1][m][0] * (ain * oscale), u1 = acc[ai][1][m][1] * (ain * oscale);
                unsigned long long w = (unsigned long long)pack4_fp8(EpiSwiglu::silu_mul(g0[0], u0[0]), EpiSwiglu::silu_mul(g0[1], u0[1]), EpiSwiglu::silu_mul(g0[2], u0[2]), EpiSwiglu::silu_mul(g0[3], u0[3]))
                    | ((unsigned long long)pack4_fp8(EpiSwiglu::silu_mul(g1[0], u1[0]), EpiSwiglu::silu_mul(g1[1], u1[1]), EpiSwiglu::silu_mul(g1[2], u1[2]), EpiSwiglu::silu_mul(g1[3], u1[3])) << 32);
                *(unsigned long long*)(O + (size_t)(row0 + ai * HALF + m * 16) * ldc + col0) = w;
            }
    }
};
struct EpiResGate {
    static constexpr bool PERM = false, AFTER_DRAIN = false;
    const float* base; float* out; const float* gate;
    __device__ __forceinline__ void operator()(const f32x4 (&acc)[2][2][4][2], const Unit& u, int wr, int wc, int fr, int fq) const {
        const int row0 = u.pm * BM + wr * 64 + fr, col0 = u.pn * BM + wc * 32 + 4 * fq;
        const float* gp = gate + (size_t)((u.pm * BM) / SEQ) * MODB + col0;
        f32x4 gv[2][2];
#pragma unroll
        for (int bj = 0; bj < 2; ++bj)
#pragma unroll
            for (int n = 0; n < 2; ++n) gv[bj][n] = *(const f32x4*)(gp + bj * HALF + n * 16);
#pragma unroll
        for (int ai = 0; ai < 2; ++ai)
#pragma unroll
            for (int m = 0; m < 4; ++m) { const size_t off = (size_t)(row0 + ai * HALF + m * 16) * DM + col0;
#pragma unroll
                for (int bj = 0; bj < 2; ++bj)
#pragma unroll
                    for (int n = 0; n < 2; ++n) { const f32x4 bs = *(const f32x4*)(base + off + bj * HALF + n * 16); *(f32x4*)(out + off + bj * HALF + n * 16) = bs + gv[bj][n] * acc[ai][bj][m][n]; } }
    }
};

template <bool BASE_F32>
struct EpiResGateB {
    static constexpr bool PERM = true, AFTER_DRAIN = false;
    const void* base; bf16_t* out; const float* gate; float ascale = 1.f;
    __device__ __forceinline__ void operator()(const f32x4 (&acc)[2][2][4][2], const Unit& u, int wr, int wc, int fr, int fq) const {
        const int row0 = u.pm * BM + wr * 64 + fr, col0 = u.pn * BM + wc * 32 + 8 * fq;
        const float* gp = gate + (size_t)((u.pm * BM) / SEQ) * MODB + col0;
        f32x4 gv[2][2];
#pragma unroll
        for (int bj = 0; bj < 2; ++bj)
#pragma unroll
            for (int n = 0; n < 2; ++n) gv[bj][n] = *(const f32x4*)(gp + bj * HALF + n * 4) * ascale;
#pragma unroll
        for (int ai = 0; ai < 2; ++ai)
#pragma unroll
            for (int m = 0; m < 4; ++m) { const size_t off = (size_t)(row0 + ai * HALF + m * 16) * DM + col0;
#pragma unroll
                for (int bj = 0; bj < 2; ++bj) { f32x4 b0, b1;
                    if (BASE_F32) { b0 = *(const f32x4*)((const float*)base + off + bj * HALF); b1 = *(const f32x4*)((const float*)base + off + bj * HALF + 4); }
                    else { const u32x4 w = *(const u32x4*)((const bf16_t*)base + off + bj * HALF);
                        b0 = (f32x4){__uint_as_float(w.x << 16), __uint_as_float(w.x & 0xffff0000u), __uint_as_float(w.y << 16), __uint_as_float(w.y & 0xffff0000u)};
                        b1 = (f32x4){__uint_as_float(w.z << 16), __uint_as_float(w.z & 0xffff0000u), __uint_as_float(w.w << 16), __uint_as_float(w.w & 0xffff0000u)}; }
                    const f32x4 v0 = b0 + gv[bj][0] * acc[ai][bj][m][0], v1 = b1 + gv[bj][1] * acc[ai][bj][m][1];
                    u32x4 o; o.x = cvt_pk_bf16(v0[0], v0[1]); o.y = cvt_pk_bf16(v0[2], v0[3]); o.z = cvt_pk_bf16(v1[0], v1[1]); o.w = cvt_pk_bf16(v1[2], v1[3]);
                    *(u32x4*)(out + off + bj * HALF) = o; } }
    }
};

struct NoGather { static constexpr bool ON = false; __device__ __forceinline__ int tok(int, int) const { return 0; } };
struct LdsGather { static constexpr bool ON = true; const PG8_LAS int* idx; __device__ __forceinline__ int tok(int ui, int r) const { return idx[ui * 256 + r]; } };
typedef int v4i_t __attribute__((ext_vector_type(4)));
typedef int v8i_t __attribute__((ext_vector_type(8)));
template <class Epi, class Sched, bool ALIGN_EPI = false, bool SP2 = false, class Gath = NoGather, bool F8 = false>
__device__ __forceinline__ void gemm_phase(PG8_LAS unsigned char* lds, const Gemm g, const Sched& S, const Epi& E, const Gath GA = Gath()) {
    static_assert(!Gath::ON || SP2, "the row gather is written for the SP2 loop");
    int tid_ = threadIdx.x; asm volatile("" : "+v"(tid_));
    const int tid = tid_, wid = __builtin_amdgcn_readfirstlane(tid >> 6), lane = tid & 63, wr = wid >> 2, wc = wid & 3, fr = lane & 15, fq = lane >> 4;
    const int K = g.K, RB = F8 ? K : 2 * K  , nt = RB / (2 * BK);
    unsigned voffA[2], voffB[2];
#pragma unroll
    for (int i = 0; i < 2; ++i) { int R, C; stage_rc(tid * 16 + i * 8192, R, C); const int Rb = Epi::PERM ? ((R & ~31) + perm32(R & 31)) : R;
        voffA[i] = (unsigned)(R * RB + C * 2); voffB[i] = (unsigned)(Rb * RB + C * 2); }
    unsigned voffG[2][2], voffN[2][2];
#define PG8_GOFF(dst, uidx) do { _Pragma("unroll") for (int i_ = 0; i_ < 2; ++i_) { int R_, C_; stage_rc(tid * 16 + i_ * 8192, R_, C_); _Pragma("unroll") for (int h_ = 0; h_ < 2; ++h_) dst[h_][i_] = (unsigned)(GA.tok(uidx, h_ * HALF + R_) * RB + C_ * 2); } } while (0)
#define PG8_STAGE_A(bufoff, gbase, h, NX) do { if constexpr (Gath::ON) { PG8_STAGE(bufoff, gbase, ((NX) ? voffN : voffG)[h]); } else { PG8_STAGE(bufoff, (gbase) + (h) * hstep, voffA); } } while (0)
    const size_t kstep = (size_t)(BK * 2);
    const size_t hstep = (size_t)HALF * RB;
    const size_t tstep = 2 * hstep;
    const unsigned ldsw = (unsigned)wid * 1024u;
    const int aoff = lds_byte(wr * 64 + fr, fq * 8), boff = lds_byte(wc * 32 + fr, fq * 8);
#define PG8_SA(b, h) (((b) * 2 + (h)) * HTB)
#define PG8_SB(b, h) ((4 + (b) * 2 + (h)) * HTB)
#define PG8_STAGE(bufoff, gbase, voff) do { _Pragma("unroll") for (int _i = 0; _i < 2; ++_i) \
        __builtin_amdgcn_global_load_lds((const unsigned*)((const char*)(gbase) + (voff)[_i]), (PG8_LAS unsigned*)(lds + (bufoff) + ldsw + _i * 8192), 16, 0, 0); } while (0)
#define PG8_LDA(dst, b, h) do { _Pragma("unroll") for (int m = 0; m < 4; ++m) _Pragma("unroll") for (int k = 0; k < 2; ++k) dst[m][k] = *(const PG8_LAS bf16x8*)(lds + PG8_SA(b, h) + aoff + m * 2048 + k * 1024); } while (0)
#define PG8_LDB(dst, b, h) do { _Pragma("unroll") for (int n = 0; n < 2; ++n) _Pragma("unroll") for (int k = 0; k < 2; ++k) dst[n][k] = *(const PG8_LAS bf16x8*)(lds + PG8_SB(b, h) + boff + n * 2048 + k * 1024); } while (0)
#define PG8_CAT8(x) __builtin_shufflevector(__builtin_bit_cast(v4i_t, (x)[0]), __builtin_bit_cast(v4i_t, (x)[1]), 0, 1, 2, 3, 4, 5, 6, 7)
#define PG8_MMA(ai, bj, At, Bt) do { __builtin_amdgcn_s_setprio(1); if constexpr (F8) { _Pragma("unroll") for (int m = 0; m < 4; ++m) _Pragma("unroll") for (int n = 0; n < 2; ++n) \
        asm("v_mfma_f32_16x16x128_f8f6f4 %0, %1, %2, %0" : "+v"(acc[ai][bj][m][n]) : "v"(PG8_CAT8(Bt[n])), "v"(PG8_CAT8(At[m]))); } else { \
        _Pragma("unroll") for (int m = 0; m < 4; ++m) _Pragma("unroll") for (int n = 0; n < 2; ++n) _Pragma("unroll") for (int k = 0; k < 2; ++k) \
        acc[ai][bj][m][n] = __builtin_amdgcn_mfma_f32_16x16x32_bf16(Bt[n][k], At[m][k], acc[ai][bj][m][n], 0, 0, 0); } __builtin_amdgcn_s_setprio(0); } while (0)
#define PG8_WAIT_V(n) asm volatile("s_waitcnt vmcnt(" #n ")" ::: "memory")
#define PG8_WAIT_L(n) asm volatile("s_waitcnt lgkmcnt(" #n ")" ::: "memory")
#define PG8_BAR __builtin_amdgcn_s_barrier()
#define PG8_SCHED __builtin_amdgcn_sched_barrier(0)
    Unit cur, nxt; int ui = 0;
    if (!S.next(0, cur)) return;
    float zf_ = 0.f; asm volatile("" : "+v"(zf_));
    f32x4 acc[2][2][4][2];
#pragma unroll
    for (int a = 0; a < 2; ++a)
#pragma unroll
        for (int b = 0; b < 2; ++b)
#pragma unroll
            for (int m = 0; m < 4; ++m)
#pragma unroll
                for (int n = 0; n < 2; ++n) acc[a][b][m][n] = (f32x4){zf_, zf_, zf_, zf_};
    bf16x8 At[4][2], B0[2][2], B1[2][2];
    const char* cA = (const char*)g.A + (Gath::ON ? (size_t)0 : (size_t)cur.pm * tstep) + (Sched::VARK ? cur.koff : 0); const char* cB = (const char*)g.Bt + (size_t)cur.pnb * tstep + (Sched::VARK ? cur.koff : 0);
    if constexpr (Gath::ON) { PG8_GOFF(voffG, 0); }
    S.a_ready(cur);
    if constexpr (SP2) {
        PG8_STAGE(PG8_SB(0, 0), cB, voffB); PG8_STAGE(PG8_SB(0, 1), cB + hstep, voffB); PG8_STAGE_A(PG8_SA(0, 0), cA, 0, false); PG8_STAGE_A(PG8_SA(0, 1), cA, 1, false);
        if (wr == 1) PG8_BAR;
        PG8_WAIT_V(2); PG8_BAR;
        PG8_STAGE(PG8_SB(1, 0), cB + kstep, voffB); PG8_STAGE_A(PG8_SA(1, 0), cA + kstep, 0, false); PG8_STAGE(PG8_SB(1, 1), cB + hstep + kstep, voffB);
        PG8_WAIT_V(6); PG8_BAR;
    } else {
        PG8_STAGE(PG8_SB(0, 0), cB, voffB); PG8_STAGE(PG8_SA(0, 0), cA, voffA); PG8_STAGE(PG8_SB(0, 1), cB + hstep, voffB); PG8_STAGE(PG8_SA(0, 1), cA + hstep, voffA);
        if (wr == 1) PG8_BAR;
        PG8_WAIT_V(4); PG8_BAR;
        PG8_STAGE(PG8_SB(1, 0), cB + kstep, voffB); PG8_STAGE(PG8_SA(1, 0), cA + kstep, voffA); PG8_STAGE(PG8_SB(1, 1), cB + hstep + kstep, voffB);
        PG8_WAIT_V(6); PG8_BAR;
    }
    for (;;) {
        const bool has_next = S.next(ui + 1, nxt);
        const char* nA = (has_next && !Gath::ON) ? (const char*)g.A + (size_t)nxt.pm * tstep + (Sched::VARK ? nxt.koff : 0) : cA; const char* nB = has_next ? (const char*)g.Bt + (size_t)nxt.pnb * tstep + (Sched::VARK ? nxt.koff : 0) : cB;
        const int ntu = Sched::VARK ? cur.nt : nt;
        for (int t = 0; t < ntu; t += 2) {
            const bool last = (t == ntu - 2);
            const char* a1 = cA + (size_t)(t + 1) * kstep;
            const char* a2 = last ? nA : cA + (size_t)(t + 2) * kstep; const char* b2 = last ? nB : cB + (size_t)(t + 2) * kstep;
            const char* a3 = a2 + kstep; const char* b3 = b2 + kstep;
            if (last && has_next) S.a_ready(nxt);
            if constexpr (Gath::ON) { if (last) { PG8_GOFF(voffN, has_next ? ui + 1 : ui); } }
            if constexpr (SP2) {
            PG8_LDB(B0, 0, 0); PG8_LDB(B1, 0, 1); PG8_SCHED; PG8_LDA(At, 0, 0); PG8_STAGE_A(PG8_SA(1, 1), a1, 1, false);
            PG8_WAIT_V(8); PG8_WAIT_L(0); PG8_BAR; PG8_MMA(0, 0, At, B0); PG8_MMA(0, 1, At, B1); PG8_BAR; PG8_SCHED;
            PG8_LDA(At, 0, 1); PG8_STAGE(PG8_SB(0, 0), b2, voffB); PG8_STAGE(PG8_SB(0, 1), b2 + hstep, voffB); PG8_STAGE_A(PG8_SA(0, 0), a2, 0, last);
            PG8_WAIT_V(8); PG8_WAIT_L(0); PG8_BAR; PG8_MMA(1, 0, At, B0); PG8_MMA(1, 1, At, B1); PG8_BAR; PG8_SCHED;
            PG8_LDB(B0, 1, 0); PG8_LDB(B1, 1, 1); PG8_SCHED; PG8_LDA(At, 1, 0); PG8_STAGE_A(PG8_SA(0, 1), a2, 1, last);
            PG8_WAIT_V(8); PG8_WAIT_L(0); PG8_BAR; PG8_MMA(0, 0, At, B0); PG8_MMA(0, 1, At, B1); PG8_BAR; PG8_SCHED;
            PG8_LDA(At, 1, 1); PG8_STAGE(PG8_SB(1, 0), b3, voffB); PG8_STAGE(PG8_SB(1, 1), b3 + hstep, voffB); PG8_STAGE_A(PG8_SA(1, 0), a3, 0, last);
            PG8_WAIT_V(8); PG8_WAIT_L(0); PG8_BAR; PG8_MMA(1, 0, At, B0); PG8_MMA(1, 1, At, B1); PG8_BAR; PG8_SCHED;
            } else {
            PG8_LDB(B0, 0, 0); PG8_SCHED; PG8_LDA(At, 0, 0); PG8_STAGE(PG8_SA(1, 1), a1 + hstep, voffA);
            PG8_WAIT_L(8); PG8_BAR; PG8_WAIT_L(0); PG8_MMA(0, 0, At, B0); PG8_BAR; PG8_SCHED;
            PG8_LDB(B1, 0, 1); PG8_STAGE(PG8_SB(0, 0), b2, voffB);
            PG8_BAR; PG8_WAIT_L(0); PG8_MMA(0, 1, At, B1); PG8_BAR;
            PG8_LDA(At, 0, 1); PG8_STAGE(PG8_SA(0, 0), a2, voffA);
            PG8_BAR; PG8_WAIT_L(0); PG8_MMA(1, 0, At, B0); PG8_BAR; PG8_SCHED;
            PG8_STAGE(PG8_SB(0, 1), b2 + hstep, voffB);
            PG8_WAIT_V(6); PG8_BAR; PG8_MMA(1, 1, At, B1); PG8_BAR;
            PG8_LDB(B0, 1, 0); PG8_SCHED; PG8_LDA(At, 1, 0); PG8_STAGE(PG8_SA(0, 1), a2 + hstep, voffA);
            PG8_WAIT_L(8); PG8_BAR; PG8_WAIT_L(0); PG8_MMA(0, 0, At, B0); PG8_BAR; PG8_SCHED;
            PG8_LDB(B1, 1, 1); PG8_STAGE(PG8_SB(1, 0), b3, voffB);
            PG8_BAR; PG8_WAIT_L(0); PG8_MMA(0, 1, At, B1); PG8_BAR;
            PG8_LDA(At, 1, 1); PG8_STAGE(PG8_SA(1, 0), a3, voffA);
            PG8_BAR; PG8_WAIT_L(0); PG8_MMA(1, 0, At, B0); PG8_BAR; PG8_SCHED;
            PG8_STAGE(PG8_SB(1, 1), b3 + hstep, voffB);
            PG8_WAIT_V(6); PG8_BAR; PG8_MMA(1, 1, At, B1); PG8_BAR;
            }
        }
        if constexpr (F8) { asm volatile("s_nop 15\n\ts_nop 15" ::: "memory"); PG8_SCHED; }
        if constexpr (ALIGN_EPI) { if (wr == 0) PG8_BAR; }
        if constexpr (!Epi::AFTER_DRAIN) { E(acc, cur, wr, wc, fr, fq); S.done(cur); }
        if (!has_next) break;
#pragma unroll
        for (int a = 0; a < 2; ++a)
#pragma unroll
            for (int b = 0; b < 2; ++b)
#pragma unroll
                for (int m = 0; m < 4; ++m)
#pragma unroll
                    for (int n = 0; n < 2; ++n) acc[a][b][m][n] = (f32x4){zf_, zf_, zf_, zf_};
        cur = nxt; cA = nA; cB = nB; ++ui;
        if constexpr (Gath::ON) { _Pragma("unroll") for (int h_ = 0; h_ < 2; ++h_) _Pragma("unroll") for (int i_ = 0; i_ < 2; ++i_) voffG[h_][i_] = voffN[h_][i_]; }
        if constexpr (ALIGN_EPI) { if (wr == 1) PG8_BAR; }
    }
    PG8_WAIT_V(0);
    if constexpr (!ALIGN_EPI) { if (wr == 0) PG8_BAR; }
    PG8_BAR;
    if constexpr (Epi::AFTER_DRAIN) { E.fused(acc, cur, wr, wc, fr, fq, lds, wid, lane); S.done(cur); }
#undef PG8_SA
#undef PG8_SB
#undef PG8_STAGE
#undef PG8_STAGE_A
#undef PG8_GOFF
#undef PG8_LDA
#undef PG8_LDB
#undef PG8_MMA
#undef PG8_CAT8
#undef PG8_WAIT_V
#undef PG8_WAIT_L
#undef PG8_BAR
#undef PG8_SCHED
}
}

#include <hip/hip_bf16.h>
#include <cmath>
namespace attn_body {
using bf16=__hip_bfloat16;
using bf16x8=__attribute__((ext_vector_type(8)))short;
using s16x4=__attribute__((ext_vector_type(4)))short;
using f32x16=__attribute__((ext_vector_type(16)))float;
using u32x4=__attribute__((ext_vector_type(4)))unsigned;
constexpr int SEQ=8192,D=64,PITCH=2304;
constexpr int NW=8,QBLK=32,QB=QBLK*NW,KVBLK=64,NQB=SEQ/QB;
constexpr int ATTN_UNIT_ROWS=QB;
__device__ __forceinline__ int crow(int r,int hi){return (r&3)+8*(r>>2)+4*hi;}
#define SBAR() __builtin_amdgcn_sched_barrier(0)
__device__ __forceinline__ void bmask(f32x16&p0,f32x16&p1,int T,int qw,int qabs,int hi){
  if(64*T+63-qw<=128 && qw+31-64*T<=128) return;
  const float NEG=-INFINITY; const int kb=64*T+4*hi-qabs;
  #pragma unroll
  for(int r=0;r<16;++r){const int d=kb+(r&3)+8*(r>>2); if(d>128||d<-128)p0[r]=NEG; if(d+32>128||d+32<-128)p1[r]=NEG;}
}
__device__ __forceinline__ void cmask(f32x16&p0,f32x16&p1,int jb,int qrel,int hi){
  const float NEG=-INFINITY; int kb=64*jb+4*hi;
  #pragma unroll
  for(int r=0;r<16;++r){int kv=kb+(r&3)+8*(r>>2); if(kv>qrel)p0[r]=NEG; if(kv+32>qrel)p1[r]=NEG;}
}

constexpr int NSLOT=3, SLOTB=8192;
constexpr int LDS_K=0, LDS_V=NSLOT*SLOTB, LDS_WS=2*NSLOT*SLOTB, LDS_OST=LDS_WS+NW*64*4, LDS_BYTES=LDS_OST+NW*4096;
constexpr float C2=0.125f*1.4426950408889634f;
__device__ __forceinline__ void glds16(const void*gsrc,unsigned lds_dst){unsigned keep;
  asm volatile("s_mov_b32 %0, m0\n\ts_mov_b32 m0, %2\n\ts_nop 0\n\tglobal_load_lds_dwordx4 %1, off\n\ts_mov_b32 m0, %0":"=&s"(keep):"v"(gsrc),"s"(lds_dst):"memory");}
__device__ __forceinline__ void glds16s(const void*sbase,unsigned voff,unsigned lds_dst){unsigned keep;
  asm volatile("s_mov_b32 %0, m0\n\ts_mov_b32 m0, %3\n\ts_nop 0\n\tglobal_load_lds_dwordx4 %1, %2\n\ts_mov_b32 m0, %0":"=&s"(keep):"v"(voff),"s"(sbase),"s"(lds_dst):"memory");}
__device__ __forceinline__ float max3f(float a,float b,float c){float r;asm("v_max3_f32 %0, %1, %2, %3":"=v"(r):"v"(a),"v"(b),"v"(c));return r;}
__device__ __forceinline__ float max2f(float a,float b){float r;asm("v_max_f32_e32 %0, %1, %2":"=v"(r):"v"(a),"v"(b));return r;}
__device__ __forceinline__ float fadd_s(float a,float b){float r;asm("v_add_f32_e32 %0, %1, %2":"=v"(r):"v"(a),"v"(b));return r;}
__device__ __forceinline__ float fsub_s(float a,float b){float r;asm("v_sub_f32_e32 %0, %1, %2":"=v"(r):"v"(a),"v"(b));return r;}
typedef float f32x2_t __attribute__((ext_vector_type(2))); typedef __bf16 bf16x2_t __attribute__((ext_vector_type(2)));
__device__ __forceinline__ unsigned cvtpk_s(float lo,float hi){f32x2_t v={lo,hi};bf16x2_t b=__builtin_convertvector(v,bf16x2_t);return __builtin_bit_cast(unsigned,b);}
#define WAIT_BAR(N) asm volatile("s_waitcnt vmcnt(" #N ") lgkmcnt(0)\n\ts_barrier":::"memory")

__device__ __forceinline__ void qkt(f32x16&p0,f32x16&p1,const char*Kslot,const bf16x8*qr,const f32x16&negm,int r32,int hi){
  const char*kb=Kslot+hi*1024+r32*16;
  #pragma unroll
  for(int d0=0;d0<4;++d0){
    const bf16x8 b0=*reinterpret_cast<const bf16x8*>(kb+d0*2048);
    const bf16x8 b1=*reinterpret_cast<const bf16x8*>(kb+d0*2048+512);
    if(d0==0){p0=__builtin_amdgcn_mfma_f32_32x32x16_bf16(b0,qr[0],negm,0,0,0);p1=__builtin_amdgcn_mfma_f32_32x32x16_bf16(b1,qr[0],negm,0,0,0);}
    else{p0=__builtin_amdgcn_mfma_f32_32x32x16_bf16(b0,qr[d0],p0,0,0,0);p1=__builtin_amdgcn_mfma_f32_32x32x16_bf16(b1,qr[d0],p1,0,0,0);}}
}
typedef __attribute__((address_space(3))) const char* lds_cptr;
typedef short v4i16_t __attribute__((ext_vector_type(4)));
__device__ __forceinline__ void kload8(bf16x8*kf,lds_cptr kp){
  kf[0]=*(const __attribute__((address_space(3))) bf16x8*)(kp);      kf[1]=*(const __attribute__((address_space(3))) bf16x8*)(kp+512);
  kf[2]=*(const __attribute__((address_space(3))) bf16x8*)(kp+2048); kf[3]=*(const __attribute__((address_space(3))) bf16x8*)(kp+2560);
  kf[4]=*(const __attribute__((address_space(3))) bf16x8*)(kp+4096); kf[5]=*(const __attribute__((address_space(3))) bf16x8*)(kp+4608);
  kf[6]=*(const __attribute__((address_space(3))) bf16x8*)(kp+6144); kf[7]=*(const __attribute__((address_space(3))) bf16x8*)(kp+6656);
}
__device__ __forceinline__ void kload2(bf16x8*kf,lds_cptr kp,int j){ kf[2*j]=*(const __attribute__((address_space(3))) bf16x8*)(kp+j*2048); kf[2*j+1]=*(const __attribute__((address_space(3))) bf16x8*)(kp+j*2048+512); }
__device__ __forceinline__ s16x4 vtr(lds_cptr p){ return __builtin_bit_cast(s16x4,__builtin_amdgcn_ds_read_tr16_b64_v4i16((__attribute__((address_space(3))) v4i16_t*)p)); }
__device__ __forceinline__ float rowmax(const f32x16&p0,const f32x16&p1){
  float a=max3f(p0[0],p0[1],p1[0]),b=max3f(p0[2],p0[3],p1[1]);a=max3f(a,p1[2],p1[3]);
  #pragma unroll
  for(int r=4;r<16;r+=4){a=max3f(a,p0[r],p0[r+1]);b=max3f(b,p0[r+2],p0[r+3]);a=max3f(a,p1[r],p1[r+1]);b=max3f(b,p1[r+2],p1[r+3]);}
  const float m=max2f(a,b);
  auto rr=__builtin_amdgcn_permlane32_swap(__float_as_uint(m),__float_as_uint(m),false,false);
  return max2f(__uint_as_float(rr[0]),__uint_as_float(rr[1]));
}
__device__ __forceinline__ void pv(f32x16*o,int vb,bf16x8 pa0,bf16x8 pa1,bf16x8 pa2,bf16x8 pa3){
  #pragma unroll
  for(int d0=0;d0<2;++d0){s16x4 lo[4],hi[4];
    #pragma unroll
    for(int ks=0;ks<4;++ks){
      asm volatile("ds_read_b64_tr_b16 %0,%1 offset:%c2":"=&v"(lo[ks]):"v"(vb),"i"(d0*4096+ks*1024):"memory");
      asm volatile("ds_read_b64_tr_b16 %0,%1 offset:%c2":"=&v"(hi[ks]):"v"(vb),"i"(d0*4096+ks*1024+512):"memory");}
    asm volatile("s_waitcnt lgkmcnt(0)":::"memory");SBAR();
    #define PK(k) (bf16x8){lo[k][0],lo[k][1],lo[k][2],lo[k][3],hi[k][0],hi[k][1],hi[k][2],hi[k][3]}
    o[d0]=__builtin_amdgcn_mfma_f32_32x32x16_bf16(pa0,PK(0),o[d0],0,0,0);
    o[d0]=__builtin_amdgcn_mfma_f32_32x32x16_bf16(pa1,PK(1),o[d0],0,0,0);
    o[d0]=__builtin_amdgcn_mfma_f32_32x32x16_bf16(pa2,PK(2),o[d0],0,0,0);
    o[d0]=__builtin_amdgcn_mfma_f32_32x32x16_bf16(pa3,PK(3),o[d0],0,0,0);
    #undef PK
  }
}

#ifndef ATTN_STORE16
#define ATTN_STORE16(p,v) (*(u32x4*)(p)=(v))
#endif
template<int THRL,bool WIN> __device__ __forceinline__ void attn_unit(const bf16*Qb,const bf16*__restrict__ Kb,const bf16*__restrict__ Vb,bf16*Ob,int opitch,int q0,float sink_l2,char*shm){
  int tid_=threadIdx.x; asm volatile("":"+v"(tid_)); const int tid=tid_,lane=tid&63,r32=lane&31,hi=lane>>5; const int wid=__builtin_amdgcn_readfirstlane(tid>>6);
  const bf16*Qw=Qb+(long)(q0+wid*QBLK)*PITCH;
  const int tq=q0/KVBLK; const int ta=WIN?(tq-2<0?0:tq-2):0; const int tb=WIN?(tq+6>SEQ/KVBLK?SEQ/KVBLK:tq+6):SEQ/KVBLK;
  const int NT=tb-ta; const int s0=WIN?(tq+1-ta):0;
  #define TMAP(t) (WIN?(ta+(((t)+s0>=NT)?(t)+s0-NT:(t)+s0)):(t))
  const unsigned lds0=(unsigned)(uintptr_t)shm;
  float*wsf=(float*)(shm+LDS_WS)+wid*64;
  const bf16*ksrc=Kb+(long)lane*PITCH+wid*8;
  const bf16*vsrc=Vb+(long)(16*(wid&3)+(lane>>2))*PITCH+(wid>>2)*32+(lane&3)*8;
  const unsigned kdst=lds0+LDS_K+wid*1024, vdst=lds0+LDS_V+wid*1024;
  #define DMA_K(t,slot) glds16(ksrc+(long)TMAP(t)*KVBLK*PITCH,(unsigned)__builtin_amdgcn_readfirstlane(kdst+(slot)))
  #define DMA_V(t,slot) glds16(vsrc+(long)TMAP(t)*KVBLK*PITCH,(unsigned)__builtin_amdgcn_readfirstlane(vdst+(slot)))
  const int vb0=(int)(lds0+LDS_V)+((lane>>4)&1)*32+(lane&3)*8+(4*hi+((lane&15)>>2))*64;
  const char*Kbase=shm+LDS_K; bf16x8 kf[8];
  const lds_cptr shm3=(lds_cptr)shm; const lds_cptr kp0=shm3+LDS_K+hi*1024+r32*16; const lds_cptr vp0=shm3+LDS_V+((lane>>4)&1)*32+(lane&3)*8+(4*hi+((lane&15)>>2))*64;
  DMA_K(0,0);DMA_V(0,0);DMA_K(1,SLOTB);
  bf16x8 qr[4];
  #pragma unroll
  for(int d0=0;d0<4;++d0)qr[d0]=*reinterpret_cast<const bf16x8*>(&Qw[(long)r32*PITCH+d0*16+hi*8]);
  float zf_=0.f; asm volatile("":"+v"(zf_)); f32x16 zz_; _Pragma("unroll") for(int r=0;r<16;++r)zz_[r]=zf_;
  float mhat=0.f,l_reg=0.f;f32x16 o[2];o[0]=zz_;o[1]=zz_;f32x16 negm=zz_;asm volatile("":"+v"(negm));
  const int qw=q0+wid*QBLK, qabs=qw+r32;
  #define CMASK(P0,P1,t) do{ if constexpr(WIN) bmask(P0,P1,TMAP(t),qw,qabs,hi); }while(0)
  bool resc=false;
  #define START(P0,P1) do{ const float rm=rowmax(P0,P1); resc=false; \
    { const float dl=rm; mhat=fadd_s(mhat,dl); \
      _Pragma("unroll") for(int r=0;r<16;++r){P0[r]=fsub_s(P0[r],dl);P1[r]=fsub_s(P1[r],dl);} \
      _Pragma("unroll") for(int r=0;r<16;++r)negm[r]=-mhat; asm volatile("":"+v"(negm)); } \
    _Pragma("unroll") for(int r=0;r<16;++r)P0[r]=__builtin_amdgcn_exp2f(P0[r]); }while(0)
  #define RESC() do{ if(resc){ asm volatile("s_waitcnt lgkmcnt(0)":::"memory"); \
      _Pragma("unroll") for(int d_=0;d_<2;++d_) _Pragma("unroll") for(int r=0;r<16;++r)o[d_][r]*=wsf[crow(r,hi)]; } }while(0)
  f32x16 pA0,pA1,pB0,pB1;
  int sl_prev=0,sl_cur=0,sl_next=SLOTB;
  #define ROT() do{sl_prev=sl_cur;sl_cur=sl_next;sl_next=(sl_next==(NSLOT-1)*SLOTB)?0:sl_next+SLOTB;}while(0)
  DMA_K(2,2*SLOTB);
  WAIT_BAR(3);
  qkt(pA0,pA1,Kbase,qr,negm,r32,hi);asm volatile("s_nop 15\n\ts_nop 7":"+v"(pA0),"+v"(pA1));CMASK(pA0,pA1,0);
  START(pA0,pA1);
  _Pragma("unroll") for(int r=0;r<16;++r)pA1[r]=__builtin_amdgcn_exp2f(pA1[r]);
  WAIT_BAR(0);
  DMA_K(3,0);DMA_V(1,SLOTB);
  ROT();
  kload8(kf,kp0+sl_cur);
  WAIT_BAR(2);
  u32x4 pw0,pw1,pw2,pw3; { const unsigned zu_=__float_as_uint(zf_); pw0=(u32x4){zu_,zu_,zu_,zu_}; pw1=pw0; pw2=pw0; pw3=pw0; }
  #define PKW(P,B) cvtpk_s(P[B],P[B+1])
  #define PAF(k) __builtin_bit_cast(bf16x8,pw##k)
  #define VFR(i) (bf16x8){vlo[i][0],vlo[i][1],vlo[i][2],vlo[i][3],vhi[i][0],vhi[i][1],vhi[i][2],vhi[i][3]}
  #define PIN(x) asm volatile("":"+v"(x))
  #define MX3(a,b,c) __builtin_fmaxf(__builtin_fmaxf((a),(b)),(c))
  #define GAPA(MF,A0,A1,A2,A3,W0,W1,PW) do{ MF; sacc+=A0; sacc+=A1; sacc+=A2; sacc+=A3; PIN(sacc); W0; W1; PIN(PW); SBAR(); }while(0)
  #define EX(v) __builtin_amdgcn_exp2f(v)
  #define GAPB(MF,X,B) do{ MF; X[B]=EX(X[B]); X[B+1]=EX(X[B+1]); X[B+2]=EX(X[B+2]); X[B+3]=EX(X[B+3]); PIN(X); SBAR(); }while(0)
  #define VRD(i) do{ vlo[i]=vtr(vp_+(((i)>>2)*4096+((i)&3)*1024)); vhi[i]=vtr(vp_+(((i)>>2)*4096+((i)&3)*1024+512)); }while(0)
  #define KRD(G,j) do{ if(G){ kload2(kf,kp0+sl_next,j); SBAR(); } }while(0)
  #define STEP(C0,C1,P0,P1,t,GK,GV,GL) do{ SBAR(); s16x4 vlo[8],vhi[8]; \
    const lds_cptr vp_=vp0+sl_prev; \
    VRD(0); SBAR(); float sacc=(P0[0]+P0[1]); \
    GAPA(C0=__builtin_amdgcn_mfma_f32_32x32x16_bf16(kf[0],qr[0],negm,0,0,0), P0[2],P0[3],P0[4],P0[5],     pw0[0]=PKW(P0,0), pw0[1]=PKW(P0,2), pw0); \
    VRD(4); SBAR(); GAPA(C1=__builtin_amdgcn_mfma_f32_32x32x16_bf16(kf[1],qr[0],negm,0,0,0), P0[6],P0[7],P0[8],P0[9],     pw0[2]=PKW(P0,4), pw0[3]=PKW(P0,6), pw0); \
    VRD(1); SBAR(); GAPA(C0=__builtin_amdgcn_mfma_f32_32x32x16_bf16(kf[2],qr[1],C0,0,0,0),   P0[10],P0[11],P0[12],P0[13], pw1[0]=PKW(P0,8), pw1[1]=PKW(P0,10), pw1); \
    VRD(5); SBAR(); GAPA(C1=__builtin_amdgcn_mfma_f32_32x32x16_bf16(kf[3],qr[1],C1,0,0,0),   P0[14],P0[15],P1[0],P1[1],   pw1[2]=PKW(P0,12),pw1[3]=PKW(P0,14), pw1); \
    VRD(2); SBAR(); GAPA(C0=__builtin_amdgcn_mfma_f32_32x32x16_bf16(kf[4],qr[2],C0,0,0,0),   P1[2],P1[3],P1[4],P1[5],     pw2[0]=PKW(P1,0), pw2[1]=PKW(P1,2), pw2); \
    VRD(6); SBAR(); GAPA(C1=__builtin_amdgcn_mfma_f32_32x32x16_bf16(kf[5],qr[2],C1,0,0,0),   P1[6],P1[7],P1[8],P1[9],     pw2[2]=PKW(P1,4), pw2[3]=PKW(P1,6), pw2); \
    VRD(3); SBAR(); GAPA(C0=__builtin_amdgcn_mfma_f32_32x32x16_bf16(kf[6],qr[3],C0,0,0,0),   P1[10],P1[11],P1[12],P1[13], pw3[0]=PKW(P1,8), pw3[1]=PKW(P1,10), pw3); \
    VRD(7); SBAR(); GAPA(C1=__builtin_amdgcn_mfma_f32_32x32x16_bf16(kf[7],qr[3],C1,0,0,0),   P1[14],P1[15],0.f,0.f,       pw3[2]=PKW(P1,12),pw3[3]=PKW(P1,14), pw3); \
    l_reg+=sacc; \
    if(GK){DMA_K((t)+3,sl_cur);} if(GV){DMA_V((t)+1,sl_next);} \
    CMASK(C0,C1,t); \
    { float a=MX3(C0[0],C0[1],C1[0]),b=MX3(C0[2],C0[3],C1[1]); a=MX3(a,C1[2],C1[3]); \
      _Pragma("unroll") for(int r=4;r<16;r+=4){a=MX3(a,C0[r],C0[r+1]);b=MX3(b,C0[r+2],C0[r+3]);a=MX3(a,C1[r],C1[r+1]);b=MX3(b,C1[r+2],C1[r+3]);} \
      float rm=__builtin_fmaxf(a,b); { auto rr=__builtin_amdgcn_permlane32_swap(__float_as_uint(rm),__float_as_uint(rm),false,false); rm=__builtin_fmaxf(__uint_as_float(rr[0]),__uint_as_float(rr[1])); } \
      resc=false; \
      if(__builtin_expect(__any(rm>(float)THRL),0)){ const float dl=__builtin_fmaxf(rm,0.f); mhat+=dl; \
        _Pragma("unroll") for(int r=0;r<16;++r){C0[r]-=dl;C1[r]-=dl;} \
        _Pragma("unroll") for(int r=0;r<16;++r)negm[r]=-mhat; asm volatile("":"+v"(negm)); \
        const float f=__builtin_amdgcn_exp2f(-dl); l_reg*=f; if(hi==0)wsf[r32]=f; resc=true; } } \
    SBAR(); \
    GAPB(o[0]=__builtin_amdgcn_mfma_f32_32x32x16_bf16(PAF(0),VFR(0),o[0],0,0,0), C0,0); \
    GAPB(o[1]=__builtin_amdgcn_mfma_f32_32x32x16_bf16(PAF(0),VFR(4),o[1],0,0,0), C0,4); \
    KRD(GL,0); GAPB(o[0]=__builtin_amdgcn_mfma_f32_32x32x16_bf16(PAF(1),VFR(1),o[0],0,0,0), C0,8); \
    KRD(GL,1); GAPB(o[1]=__builtin_amdgcn_mfma_f32_32x32x16_bf16(PAF(1),VFR(5),o[1],0,0,0), C0,12); \
    KRD(GL,2); GAPB(o[0]=__builtin_amdgcn_mfma_f32_32x32x16_bf16(PAF(2),VFR(2),o[0],0,0,0), C1,0); \
    KRD(GL,3); GAPB(o[1]=__builtin_amdgcn_mfma_f32_32x32x16_bf16(PAF(2),VFR(6),o[1],0,0,0), C1,4); \
    GAPB(o[0]=__builtin_amdgcn_mfma_f32_32x32x16_bf16(PAF(3),VFR(3),o[0],0,0,0), C1,8); \
    GAPB(o[1]=__builtin_amdgcn_mfma_f32_32x32x16_bf16(PAF(3),VFR(7),o[1],0,0,0), C1,12); \
    }while(0)
  int t=1;
  for(;t+5<NT;t+=2){
    STEP(pB0,pB1,pA0,pA1,t,true,true,true);     WAIT_BAR(2); RESC(); ROT();
    STEP(pA0,pA1,pB0,pB1,t+1,true,true,true);   WAIT_BAR(2); RESC(); ROT();
  }
  #define ENDW(tt) do{ if((tt)+3<NT){WAIT_BAR(2);} else if((tt)+2<NT){WAIT_BAR(1);} else {WAIT_BAR(0);} }while(0)
  for(;t+1<NT;t+=2){
    STEP(pB0,pB1,pA0,pA1,t,(t+3<NT),(t+1<NT),(t+1<NT));       ENDW(t);   RESC(); ROT();
    STEP(pA0,pA1,pB0,pB1,t+1,(t+4<NT),(t+2<NT),(t+2<NT));     ENDW(t+1); RESC(); ROT();
  }
  STEP(pB0,pB1,pA0,pA1,NT-1,false,false,false); RESC();
  { float sacc=pB0[0]+pB0[1]; _Pragma("unroll") for(int r=2;r<16;++r)sacc+=pB0[r]; _Pragma("unroll") for(int r=0;r<16;++r)sacc+=pB1[r]; l_reg+=sacc;
    pw0=(u32x4){PKW(pB0,0),PKW(pB0,2),PKW(pB0,4),PKW(pB0,6)};pw1=(u32x4){PKW(pB0,8),PKW(pB0,10),PKW(pB0,12),PKW(pB0,14)};pw2=(u32x4){PKW(pB1,0),PKW(pB1,2),PKW(pB1,4),PKW(pB1,6)};pw3=(u32x4){PKW(pB1,8),PKW(pB1,10),PKW(pB1,12),PKW(pB1,14)};
    SBAR(); pv(o,vb0+sl_cur,PAF(0),PAF(1),PAF(2),PAF(3)); }
  #undef PKW
  #undef PAF
  #undef VFR
  #undef PIN
  #undef MX3
  #undef GAPA
  #undef GAPB
  #undef EX
  #undef VRD
  #undef KRD
  #undef STEP
  #undef ENDW
  {auto rr=__builtin_amdgcn_permlane32_swap(__float_as_uint(l_reg),__float_as_uint(l_reg),false,false);l_reg=__uint_as_float(rr[0])+__uint_as_float(rr[1]);}
  if constexpr(WIN) l_reg+=__builtin_amdgcn_exp2f(sink_l2-mhat);
  if(hi==0)wsf[32+r32]=l_reg;asm volatile("s_waitcnt lgkmcnt(0)":::"memory");
  float rli[16];
  #pragma unroll
  for(int r=0;r<16;++r)rli[r]=__builtin_amdgcn_rcpf(wsf[32+crow(r,hi)]);
  bf16*Ow=Ob+(long)(q0+wid*QBLK)*opitch;
  { bf16*stg=(bf16*)(shm+LDS_OST)+wid*2048;
    #pragma unroll
    for(int r=0;r<16;++r){const int orow=crow(r,hi);
      #pragma unroll
      for(int d0=0;d0<2;++d0)stg[orow*64+d0*32+r32]=__float2bfloat16(o[d0][r]*rli[r]);}
    asm volatile("s_waitcnt lgkmcnt(0)":::"memory");
    #pragma unroll
    for(int i=0;i<4;++i){const int row=i*8+(lane>>3),ch=lane&7; const u32x4 v=*(const u32x4*)(stg+row*64+ch*8); ATTN_STORE16(Ow+(long)row*opitch+ch*8,v);} }
  asm volatile("s_waitcnt lgkmcnt(0)\n\ts_barrier":::"memory");
  #undef DMA_K
  #undef TMAP
  #undef DMA_V
  #undef CMASK
  #undef START
  #undef RESC
  #undef ROT
}
constexpr int DSLOT=16384, D_LDS_K=0, D_LDS_V=3*DSLOT, D_LDS_WS=6*DSLOT, D_LDS_Q=D_LDS_WS+NW*256, D_LDS_BYTES=D_LDS_Q+NW*4096;
typedef __attribute__((address_space(3))) char* lds_ptr;
__device__ __forceinline__ void pv4(f32x16*o,int vb,bf16x8 pa0,bf16x8 pa1,bf16x8 pa2,bf16x8 pa3){
  #pragma unroll
  for(int d0=0;d0<4;++d0){s16x4 lo[4],hi[4];
    #pragma unroll
    for(int ks=0;ks<4;++ks){
      asm volatile("ds_read_b64_tr_b16 %0,%1 offset:%c2":"=&v"(lo[ks]):"v"(vb),"i"(d0*4096+ks*1024):"memory");
      asm volatile("ds_read_b64_tr_b16 %0,%1 offset:%c2":"=&v"(hi[ks]):"v"(vb),"i"(d0*4096+ks*1024+512):"memory");}
    asm volatile("s_waitcnt lgkmcnt(0)":::"memory");SBAR();
    #define PK(k) (bf16x8){lo[k][0],lo[k][1],lo[k][2],lo[k][3],hi[k][0],hi[k][1],hi[k][2],hi[k][3]}
    o[d0]=__builtin_amdgcn_mfma_f32_32x32x16_bf16(pa0,PK(0),o[d0],0,0,0);
    o[d0]=__builtin_amdgcn_mfma_f32_32x32x16_bf16(pa1,PK(1),o[d0],0,0,0);
    o[d0]=__builtin_amdgcn_mfma_f32_32x32x16_bf16(pa2,PK(2),o[d0],0,0,0);
    o[d0]=__builtin_amdgcn_mfma_f32_32x32x16_bf16(pa3,PK(3),o[d0],0,0,0);
    #undef PK
  }
}
__device__ __forceinline__ float half_sum(float v){
  #define HS_DPP(ctrl) v+=__builtin_bit_cast(float,__builtin_amdgcn_update_dpp(0,__builtin_bit_cast(int,v),ctrl,0xF,0xF,true))
  HS_DPP(0xB1); HS_DPP(0x4E); HS_DPP(0x141); HS_DPP(0x140);
  #undef HS_DPP
  v+=__builtin_bit_cast(float,__builtin_amdgcn_ds_swizzle(__builtin_bit_cast(int,v),0x401F));
  return v;
}
template<int THRL> __device__ __forceinline__ void dattn_unit(const bf16*Qb,const bf16*__restrict__ Kb,const bf16*__restrict__ Vb,bf16*Ob,int q0,float lam,float omli,const float*subg,char*shm){
  constexpr int OPITCH=1024; constexpr float DEPS=1e-6f;
  int tid_=threadIdx.x; asm volatile("":"+v"(tid_)); const int tid=tid_,lane=tid&63,r32=lane&31,hi=lane>>5; const int wid=__builtin_amdgcn_readfirstlane(tid>>6);
  const int qg=wid>>1,c=wid&1;
  const bf16*Qw=Qb+(long)(q0+qg*QBLK)*PITCH+c*64;
  constexpr int NT=SEQ/KVBLK;
  const unsigned lds0=(unsigned)(uintptr_t)shm;
  float*wsf=(float*)(shm+D_LDS_WS)+wid*64;
  const unsigned ksoff=(unsigned)(lane*PITCH+wid*8)*2u;
  const unsigned vsoff=(unsigned)((16*(wid&3)+(lane>>2))*PITCH+(wid>>2)*32+(lane&3)*8)*2u;
  const unsigned kdst=lds0+D_LDS_K+wid*1024, vdst=lds0+D_LDS_V+wid*1024;
  #define WB(a,b) do{ if(PROBE==20){WAIT_BAR(b);}else{WAIT_BAR(a);} if(PROBE==22){asm volatile("s_barrier":::"memory");} }while(0)
  #define RFL(x) ((unsigned)__builtin_amdgcn_readfirstlane(x))
  #define DMA_K1(t,slot) do{ glds16s(Kb+(long)(t)*KVBLK*PITCH,ksoff,RFL(kdst+(slot))); glds16s(Kb+64+(long)(t)*KVBLK*PITCH,ksoff,RFL(kdst+8192+(slot))); }while(0)
  #define DMA_K(t,slot) do{ DMA_K1(t,slot); if(PROBE==20){DMA_K1(t,slot);} }while(0)
  #define DMA_KA(t,slot) glds16s(Kb+(long)(t)*KVBLK*PITCH,ksoff,RFL(kdst+(slot)))
  #define DMA_KB(t,slot) glds16s(Kb+64+(long)(t)*KVBLK*PITCH,ksoff,RFL(kdst+8192+(slot)))
  #define DMA_VA(t,slot) glds16s(Vb+(long)(t)*KVBLK*PITCH,vsoff,RFL(vdst+(slot)))
  #define DMA_VB(t,slot) glds16s(Vb+64+(long)(t)*KVBLK*PITCH,vsoff,RFL(vdst+8192+(slot)))
  #define DMA_V1(t,slot) do{ glds16s(Vb+(long)(t)*KVBLK*PITCH,vsoff,RFL(vdst+(slot))); glds16s(Vb+64+(long)(t)*KVBLK*PITCH,vsoff,RFL(vdst+8192+(slot))); }while(0)
  #define DMA_V(t,slot) do{ DMA_V1(t,slot); if(PROBE==20){DMA_V1(t,slot);} }while(0)
  const int vb0=(int)(lds0+D_LDS_V)+((lane>>4)&1)*32+(lane&3)*8+(4*hi+((lane&15)>>2))*64;
  const char*Kbase=shm+D_LDS_K+c*8192; bf16x8 kf[8];
  const lds_cptr shm3=(lds_cptr)shm; const lds_cptr kp0=shm3+D_LDS_K+c*8192+hi*1024+r32*16; const lds_cptr vp0=shm3+D_LDS_V+((lane>>4)&1)*32+(lane&3)*8+(4*hi+((lane&15)>>2))*64;
  DMA_K(0,0);DMA_V(0,0);DMA_K(1,DSLOT);
  const __attribute__((address_space(3))) bf16x8*qsp=(const __attribute__((address_space(3))) bf16x8*)((lds_ptr)shm+D_LDS_Q+wid*4096)+lane;
  { bf16x8 qr[4];
    #pragma unroll
    for(int d0=0;d0<4;++d0)qr[d0]=*reinterpret_cast<const bf16x8*>(&Qw[(long)r32*PITCH+d0*16+hi*8]);
    #pragma unroll
    for(int d0=0;d0<4;++d0)((__attribute__((address_space(3))) bf16x8*)qsp)[64*d0]=qr[d0];
    asm volatile("s_waitcnt lgkmcnt(0)":::"memory"); }
  #define QF(d0) (qsp[64*(d0)])
  float zf_=0.f; asm volatile("":"+v"(zf_)); f32x16 zz_; _Pragma("unroll") for(int r=0;r<16;++r)zz_[r]=zf_;
  float mhat=0.f,l_reg=0.f;f32x16 o[4];o[0]=zz_;o[1]=zz_;o[2]=zz_;o[3]=zz_;f32x16 negm=zz_;asm volatile("":"+v"(negm));
  bool resc=false;
  #define START(P0,P1) do{ const float rm=rowmax(P0,P1); resc=false; \
    { const float dl=rm; mhat=fadd_s(mhat,dl); \
      _Pragma("unroll") for(int r=0;r<16;++r){P0[r]=fsub_s(P0[r],dl);P1[r]=fsub_s(P1[r],dl);} \
      _Pragma("unroll") for(int r=0;r<16;++r)negm[r]=-mhat; asm volatile("":"+v"(negm)); } \
    _Pragma("unroll") for(int r=0;r<16;++r)P0[r]=__builtin_amdgcn_exp2f(P0[r]); }while(0)
  #define RESC() do{ if(resc){ asm volatile("s_waitcnt lgkmcnt(0)":::"memory"); \
      _Pragma("unroll") for(int d_=0;d_<4;++d_) _Pragma("unroll") for(int r=0;r<16;++r)o[d_][r]*=wsf[crow(r,hi)]; } }while(0)
  f32x16 pA0,pA1,pB0,pB1;
  int sl_prev=0,sl_cur=0,sl_next=DSLOT;
  #define ROT() do{sl_prev=sl_cur;sl_cur=sl_next;sl_next=(sl_next==2*DSLOT)?0:sl_next+DSLOT;}while(0)
  DMA_K(2,2*DSLOT);
  WB(6,12);
  { bf16x8 qr[4]; _Pragma("unroll") for(int d0=0;d0<4;++d0)qr[d0]=QF(d0); qkt(pA0,pA1,Kbase,qr,negm,r32,hi); }asm volatile("s_nop 15\n\ts_nop 7":"+v"(pA0),"+v"(pA1));
  START(pA0,pA1);
  _Pragma("unroll") for(int r=0;r<16;++r)pA1[r]=__builtin_amdgcn_exp2f(pA1[r]);
  WAIT_BAR(0);
  DMA_K(3,0);DMA_V(1,DSLOT);
  ROT();
  kload8(kf,kp0+sl_cur);
  WB(4,8);
  u32x4 pw0,pw1,pw2,pw3; { const unsigned zu_=__float_as_uint(zf_); pw0=(u32x4){zu_,zu_,zu_,zu_}; pw1=pw0; pw2=pw0; pw3=pw0; }
  #define PKW(P,B) cvtpk_s(P[B],P[B+1])
  #define PAF(k) __builtin_bit_cast(bf16x8,pw##k)
  #define VFR(i) (bf16x8){vlo[i][0],vlo[i][1],vlo[i][2],vlo[i][3],vhi[i][0],vhi[i][1],vhi[i][2],vhi[i][3]}
  #define PIN(x) asm volatile("":"+v"(x))
  #define MX3(a,b,c) __builtin_fmaxf(__builtin_fmaxf((a),(b)),(c))
  #define GAPA(MF,A0,A1,A2,A3,W0,W1,PW) do{ MF; sacc+=A0; sacc+=A1; sacc+=A2; sacc+=A3; PIN(sacc); if(PROBE==23){float d0_; asm volatile("v_add_f32 %0, %1, %1\n\tv_add_f32 %0, %1, %1\n\tv_add_f32 %0, %1, %1\n\tv_add_f32 %0, %1, %1":"=&v"(d0_):"v"(sacc));} W0; W1; PIN(PW); SBAR(); }while(0)
  #define EX(v) __builtin_amdgcn_exp2f(v)
  #define GAPB(MF,X,B) do{ MF; X[B]=EX(X[B]); X[B+1]=EX(X[B+1]); if(PROBE==21){float d0_,d1_; asm volatile("v_exp_f32 %0, %2\n\tv_exp_f32 %1, %3":"=&v"(d0_),"=&v"(d1_):"v"(X[B]),"v"(X[B+1]));} PIN(X); SBAR(); }while(0)
  #define GAPM(MF,OPS) do{ MF; OPS; SBAR(); }while(0)
  #define MXG(X0,X1,r) mxa=MX3(mxa,X0[r],X0[(r)+1]); mxb=MX3(mxb,X0[(r)+2],X0[(r)+3]); mxa=MX3(mxa,X1[r],X1[(r)+1]); mxb=MX3(mxb,X1[(r)+2],X1[(r)+3]); PIN(mxa); PIN(mxb)
  #define GAPE2(MF,X,i0,i1) do{ MF; X[i0]=EX(X[i0]); X[i1]=EX(X[i1]); PIN(X); SBAR(); }while(0)
  #define GAPE3(MF,X,i0,i1,i2) do{ MF; X[i0]=EX(X[i0]); X[i1]=EX(X[i1]); X[i2]=EX(X[i2]); PIN(X); SBAR(); }while(0)
  #define VRD(i) do{ vlo[i]=vtr(vp_+(((i)>>2)*4096+((i)&3)*1024)); vhi[i]=vtr(vp_+(((i)>>2)*4096+((i)&3)*1024+512)); }while(0)
  #define VRD2(i) do{ vlo[i]=vtr(vp_+(((i)>>2)*4096+8192+((i)&3)*1024)); vhi[i]=vtr(vp_+(((i)>>2)*4096+8192+((i)&3)*1024+512)); SBAR(); }while(0)
  #define KRD(G,j) do{ if(G){ kload2(kf,kp0+sl_next,j); SBAR(); } }while(0)
  #define MF32(a,b,cc) __builtin_amdgcn_mfma_f32_32x32x16_bf16(a,b,cc,0,0,0)
  #define STEP(C0,C1,P0,P1,t,GK,GV,GL) do{ SBAR(); s16x4 vlo[8],vhi[8]; \
    const lds_cptr vp_=vp0+sl_prev; \
    VRD(0); SBAR(); float sacc=(P0[0]+P0[1]); \
    GAPA(C0=MF32(kf[0],qa,negm), P0[2],P0[3],P0[4],P0[5],     pw0[0]=PKW(P0,0), pw0[1]=PKW(P0,2), pw0); \
    VRD(4); SBAR(); GAPA(C1=MF32(kf[1],qa,negm), P0[6],P0[7],P0[8],P0[9],     pw0[2]=PKW(P0,4), pw0[3]=PKW(P0,6), pw0); \
    VRD(1); qa=QF(2); SBAR(); GAPA(C0=MF32(kf[2],qb,C0),   P0[10],P0[11],P0[12],P0[13], pw1[0]=PKW(P0,8), pw1[1]=PKW(P0,10), pw1); \
    VRD(5); SBAR(); GAPA(C1=MF32(kf[3],qb,C1),   P0[14],P0[15],P1[0],P1[1],   pw1[2]=PKW(P0,12),pw1[3]=PKW(P0,14), pw1); \
    VRD(2); qb=QF(3); SBAR(); GAPA(C0=MF32(kf[4],qa,C0),   P1[2],P1[3],P1[4],P1[5],     pw2[0]=PKW(P1,0), pw2[1]=PKW(P1,2), pw2); \
    VRD(6); SBAR(); GAPA(C1=MF32(kf[5],qa,C1),   P1[6],P1[7],P1[8],P1[9],     pw2[2]=PKW(P1,4), pw2[3]=PKW(P1,6), pw2); \
    VRD(3); SBAR(); GAPA(C0=MF32(kf[6],qb,C0),   P1[10],P1[11],P1[12],P1[13], pw3[0]=PKW(P1,8), pw3[1]=PKW(P1,10), pw3); \
    VRD(7); SBAR(); GAPA(C1=MF32(kf[7],qb,C1),   P1[14],P1[15],0.f,0.f,       pw3[2]=PKW(P1,12),pw3[3]=PKW(P1,14), pw3); \
    l_reg+=sacc; \
    float mxa,mxb; SBAR(); \
    GAPM(o[0]=MF32(PAF(0),VFR(0),o[0]), mxa=MX3(C0[0],C0[1],C1[0]); mxb=MX3(C0[2],C0[3],C1[1]); mxa=MX3(mxa,C1[2],C1[3]); PIN(mxa); PIN(mxb));  VRD2(0); \
    GAPM(o[1]=MF32(PAF(0),VFR(4),o[1]), MXG(C0,C1,4));  VRD2(4); if(GK){DMA_KA((t)+3,sl_cur);} \
    GAPM(o[0]=MF32(PAF(1),VFR(1),o[0]), MXG(C0,C1,8));  VRD2(1); \
    GAPM(o[1]=MF32(PAF(1),VFR(5),o[1]), MXG(C0,C1,12)); VRD2(5); \
    { float rm=__builtin_fmaxf(mxa,mxb); { auto rr=__builtin_amdgcn_permlane32_swap(__float_as_uint(rm),__float_as_uint(rm),false,false); rm=__builtin_fmaxf(__uint_as_float(rr[0]),__uint_as_float(rr[1])); } \
      resc=false; \
      if(__builtin_expect(__any(rm>(float)THRL),0)){ const float dl=__builtin_fmaxf(rm,0.f); mhat+=dl; \
        _Pragma("unroll") for(int r=0;r<16;++r){C0[r]-=dl;C1[r]-=dl;} \
        _Pragma("unroll") for(int r=0;r<16;++r)negm[r]=-mhat; asm volatile("":"+v"(negm)); \
        const float f=__builtin_amdgcn_exp2f(-dl); l_reg*=f; if(hi==0)wsf[r32]=f; resc=true; } } \
    SBAR(); \
    GAPE3(o[0]=MF32(PAF(2),VFR(2),o[0]), C0,0,1,2);    VRD2(2); \
    GAPE3(o[1]=MF32(PAF(2),VFR(6),o[1]), C0,3,4,5);    VRD2(6); if(GK){DMA_KB((t)+3,sl_cur);} \
    GAPE2(o[0]=MF32(PAF(3),VFR(3),o[0]), C0,6,7);      VRD2(3); \
    GAPE3(o[1]=MF32(PAF(3),VFR(7),o[1]), C0,8,9,10);   VRD2(7); \
    GAPE3(o[2]=MF32(PAF(0),VFR(0),o[2]), C0,11,12,13); \
    GAPE2(o[3]=MF32(PAF(0),VFR(4),o[3]), C0,14,15); if(GV){DMA_VA((t)+1,sl_next);} \
    KRD(GL,0); GAPE3(o[2]=MF32(PAF(1),VFR(1),o[2]), C1,0,1,2); \
    KRD(GL,1); GAPE3(o[3]=MF32(PAF(1),VFR(5),o[3]), C1,3,4,5); \
    KRD(GL,2); GAPE2(o[2]=MF32(PAF(2),VFR(2),o[2]), C1,6,7); \
    KRD(GL,3); GAPE3(o[3]=MF32(PAF(2),VFR(6),o[3]), C1,8,9,10); if(GV){DMA_VB((t)+1,sl_next);} \
    qa=QF(0); SBAR(); GAPE3(o[2]=MF32(PAF(3),VFR(3),o[2]), C1,11,12,13); \
    qb=QF(1); SBAR(); GAPE2(o[3]=MF32(PAF(3),VFR(7),o[3]), C1,14,15); \
    }while(0)
  bf16x8 qa=QF(0),qb=QF(1);
  int t=1;
  for(;t+5<NT;t+=2){
    STEP(pB0,pB1,pA0,pA1,t,true,true,true);     WB(4,8); RESC(); ROT();
    STEP(pA0,pA1,pB0,pB1,t+1,true,true,true);   WB(4,8); RESC(); ROT();
  }
  #define ENDW(tt) do{ if((tt)+3<NT){WB(4,8);} else if((tt)+2<NT){WB(2,4);} else {WAIT_BAR(0);} }while(0)
  for(;t+1<NT;t+=2){
    STEP(pB0,pB1,pA0,pA1,t,(t+3<NT),(t+1<NT),(t+1<NT));       ENDW(t);   RESC(); ROT();
    STEP(pA0,pA1,pB0,pB1,t+1,(t+4<NT),(t+2<NT),(t+2<NT));     ENDW(t+1); RESC(); ROT();
  }
  STEP(pB0,pB1,pA0,pA1,NT-1,false,false,false); RESC();
  { float sacc=pB0[0]+pB0[1]; _Pragma("unroll") for(int r=2;r<16;++r)sacc+=pB0[r]; _Pragma("unroll") for(int r=0;r<16;++r)sacc+=pB1[r]; l_reg+=sacc;
    pw0=(u32x4){PKW(pB0,0),PKW(pB0,2),PKW(pB0,4),PKW(pB0,6)};pw1=(u32x4){PKW(pB0,8),PKW(pB0,10),PKW(pB0,12),PKW(pB0,14)};pw2=(u32x4){PKW(pB1,0),PKW(pB1,2),PKW(pB1,4),PKW(pB1,6)};pw3=(u32x4){PKW(pB1,8),PKW(pB1,10),PKW(pB1,12),PKW(pB1,14)};
    SBAR(); pv4(o,vb0+sl_cur,PAF(0),PAF(1),PAF(2),PAF(3)); }
  #undef PKW
  #undef PAF
  #undef VFR
  #undef PIN
  #undef MX3
  #undef GAPA
  #undef GAPB
  #undef GAPM
  #undef MXG
  #undef GAPE2
  #undef GAPE3
  #undef EX
  #undef VRD
  #undef VRD2
  #undef KRD
  #undef MF32
  #undef QF
  #undef STEP
  #undef ENDW
  {auto rr=__builtin_amdgcn_permlane32_swap(__float_as_uint(l_reg),__float_as_uint(l_reg),false,false);l_reg=__uint_as_float(rr[0])+__uint_as_float(rr[1]);}
  if(hi==0)wsf[32+r32]=l_reg;asm volatile("s_waitcnt lgkmcnt(0)":::"memory");
  float rli[16];
  #pragma unroll
  for(int r=0;r<16;++r)rli[r]=__builtin_amdgcn_rcpf(wsf[32+crow(r,hi)]);
  asm volatile("s_waitcnt lgkmcnt(0)\n\ts_barrier":::"memory");
  int tide_=threadIdx.x; asm volatile("":"+v"(tide_)); const int lane_e=tide_&63;
  __attribute__((address_space(3))) float*xf=(__attribute__((address_space(3))) float*)((lds_ptr)shm+qg*16384)+lane_e;
  if(c==1){
    #pragma unroll
    for(int d_=0;d_<4;++d_)
      #pragma unroll
      for(int r=0;r<16;++r)xf[(d_*16+r)*64]=o[d_][r]*rli[r];
  }
  asm volatile("s_waitcnt lgkmcnt(0)\n\ts_barrier":::"memory");
  if(c==0){
    float ss[16];
    #pragma unroll
    for(int r=0;r<16;++r)ss[r]=0.f;
    #pragma unroll
    for(int d_=0;d_<4;++d_)
      #pragma unroll
      for(int r=0;r<16;++r){const float v=o[d_][r]*rli[r]-lam*xf[(d_*16+r)*64];o[d_][r]=v;ss[r]+=v*v;}
    #pragma unroll
    for(int r=0;r<16;++r){const float s=half_sum(ss[r]);ss[r]=omli/sqrtf(s*(1.f/128.f)+DEPS);}
    __attribute__((address_space(3))) unsigned short*sb=(__attribute__((address_space(3))) unsigned short*)((lds_ptr)shm+65536+qg*8192);
    #pragma unroll
    for(int d_=0;d_<4;++d_){const float g=subg[d_*32+r32];
      #pragma unroll
      for(int r=0;r<16;++r){const float y=o[d_][r]*ss[r]*g; sb[crow(r,hi)*128+d_*32+r32]=(unsigned short)(cvtpk_s(y,y)&0xffffu);}}
    asm volatile("s_waitcnt lgkmcnt(0)":::"memory");
    bf16*Ow=Ob+(long)(q0+qg*QBLK)*OPITCH;
    #pragma unroll
    for(int i=0;i<8;++i){const int row=i*4+(lane_e>>4),ch=lane_e&15; const u32x4 v=*(const __attribute__((address_space(3))) u32x4*)(sb+row*128+ch*8); ATTN_STORE16(Ow+(long)row*OPITCH+ch*8,v);}
  }
  asm volatile("s_waitcnt lgkmcnt(0)\n\ts_barrier":::"memory");
  #undef DMA_K
  #undef DMA_V
  #undef RFL
  #undef WB
  #undef DMA_K1
  #undef DMA_KA
  #undef DMA_KB
  #undef DMA_VA
  #undef DMA_VB
  #undef DMA_V1
  #undef START
  #undef RESC
  #undef ROT
}

typedef int v4i_a __attribute__((ext_vector_type(4)));
typedef int v8i_a __attribute__((ext_vector_type(8)));
#define CAT8A(a,b) __builtin_shufflevector((a),(b),0,1,2,3,4,5,6,7)
template<int THRL> __device__ __forceinline__ void dattn_unit_f8(const unsigned char*P8,const unsigned char*VTh,int h,bf16*Ob,int q0,float lam,float omli,const float*subg,char*shm){
  constexpr int OPITCH=1024,P8P=1536; constexpr float DEPS=1e-6f; constexpr int NT=SEQ/64; constexpr int SLOT=8192,F_K=0,F_V=3*SLOT,F_WS=6*SLOT;
  int tid_=threadIdx.x; asm volatile("":"+v"(tid_)); const int tid=tid_,lane=tid&63,r32=lane&31,hi=lane>>5; const int wid=__builtin_amdgcn_readfirstlane(tid>>6);
  const int qg=wid>>1,c=wid&1;
  const unsigned lds0=(unsigned)(uintptr_t)shm;
  float*wsf=(float*)(shm+F_WS)+wid*64;
  #define RFL(x) ((unsigned)__builtin_amdgcn_readfirstlane(x))
  const unsigned char*Kg=P8+512+h*128;
  const unsigned kvoff=(unsigned)(lane*P8P+(wid&3)*16+(wid>>2)*64);
  const unsigned vvoff=(unsigned)(((wid>>2)*64+lane)*SEQ+(wid&3)*16);
  const unsigned kdst=lds0+F_K+wid*1024, vdst=lds0+F_V+(wid&3)*2048+(wid>>2)*1024;
  #define DMAK(t,slot) glds16s(Kg+(long)(t)*64*P8P,kvoff,RFL(kdst+(slot)))
  #define DMAV(t,slot) glds16s(VTh+(long)(t)*64,vvoff,RFL(vdst+(slot)))
  v8i_a q8; { const unsigned char*Qp=P8+(long)(q0+qg*32+r32)*P8P+h*128+c*64+hi*32; const v4i_a qa=*(const v4i_a*)Qp, qb=*(const v4i_a*)(Qp+16); q8=CAT8A(qa,qb); }
  DMAK(0,0);DMAV(0,0);DMAK(1,SLOT);DMAV(1,SLOT);
  typedef __attribute__((address_space(3))) const v4i_a* lv4;
  const lds_cptr shm3=(lds_cptr)shm; const lds_cptr kp0=shm3+F_K+c*4096+(2*hi)*1024+r32*16, vp0=shm3+F_V+(2*hi)*2048+r32*16;
  float zf_=0.f; asm volatile("":"+v"(zf_)); f32x16 zz_; _Pragma("unroll") for(int r=0;r<16;++r)zz_[r]=zf_;
  float mhat=0.f; f32x16 o[4]; o[0]=zz_;o[1]=zz_;o[2]=zz_;o[3]=zz_; f32x16 lacc=zz_; f32x16 negm=zz_; asm volatile("":"+v"(negm));
  v8i_a ones; { int on_=0x38383838; asm volatile("":"+v"(on_)); _Pragma("unroll") for(int j=0;j<8;++j)ones[j]=on_; }
  #define MFQK(C,KF) asm volatile("v_mfma_f32_32x32x64_f8f6f4 %0, %1, %2, %3":"=&v"(C):"v"(KF),"v"(q8),"v"(negm))
  #define MFPV(O,VF) asm volatile("v_mfma_f32_32x32x64_f8f6f4 %0, %1, %2, %0":"+v"(O):"v"(pw),"v"(VF))
  #define KFRAG(kp) const v8i_a kf0=CAT8A(*(lv4)(kp),*(lv4)((kp)+1024)), kf1=CAT8A(*(lv4)((kp)+512),*(lv4)((kp)+1536))
  #define VFRAG(vp) do{ vf0=CAT8A(*(lv4)(vp),*(lv4)((vp)+2048)); vf1=CAT8A(*(lv4)((vp)+512),*(lv4)((vp)+2560)); vf2=CAT8A(*(lv4)((vp)+1024),*(lv4)((vp)+3072)); vf3=CAT8A(*(lv4)((vp)+1536),*(lv4)((vp)+3584)); }while(0)
  #define SOFTMAX(FIRST,WAITO) do{ const float rm=rowmax(C0,C1); \
    if((FIRST)||__any(rm>(float)THRL)){ const float dl=(FIRST)?rm:__builtin_fmaxf(rm,0.f); mhat+=dl; \
      _Pragma("unroll") for(int r=0;r<16;++r){C0[r]-=dl;C1[r]-=dl;} \
      _Pragma("unroll") for(int r=0;r<16;++r)negm[r]=-mhat; asm volatile("":"+v"(negm)); \
      if(!(FIRST)){ const float f=__builtin_amdgcn_exp2f(-dl); if(hi==0)wsf[r32]=f; \
        if(WAITO){ _Pragma("unroll") for(int rep_=0;rep_<(WAITO);++rep_) asm volatile("s_nop 15\n\ts_nop 15\n\ts_nop 15\n\ts_nop 15\n\ts_nop 15\n\ts_nop 15":"+v"(o[0]),"+v"(o[1]),"+v"(o[2]),"+v"(o[3]),"+v"(lacc)); } \
        asm volatile("s_waitcnt lgkmcnt(0)":::"memory"); \
        _Pragma("unroll") for(int r=0;r<16;++r){ const float fr_=wsf[crow(r,hi)]; o[0][r]*=fr_; o[1][r]*=fr_; o[2][r]*=fr_; o[3][r]*=fr_; lacc[r]*=fr_; } } } \
    _Pragma("unroll") for(int r=0;r<16;++r){C0[r]=__builtin_amdgcn_exp2f(C0[r]);C1[r]=__builtin_amdgcn_exp2f(C1[r]);} \
    _Pragma("unroll") for(int j=0;j<4;++j){ int w0=0,w1=0; \
      w0=__builtin_amdgcn_cvt_pk_fp8_f32(C0[4*j],C0[4*j+1],w0,false); w0=__builtin_amdgcn_cvt_pk_fp8_f32(C0[4*j+2],C0[4*j+3],w0,true); \
      w1=__builtin_amdgcn_cvt_pk_fp8_f32(C1[4*j],C1[4*j+1],w1,false); w1=__builtin_amdgcn_cvt_pk_fp8_f32(C1[4*j+2],C1[4*j+3],w1,true); \
      pw[j]=w0; pw[4+j]=w1; } }while(0)
  #define DRAIN() do{ float d_=lacc[15]; asm volatile("v_mov_b32 %0, %0":"+v"(d_),"+v"(C0),"+v"(C1)::"memory"); }while(0)
  v8i_a pw,vf0,vf1,vf2,vf3; f32x16 C0,C1;
  int sl=0,sl2=2*SLOT;
  #define ROTS() do{ sl=(sl==2*SLOT)?0:sl+SLOT; sl2=(sl2==2*SLOT)?0:sl2+SLOT; }while(0)
  if(wid<LEAD_WAVES){
    WAIT_BAR(2); DMAK(2,sl2);DMAV(2,sl2);
    { KFRAG(kp0); MFQK(C0,kf0); MFQK(C1,kf1); VFRAG(vp0); asm volatile("s_nop 15\n\ts_nop 15":"+v"(C0),"+v"(C1)); SOFTMAX(true,0); }
    ROTS();
    #pragma unroll 1
    for(int t=1;t<NT;++t){
      if(t+1<NT){WAIT_BAR(2);}else{WAIT_BAR(0);}
      if(t+2<NT){DMAK(t+2,sl2);DMAV(t+2,sl2);}
      { KFRAG(kp0+sl); MFQK(C0,kf0); MFQK(C1,kf1); }
      MFPV(o[0],vf0); SBAR();
      asm volatile("":"+v"(C0));
      float ma=max3f(C0[0],C0[1],C0[2]); ma=max3f(ma,C0[3],C0[4]); ma=max3f(ma,C0[5],C0[6]); ma=max3f(ma,C0[7],C0[8]); ma=max3f(ma,C0[9],C0[10]); ma=max3f(ma,C0[11],C0[12]); ma=max3f(ma,C0[13],C0[14]); ma=max2f(ma,C0[15]);
      SBAR(); MFPV(o[1],vf1); SBAR();
      asm volatile("":"+v"(C1));
      float mb=max3f(C1[0],C1[1],C1[2]); mb=max3f(mb,C1[3],C1[4]); mb=max3f(mb,C1[5],C1[6]); mb=max3f(mb,C1[7],C1[8]); mb=max3f(mb,C1[9],C1[10]); mb=max3f(mb,C1[11],C1[12]); mb=max3f(mb,C1[13],C1[14]); mb=max3f(mb,C1[15],ma);
      float rm; { auto rr=__builtin_amdgcn_permlane32_swap(__float_as_uint(mb),__float_as_uint(mb),false,false); rm=max2f(__uint_as_float(rr[0]),__uint_as_float(rr[1])); }
      SBAR(); MFPV(o[2],vf2); SBAR();
      _Pragma("unroll") for(int r=0;r<8;++r)C0[r]=__builtin_amdgcn_exp2f(C0[r]);
      SBAR(); MFPV(o[3],vf3); SBAR();
      _Pragma("unroll") for(int r=8;r<16;++r)C0[r]=__builtin_amdgcn_exp2f(C0[r]);
      SBAR(); MFPV(lacc,ones); SBAR();
      _Pragma("unroll") for(int r=0;r<16;++r)C1[r]=__builtin_amdgcn_exp2f(C1[r]);
      if(__any(rm>(float)THRL)){ const float dl=__builtin_fmaxf(rm,0.f); mhat+=dl;
        _Pragma("unroll") for(int r=0;r<16;++r)negm[r]=-mhat; asm volatile("":"+v"(negm));
        const float f=__builtin_amdgcn_exp2f(-dl); if(hi==0)wsf[r32]=f;
        _Pragma("unroll") for(int r=0;r<16;++r){C0[r]*=f;C1[r]*=f;}
#if RESC_DRAIN
        { const float le_=lacc[15]; float td_;
          asm volatile("v_mov_b32 %5, %6\n\ts_nop 15\n\ts_nop 15":"+v"(o[0]),"+v"(o[1]),"+v"(o[2]),"+v"(o[3]),"+v"(lacc),"=&v"(td_):"v"(le_)); }
#else
        _Pragma("unroll") for(int rep_=0;rep_<RESC_NOPS;++rep_) asm volatile("s_nop 15\n\ts_nop 15\n\ts_nop 15\n\ts_nop 15\n\ts_nop 15\n\ts_nop 15":"+v"(o[0]),"+v"(o[1]),"+v"(o[2]),"+v"(o[3]),"+v"(lacc));
#endif
        asm volatile("s_waitcnt lgkmcnt(0)":::"memory");
        _Pragma("unroll") for(int r=0;r<16;++r){ const float fr_=wsf[crow(r,hi)]; o[0][r]*=fr_; o[1][r]*=fr_; o[2][r]*=fr_; o[3][r]*=fr_; lacc[r]*=fr_; } }
      _Pragma("unroll") for(int j=0;j<4;++j){ int w0=0,w1=0;
        w0=__builtin_amdgcn_cvt_pk_fp8_f32(C0[4*j],C0[4*j+1],w0,false); w0=__builtin_amdgcn_cvt_pk_fp8_f32(C0[4*j+2],C0[4*j+3],w0,true);
        w1=__builtin_amdgcn_cvt_pk_fp8_f32(C1[4*j],C1[4*j+1],w1,false); w1=__builtin_amdgcn_cvt_pk_fp8_f32(C1[4*j+2],C1[4*j+3],w1,true);
        pw[j]=w0; pw[4+j]=w1; }
      VFRAG(vp0+sl);
      ROTS();
    }
    asm volatile("s_waitcnt lgkmcnt(0)":::"memory");
    MFPV(o[0],vf0); MFPV(o[1],vf1); MFPV(o[2],vf2); MFPV(o[3],vf3); MFPV(lacc,ones);
  } else {
    WAIT_BAR(2); DMAK(2,sl2);DMAV(2,sl2);
    { KFRAG(kp0); MFQK(C0,kf0); MFQK(C1,kf1); VFRAG(vp0); asm volatile("s_nop 15\n\ts_nop 15":"+v"(C0),"+v"(C1)); SOFTMAX(true,0); }
    MFPV(o[0],vf0); MFPV(o[1],vf1); MFPV(o[2],vf2); MFPV(o[3],vf3); MFPV(lacc,ones);
    ROTS();
    #pragma unroll 1
    for(int t=1;t<NT;++t){
      if(t+1<NT){WAIT_BAR(2);}else{WAIT_BAR(0);}
      if(t+2<NT){DMAK(t+2,sl2);DMAV(t+2,sl2);}
      { KFRAG(kp0+sl); MFQK(C0,kf0); MFQK(C1,kf1); }
      VFRAG(vp0+sl);
      asm volatile("s_nop 15\n\ts_nop 15":"+v"(C0),"+v"(C1));
      SOFTMAX(false,1);
      MFPV(o[0],vf0); MFPV(o[1],vf1); MFPV(o[2],vf2); MFPV(o[3],vf3); MFPV(lacc,ones);
      ROTS();
    }
  }
  asm volatile("s_nop 15\n\ts_nop 15\n\ts_nop 15\n\ts_nop 15\n\ts_nop 15\n\ts_nop 15":"+v"(o[0]),"+v"(o[1]),"+v"(o[2]),"+v"(o[3]),"+v"(lacc));
  #undef MFQK
  #undef MFPV
  #undef KFRAG
  #undef VFRAG
  #undef SOFTMAX
  #undef ROTS
  #undef DRAIN
  float rli[16];
  #pragma unroll
  for(int r=0;r<16;++r)rli[r]=__builtin_amdgcn_rcpf(lacc[r]);
  asm volatile("s_waitcnt lgkmcnt(0)\n\ts_barrier":::"memory");
  int tide_=threadIdx.x; asm volatile("":"+v"(tide_)); const int lane_e=tide_&63;
  __attribute__((address_space(3))) float*xf=(__attribute__((address_space(3))) float*)((lds_ptr)shm+qg*16384)+lane_e;
  if(c==1){
    #pragma unroll
    for(int d_=0;d_<4;++d_)
      #pragma unroll
      for(int r=0;r<16;++r)xf[(d_*16+r)*64]=o[d_][r]*rli[r];
  }
  asm volatile("s_waitcnt lgkmcnt(0)\n\ts_barrier":::"memory");
  if(c==0){
    float ss[16];
    #pragma unroll
    for(int r=0;r<16;++r)ss[r]=0.f;
    #pragma unroll
    for(int d_=0;d_<4;++d_)
      #pragma unroll
      for(int r=0;r<16;++r){const float v=o[d_][r]*rli[r]-lam*xf[(d_*16+r)*64];o[d_][r]=v;ss[r]+=v*v;}
    #pragma unroll
    for(int r=0;r<16;++r){const float s=half_sum(ss[r]);ss[r]=omli/sqrtf(s*(1.f/128.f)+DEPS);}
    __attribute__((address_space(3))) unsigned short*sb=(__attribute__((address_space(3))) unsigned short*)((lds_ptr)shm+65536+qg*8192);
    #pragma unroll
    for(int d_=0;d_<4;++d_){const float g=subg[d_*32+r32];
      #pragma unroll
      for(int r=0;r<16;++r){const float y=o[d_][r]*ss[r]*g; sb[crow(r,hi)*128+d_*32+r32]=(unsigned short)(cvtpk_s(y,y)&0xffffu);}}
    asm volatile("s_waitcnt lgkmcnt(0)":::"memory");
    bf16*Ow=Ob+(long)(q0+qg*QBLK)*OPITCH;
    #pragma unroll
    for(int i=0;i<8;++i){const int row=i*4+(lane_e>>4),ch=lane_e&15; const u32x4 v=*(const __attribute__((address_space(3))) u32x4*)(sb+row*128+ch*8); ATTN_STORE16(Ow+(long)row*OPITCH+ch*8,v);}
  }
  asm volatile("s_waitcnt lgkmcnt(0)\n\ts_barrier":::"memory");
  #undef RFL
  #undef DMAK
  #undef DMAV
}
#undef CAT8A
constexpr int ATTN_LDS_BYTES=LDS_BYTES;
#undef SBAR
#undef WAIT_BAR
}

constexpr size_t MiB = 1u << 20;
constexpr size_t WS_CTL = 0, CTL_ZERO_BYTES = 1 * MiB;
constexpr size_t WS_MOD = 1 * MiB;
constexpr size_t WS_RC = 2 * MiB, WS_RS = 4 * MiB;
constexpr size_t WS_ROUTE = 6 * MiB, ROUTE_LAYER = 1024 * 1024;
constexpr size_t WS_WIN = 8 * MiB, WS_WOUT = 26 * MiB, WS_WGU_D = 34 * MiB, WS_WD_D = 62 * MiB, WS_WGU_M = 76 * MiB, WS_WD_M = 300 * MiB;
constexpr size_t WS_HA = 412 * MiB;
constexpr size_t WS_PROJ = 444 * MiB;
constexpr size_t WS_ATT = 516 * MiB;
constexpr size_t WS_PROJ8 = 548 * MiB;
constexpr size_t WS_VT = 576 * MiB;
constexpr size_t WS_OD = 548 * MiB;
constexpr size_t WS_HMID = 444 * MiB;
constexpr size_t WS_XS = 682 * MiB;
constexpr size_t WS_XB = 682 * MiB;
constexpr size_t WS_YSP = 716 * MiB;
constexpr size_t WS_YS = 750 * MiB;
constexpr size_t WS_END = 818 * MiB;
static_assert(WS_WD_M + (size_t)2 * NE * DM * FF * 2 <= WS_HA && WS_HMID + (size_t)PMAX * FF * 2 <= WS_XS && WS_XS + (size_t)PMAX * DM * 2 <= WS_YS && WS_YS + (size_t)PMAX * DM * 2 <= WS_END, "d_ws map");
static_assert(WS_XB + (size_t)NTOK * DM * 2 <= WS_YSP && WS_YSP + (size_t)6 * pg8::TAILROWS * DM * 2 <= WS_YS, "d_ws map 3");
static_assert(WS_OD + (size_t)2 * NTOK * 512 * 2 <= WS_HMID + (size_t)NTOK * FF * 2 + 200 * MiB, "d_ws map 2");
constexpr int CW_BAR = 4096;
constexpr int CW_IPDONE = 8192 + 1100;
constexpr int CW_QCTR = 8192 + 1024;
constexpr int CW_CNT = 8192;

constexpr int RING_OFF = 0, RING_BYTES = 135168;
constexpr int LDSCTL_OFF = RING_BYTES, MISC_OFF = LDSCTL_OFF + 320;
constexpr int TAB_OFF = MISC_OFF + 128;
constexpr int IDX_OFF = TAB_OFF + 4 * 176, IDX_UNITS = 16;
constexpr int LDS_BYTES = 155648;
static_assert(16 + NCHUNK_MAX <= 160 && IDX_OFF + IDX_UNITS * 1024 <= LDS_BYTES && (NCHUNK_MAX * (2 * FF / 256) + 255) / 256 <= IDX_UNITS && 8 * 64 * 65 * 4 <= RING_BYTES, "LDS map");

#define GAS __attribute__((address_space(1)))
#define LAS __attribute__((address_space(3)))
typedef unsigned short bf16;
typedef unsigned v4u __attribute__((ext_vector_type(4)));
typedef float f32x4 __attribute__((ext_vector_type(4)));
typedef short bf16x8 __attribute__((ext_vector_type(8)));
typedef GAS unsigned gu32;
typedef GAS unsigned long long gu64;
#define RLX_AGENT __ATOMIC_RELAXED, __HIP_MEMORY_SCOPE_AGENT
#define LDS_WAIT() asm volatile("s_waitcnt lgkmcnt(0)" ::: "memory")
#define VM_WAIT() asm volatile("s_waitcnt vmcnt(0)" ::: "memory")
__device__ __forceinline__ unsigned long long rt() { return __builtin_amdgcn_s_memrealtime(); }
__device__ __forceinline__ unsigned f2bf(float f) { unsigned u = __builtin_bit_cast(unsigned, f); return (u + 0x7fffu + ((u >> 16) & 1u)) >> 16; }
__device__ __forceinline__ unsigned pk2(float lo, float hi) { return f2bf(lo) | (f2bf(hi) << 16); }

#define XB_TMO      128
#define XB_XCNT(j)  (256  + 64 * (j))
#define XB_XSUB(j)  (1280 + 64 * (j))
#define XB_XGEN(j)  (2304 + 64 * (j))
#define XB_TOP      3328
#define XB_TOPGEN   3392
#define XCD_BAR_WORDS 3456
#define XB_SPIN_CAP (1u << 18)

__device__ __forceinline__ unsigned xb_ld(GAS unsigned* p)          { return __hip_atomic_load(p, __ATOMIC_RELAXED, __HIP_MEMORY_SCOPE_AGENT); }
__device__ __forceinline__ unsigned xb_add(GAS unsigned* p, unsigned v) { return __hip_atomic_fetch_add(p, v, __ATOMIC_RELAXED, __HIP_MEMORY_SCOPE_AGENT); }
__device__ __forceinline__ unsigned xb_xcc_id() { return (unsigned)__builtin_amdgcn_s_getreg((3 << 11) | 20) & 0xFu; }
#define XB_SPIN(cond, bar) do { unsigned _sp = 0; while (cond) { __builtin_amdgcn_s_sleep(1); \
    if ((++_sp & 255u) == 0u) { if (xb_ld(&(bar)[XB_TMO])) break; if (_sp > XB_SPIN_CAP) { (void)xb_add(&(bar)[XB_TMO], 1u); break; } } } } while (0)

struct XcdBarrier {
    unsigned* bar; unsigned x;
    volatile LAS unsigned* st;
};

__device__ __forceinline__ XcdBarrier xcd_barrier_post(unsigned* bar, volatile LAS unsigned* st) {
    XcdBarrier b; b.bar = bar; b.x = xb_xcc_id(); b.st = st;
    if (threadIdx.x == 0) (void)xb_add((GAS unsigned*)bar + XB_XCNT(b.x), 1u);
    return b;
}
__device__ __forceinline__ void xcd_barrier_complete(GAS unsigned* bar, unsigned x, unsigned& nloc, unsigned& nx) {
    const unsigned G = gridDim.x * gridDim.y * gridDim.z;
    unsigned sum, cnt, mine, sp = 0u;
    for (;;) {
        sum = 0u; cnt = 0u; mine = 0u;
#pragma unroll
        for (unsigned j = 0; j < 16; ++j) { const unsigned c = xb_ld(&bar[XB_XCNT(j)]); sum += c; cnt += (c > 0u) ? 1u : 0u; mine = (j == x) ? c : mine; }
        if (sum == G) break;
        __builtin_amdgcn_s_sleep(1);
        if ((++sp & 255u) == 0u) { if (xb_ld(&bar[XB_TMO])) break; if (sp > XB_SPIN_CAP) { (void)xb_add(&bar[XB_TMO], 1u); break; } }
    }
    nloc = mine > 0u ? mine : 1u; nx = cnt > 0u ? cnt : 1u;
}

__device__ __forceinline__ void xcd_barrier(const XcdBarrier& b) {
    asm volatile("s_waitcnt vmcnt(0)" ::: "memory");
    __syncthreads();
    if (threadIdx.x == 0) {
        GAS unsigned* bar = (GAS unsigned*)b.bar; unsigned bx_ = b.x; asm volatile("" : "+s"(bar), "+s"(bx_));
        __builtin_amdgcn_s_waitcnt(0);
        unsigned nloc = b.st[0], nx = b.st[1];
        if (nloc == 0u) { xcd_barrier_complete(bar, bx_, nloc, nx); b.st[0] = nloc; b.st[1] = nx; }
        const unsigned old = xb_add(&bar[XB_XSUB(bx_)], 1u);
        const unsigned gen = old / nloc;
        if (old + 1u == (gen + 1u) * nloc) {
            __builtin_amdgcn_fence(__ATOMIC_RELEASE, "agent");
            asm volatile("s_waitcnt vmcnt(0)" ::: "memory");
            const unsigned og = xb_add(&bar[XB_TOP], 1u);
            const unsigned tg = og / nx;
            if (og + 1u == (tg + 1u) * nx) xb_add(&bar[XB_TOPGEN], 1u);
            else XB_SPIN(xb_ld(&bar[XB_TOPGEN]) == tg, bar);
            __builtin_amdgcn_fence(__ATOMIC_ACQUIRE, "agent");
            xb_add(&bar[XB_XGEN(bx_)], 1u);
            asm volatile("s_waitcnt vmcnt(0)" ::: "memory");
        } else {
            XB_SPIN(xb_ld(&bar[XB_XGEN(bx_)]) == gen, bar);
            __builtin_amdgcn_fence(__ATOMIC_ACQUIRE, "agent");
            asm volatile("s_waitcnt vmcnt(0)" ::: "memory");
        }
    }
    __syncthreads();
}


constexpr int NWAVES = 8;
struct Frame {
    LAS unsigned char* lds;
    volatile LAS unsigned* MISC;
    gu32* ctl;
    int tid, lane, wave;
    int vcu, G;
};
__device__ __forceinline__ float wave_sum(float v) {
#define WS_DPP(ctrl) v += __builtin_bit_cast(float, __builtin_amdgcn_update_dpp(0, __builtin_bit_cast(int, v), ctrl, 0xF, 0xF, true))
    WS_DPP(0xB1); WS_DPP(0x4E); WS_DPP(0x141); WS_DPP(0x140);
#undef WS_DPP
    v += __builtin_bit_cast(float, __builtin_amdgcn_ds_swizzle(__builtin_bit_cast(int, v), 0x401F));
    const auto rr = __builtin_amdgcn_permlane32_swap(__builtin_bit_cast(unsigned, v), __builtin_bit_cast(unsigned, v), false, false);
    return __uint_as_float(rr[0]) + __uint_as_float(rr[1]);
}
__device__ __forceinline__ void sincos_acc(float angf, float& s, float& c) {
    const double a = (double)angf;
    const double k = rint(a * 0.63661977236758134308);
    double r = fma(-k, 1.57079632679489655800e+00, a); r = fma(-k, 6.12323399573676603587e-17, r);
    const double r2 = r * r;
    double sp = -2.5052108385441718775e-08; sp = sp * r2 + 2.7557319223985890653e-06; sp = sp * r2 - 1.9841269841269841253e-04; sp = sp * r2 + 8.3333333333333332177e-03; sp = sp * r2 - 1.6666666666666665741e-01;
    const double sn = r + r * r2 * sp;
    double cp = 2.0876756987868098979e-09; cp = cp * r2 - 2.7557319223985888e-07; cp = cp * r2 + 2.4801587301587301566e-05; cp = cp * r2 - 1.3888888888888889419e-03; cp = cp * r2 + 4.1666666666666664354e-02; cp = cp * r2 - 0.5;
    const double cs = 1.0 + r2 * cp;
    const int q = ((int)k) & 3;
    const double ss = (q == 0) ? sn : (q == 1) ? cs : (q == 2) ? -sn : -cs;
    const double cc = (q == 0) ? cs : (q == 1) ? -sn : (q == 2) ? -cs : sn;
    s = (float)ss; c = (float)cc;
}

template <int MAP> __device__ __forceinline__ int rowmap(int n) {
    if (MAP == 1) { const bool rope = (n < COL_VA) || (n >= COL_QD && n < COL_VD); if (!rope) return n; const int d = n & 63; return (n & ~63) + ((d < 32) ? 2 * d : 2 * (d - 32) + 1); }
    if (MAP == 2) return ((n >> 7) << 8) + (n & 127);
    if (MAP == 3) return ((n >> 7) << 8) + 128 + (n & 127);
    return n;
}
template <int MAP, bool F8 = false> __device__ __forceinline__ void cvt_item(const float* W, int K, int N, bf16* WT, LAS float* scr, int item, int lane, float f8s = 1.f) {
    const int kblk = K >> 6, nb = item / kblk, kb = item - nb * kblk, k0 = kb * 64, n0 = nb * 64;
    const GAS float* src = (const GAS float*)W + (size_t)k0 * N + n0 + lane;
    float tv[64];
#pragma unroll
    for (int kk = 0; kk < 64; ++kk) tv[kk] = __builtin_nontemporal_load(src + (size_t)kk * N);
#pragma unroll
    for (int kk = 0; kk < 64; ++kk) scr[kk * 65 + lane] = tv[kk];
    LDS_WAIT(); asm volatile("" ::: "memory");
    const int c = lane & 7;
#pragma unroll
    for (int j = 0; j < 8; ++j) { const int n = (lane >> 3) + 8 * j; const LAS float* s = scr + (8 * c) * 65 + n;
        if (F8) { const unsigned long long o8 = (unsigned long long)pg8::pack4_fp8(s[0 * 65] * f8s, s[1 * 65] * f8s, s[2 * 65] * f8s, s[3 * 65] * f8s) | ((unsigned long long)pg8::pack4_fp8(s[4 * 65] * f8s, s[5 * 65] * f8s, s[6 * 65] * f8s, s[7 * 65] * f8s) << 32);
            *(GAS unsigned long long*)((GAS unsigned char*)WT + (size_t)rowmap<MAP>(n0 + n) * K + k0 + 8 * c) = o8; }
        else { v4u o; o.x = pk2(s[0 * 65], s[1 * 65]); o.y = pk2(s[2 * 65], s[3 * 65]); o.z = pk2(s[4 * 65], s[5 * 65]); o.w = pk2(s[6 * 65], s[7 * 65]);
            *(GAS v4u*)(WT + (size_t)rowmap<MAP>(n0 + n) * K + k0 + 8 * c) = o; } }
    LDS_WAIT(); asm volatile("" ::: "memory");
}
constexpr int IT_IN = (DM / 64) * (INC / 64)  , IT_OUT = (DM / 64) * (DM / 64)  , IT_FF = (DM / 64) * (FF / 64)  ;
constexpr int IT_A = DEPTH * IT_IN, IT_B = IT_A + DEPTH * IT_OUT, IT_SET = 3 * IT_FF, NITEMS = IT_B + 18 * IT_SET;
struct Ptrs {
    const float* in[23]; float* out; unsigned char* ws;
};
struct RopeFreq { float inv[32]; };
struct Args { Ptrs p; RopeFreq rf; float lam_init[4]; int ph_lo, ph_hi; };
typedef const __attribute__((address_space(4))) Args* CArgs;
__device__ __forceinline__ CArgs kargs() { CArgs a = (CArgs)__builtin_amdgcn_kernarg_segment_ptr(); asm volatile("" : "+s"(a)); return a; }
__device__ __forceinline__ void convert_item(CArgs ka, int it, LAS float* scr, int lane) {
    const auto& P = ka->p; unsigned char* ws = P.ws;
    if (it < IT_A) { const int l = it / IT_IN, r = it - l * IT_IN; if (pg8::F8_IN) cvt_item<1, true>(P.in[7] + (size_t)l * DM * INC, DM, INC, (bf16*)(ws + WS_WIN + (size_t)l * INC * DM), scr, r, lane, pg8::F8_SW1); else cvt_item<1>(P.in[7] + (size_t)l * DM * INC, DM, INC, (bf16*)(ws + WS_WIN) + (size_t)l * INC * DM, scr, r, lane); return; }
    if (it < IT_B) { it -= IT_A; const int l = it / IT_OUT, r = it - l * IT_OUT; cvt_item<0>(P.in[8] + (size_t)l * DM * DM, DM, DM, (bf16*)(ws + WS_WOUT) + (size_t)l * DM * DM, scr, r, lane); return; }
    it -= IT_B; const int set = it / IT_SET; int r = it - set * IT_SET; const int kind = r / IT_FF; r -= kind * IT_FF;
    const float *wg, *wu, *wd; bf16 *dgu, *dd;
    bool f1, f2;
    if (set < 2) { f1 = pg8::F8_D1; f2 = pg8::F8_D2; const size_t o = (size_t)set * DM * FF; wg = P.in[15] + o; wu = P.in[16] + o; wd = P.in[17] + o; dgu = (bf16*)(ws + WS_WGU_D + (size_t)set * 2 * FF * DM * (f1 ? 1 : 2)); dd = (bf16*)(ws + WS_WD_D + (size_t)set * DM * FF * (f2 ? 1 : 2)); }
    else { f1 = pg8::F8_M1; f2 = pg8::F8_M2; const size_t o = (size_t)(set - 2) * DM * FF; wg = P.in[19] + o; wu = P.in[20] + o; wd = P.in[21] + o; dgu = (bf16*)(ws + WS_WGU_M + (size_t)(set - 2) * 2 * FF * DM * (f1 ? 1 : 2)); dd = (bf16*)(ws + WS_WD_M + (size_t)(set - 2) * DM * FF * (f2 ? 1 : 2)); }
    if (kind == 0) { if (f1) cvt_item<2, true>(wg, DM, FF, dgu, scr, r, lane, pg8::F8_SW1); else cvt_item<2>(wg, DM, FF, dgu, scr, r, lane); }
    else if (kind == 1) { if (f1) cvt_item<3, true>(wu, DM, FF, dgu, scr, r, lane, pg8::F8_SW1); else cvt_item<3>(wu, DM, FF, dgu, scr, r, lane); }
    else { if (f2) cvt_item<0, true>(wd, FF, DM, dd, scr, r, lane, pg8::F8_SW2); else cvt_item<0>(wd, FF, DM, dd, scr, r, lane); }
}
__device__ __forceinline__ void mod_item(const Frame& F, CArgs ka, int it) {
    const auto& P = ka->p;
    const int l = it / (MODB / 64), cg = it - l * (MODB / 64), col = cg * 64 + F.lane, k0 = F.wave * 128;
    const GAS float* w = (const GAS float*)P.in[3] + (size_t)l * DM * MODB + (size_t)k0 * MODB + col; const float* c = P.in[1] + k0;
    float a0 = 0.f, a1 = 0.f;
#pragma unroll 32
    for (int k = 0; k < 128; ++k) { const float wv = w[(size_t)k * MODB]; const float c0 = c[k], c1 = c[DM + k];
        a0 += (c0 / (1.f + __expf(-c0))) * wv; a1 += (c1 / (1.f + __expf(-c1))) * wv; }
    LAS float* red = (LAS float*)(F.lds + RING_OFF);
    red[(F.wave * 2 + 0) * 64 + F.lane] = a0; red[(F.wave * 2 + 1) * 64 + F.lane] = a1;
    __syncthreads();
    if (F.wave < 2) { float t = P.in[4][l * MODB + col];
#pragma unroll
        for (int w8 = 0; w8 < 8; ++w8) t += red[(w8 * 2 + F.wave) * 64 + F.lane];
        ((float*)(P.ws + WS_MOD))[((size_t)l * 2 + F.wave) * MODB + col] = t; }
    __syncthreads();
}
constexpr int PRO_ITEMS = IT_IN + IT_OUT + IT_SET;
constexpr int Q1 = IT_IN, Q2 = Q1 + IT_OUT, Q3 = Q2 + 8 * IT_SET, Q4 = Q3 + IT_IN, Q5 = Q4 + IT_OUT, Q6 = Q5 + IT_SET, Q7 = Q6 + IT_IN, Q8 = Q7 + IT_OUT, QEND = Q8 + 8 * IT_SET;
constexpr int Q3A = Q2 + 8 * 2 * IT_FF, Q8A = Q8 + 8 * 2 * IT_FF;
static_assert(QEND + PRO_ITEMS == NITEMS, "queue covers every item once");
__device__ __forceinline__ int pro_item(int p) { return p < IT_IN ? p : (p < IT_IN + IT_OUT ? IT_A + (p - IT_IN) : IT_B + (p - IT_IN - IT_OUT)); }
__device__ __forceinline__ int qitem(int q) {
    if (q < Q1) return 1 * IT_IN + q;
    if (q < Q2) return IT_A + 1 * IT_OUT + (q - Q1);
    if (q < Q3) { const int m = q - Q2; if (m < 8 * 2 * IT_FF) return IT_B + (2 + m / (2 * IT_FF)) * IT_SET + m % (2 * IT_FF);
        const int d = m - 8 * 2 * IT_FF; return IT_B + (2 + d / IT_FF) * IT_SET + 2 * IT_FF + d % IT_FF; }
    if (q < Q4) return 2 * IT_IN + (q - Q3);
    if (q < Q5) return IT_A + 2 * IT_OUT + (q - Q4);
    if (q < Q6) return IT_B + 1 * IT_SET + (q - Q5);
    if (q < Q7) return 3 * IT_IN + (q - Q6);
    if (q < Q8) return IT_A + 3 * IT_OUT + (q - Q7);
    { const int m = q - Q8; if (m < 8 * 2 * IT_FF) return IT_B + (10 + m / (2 * IT_FF)) * IT_SET + m % (2 * IT_FF);
      const int d = m - 8 * 2 * IT_FF; return IT_B + (10 + d / IT_FF) * IT_SET + 2 * IT_FF + d % IT_FF; }
}
struct CvtJob { const float* src; bf16* WT; int K, N, n0, k0, map; bool valid; float f8s; };
__device__ __forceinline__ CvtJob make_job(CArgs ka, int q) {
    CvtJob j; j.valid = q < QEND; j.src = nullptr; j.WT = nullptr; j.K = DM; j.N = DM; j.n0 = 0; j.k0 = 0; j.map = 0; j.f8s = 0.f; if (!j.valid) return j;
    const auto& P = ka->p; unsigned char* ws = P.ws; int it = qitem(q), r;
    if (it < IT_A) { const int l = it / IT_IN; r = it - l * IT_IN; j.src = P.in[7] + (size_t)l * DM * INC; j.K = DM; j.N = INC; j.WT = (bf16*)(ws + WS_WIN + (size_t)l * INC * DM * (pg8::F8_IN ? 1 : 2)); j.map = 1; j.f8s = pg8::F8_IN ? pg8::F8_SW1 : 0.f; }
    else if (it < IT_B) { it -= IT_A; const int l = it / IT_OUT; r = it - l * IT_OUT; j.src = P.in[8] + (size_t)l * DM * DM; j.K = DM; j.N = DM; j.WT = (bf16*)(ws + WS_WOUT) + (size_t)l * DM * DM; j.map = 0; }
    else { it -= IT_B; const int set = it / IT_SET; r = it - set * IT_SET; const int kind = r / IT_FF; r -= kind * IT_FF;
        const float *wg, *wu, *wd; bf16 *dgu, *dd;
        bool f1, f2;
        if (set < 2) { f1 = pg8::F8_D1; f2 = pg8::F8_D2; const size_t o = (size_t)set * DM * FF; wg = P.in[15] + o; wu = P.in[16] + o; wd = P.in[17] + o; dgu = (bf16*)(ws + WS_WGU_D + (size_t)set * 2 * FF * DM * (f1 ? 1 : 2)); dd = (bf16*)(ws + WS_WD_D + (size_t)set * DM * FF * (f2 ? 1 : 2)); }
        else { f1 = pg8::F8_M1; f2 = pg8::F8_M2; const size_t o = (size_t)(set - 2) * DM * FF; wg = P.in[19] + o; wu = P.in[20] + o; wd = P.in[21] + o; dgu = (bf16*)(ws + WS_WGU_M + (size_t)(set - 2) * 2 * FF * DM * (f1 ? 1 : 2)); dd = (bf16*)(ws + WS_WD_M + (size_t)(set - 2) * DM * FF * (f2 ? 1 : 2)); }
        if (kind == 0) { j.src = wg; j.K = DM; j.N = FF; j.WT = dgu; j.map = 2; j.f8s = f1 ? pg8::F8_SW1 : 0.f; } else if (kind == 1) { j.src = wu; j.K = DM; j.N = FF; j.WT = dgu; j.map = 3; j.f8s = f1 ? pg8::F8_SW1 : 0.f; } else { j.src = wd; j.K = FF; j.N = DM; j.WT = dd; j.map = 0; j.f8s = f2 ? pg8::F8_SW2 : 0.f; } }
    const int kblk = j.K >> 6, nb = r / kblk, kb = r - nb * kblk; j.k0 = kb * 64; j.n0 = nb * 64;
    return j;
}
__device__ __forceinline__ int rowmap_rt(int map, int n) { return map == 1 ? rowmap<1>(n) : (map == 2 ? rowmap<2>(n) : (map == 3 ? rowmap<3>(n) : n)); }
#define CVT_LOAD(J, tv) do { const GAS float* src_ = (const GAS float*)(J).src + (size_t)(J).k0 * (J).N + (J).n0 + F.lane; const size_t N_ = (size_t)(J).N; \
        _Pragma("unroll") for (int kk = 0; kk < 64; ++kk) tv[kk] = __builtin_nontemporal_load(src_ + (size_t)kk * N_); } while (0)
__device__ __forceinline__ void queue_convert(const Frame& F0, CArgs ka, int limit, int batches, const gu32* stop = nullptr, unsigned stop_at = 0u) {
    Frame F = F0; asm volatile("" : "+v"(F.tid)); F.lane = F.tid & 63;
    gu32* qc = F.ctl + CW_QCTR;
    LAS float* scr = (LAS float*)(F.lds + RING_OFF + F.wave * (64 * 65 * 4));
    volatile LAS int* slot = (volatile LAS int*)(F.lds + LDSCTL_OFF + 16);
    constexpr int SENT = 0x7fffffff;
    __syncthreads();
    if (F.tid == 0) *slot = (int)__hip_atomic_load(qc, __ATOMIC_RELAXED, __HIP_MEMORY_SCOPE_AGENT);
    __syncthreads();
    if (*slot >= limit) return;
#define QC_CLAIM(dst) do { __syncthreads(); \
        if (F.tid == 0) *slot = (stop && __hip_atomic_load(stop, __ATOMIC_RELAXED, __HIP_MEMORY_SCOPE_AGENT) >= stop_at) ? SENT : (int)__hip_atomic_fetch_add(qc, 8u, __ATOMIC_RELAXED, __HIP_MEMORY_SCOPE_AGENT); \
        __syncthreads(); dst = *slot; } while (0)
    int base; QC_CLAIM(base);
    if (base != SENT) {
        CvtJob job = make_job(ka, base + F.wave);
        float tv[64];
        if (job.valid) CVT_LOAD(job, tv);
        for (int nb = 1;; ++nb) {
            int nbase = SENT;
            if (nb < batches && base + 8 < limit) QC_CLAIM(nbase);
            CvtJob nj; nj.valid = false; if (nbase != SENT) nj = make_job(ka, nbase + F.wave);
            if (job.valid) {
#pragma unroll
                for (int kk = 0; kk < 64; ++kk) scr[kk * 65 + F.lane] = tv[kk];
                LDS_WAIT(); asm volatile("" ::: "memory"); }
            if (nj.valid) CVT_LOAD(nj, tv);
            if (job.valid) {
                const int c = F.lane & 7;
#pragma unroll
                for (int j = 0; j < 8; ++j) { const int n = (F.lane >> 3) + 8 * j; const LAS float* sp = scr + (8 * c) * 65 + n;
                    if (job.f8s != 0.f) { const float fs = job.f8s;
                        const unsigned long long o8 = (unsigned long long)pg8::pack4_fp8(sp[0 * 65] * fs, sp[1 * 65] * fs, sp[2 * 65] * fs, sp[3 * 65] * fs) | ((unsigned long long)pg8::pack4_fp8(sp[4 * 65] * fs, sp[5 * 65] * fs, sp[6 * 65] * fs, sp[7 * 65] * fs) << 32);
                        *(GAS unsigned long long*)((GAS unsigned char*)job.WT + (size_t)rowmap_rt(job.map, job.n0 + n) * job.K + job.k0 + 8 * c) = o8; }
                    else { v4u o; o.x = pk2(sp[0 * 65], sp[1 * 65]); o.y = pk2(sp[2 * 65], sp[3 * 65]); o.z = pk2(sp[4 * 65], sp[5 * 65]); o.w = pk2(sp[6 * 65], sp[7 * 65]);
                        *(GAS v4u*)(job.WT + (size_t)rowmap_rt(job.map, job.n0 + n) * job.K + job.k0 + 8 * c) = o; } }
                LDS_WAIT(); asm volatile("" ::: "memory"); }
            if (nbase == SENT) break;
            base = nbase; job = nj;
        }
    }
#undef QC_CLAIM
    __syncthreads();
}
__device__ __forceinline__ void p0_prologue(const Frame& F0, CArgs ka) {
    Frame F = F0; asm volatile("" : "+v"(F.tid)); F.lane = F.tid & 63; const auto& P = ka->p;
    { const int* pos = (const int*)P.in[2]; float* rc = (float*)(P.ws + WS_RC); float* rs = (float*)(P.ws + WS_RS);
      for (int idx = F.vcu * 512 + F.tid; idx < NTOK * 32; idx += F.G * 512) { const int tok = idx >> 5, i = idx & 31; float s, c; sincos_acc((float)pos[tok] * ka->rf.inv[i], s, c); rc[idx] = c; rs[idx] = s; } }
    for (int it = (int)blockIdx.x; it < DEPTH * (MODB / 64); it += F.G) mod_item(F, ka, it);
    LAS float* scr = (LAS float*)(F.lds + RING_OFF + F.wave * (64 * 65 * 4));
    LAS int* ctr = (LAS int*)(F.lds + LDSCTL_OFF);
    const int ipb = (PRO_ITEMS + F.G - 1) / F.G, lo = (int)blockIdx.x * ipb, hi = (lo + ipb < PRO_ITEMS) ? lo + ipb : PRO_ITEMS;
    for (;;) {
        int it = 0; if (F.lane == 0) it = __hip_atomic_fetch_add(ctr, 1, __ATOMIC_RELAXED, __HIP_MEMORY_SCOPE_WORKGROUP);
        it = lo + __builtin_amdgcn_readfirstlane(it);
        if (it >= hi) break;
        convert_item(ka, pro_item(it), scr, F.lane);
    }
    __syncthreads();
}

struct NormArgs {
    const float* xin; float* xout;
    const bf16* xinb; bf16* xoutb;
    const float* g; const float* sh; const float* sc;
    bf16* ha; float* of32;
    const bf16* ys; const float* slot_w; const float* cgate;
    const bf16* ysp; int tail0, tails;
    const float* rw; int* slot_e; int* slot_pos; float* slot_w_out; unsigned* cnt; int* row_list;
    const int* cslot_e; const int* cslot_pos;
    float oscale;
};
template <bool COMBINE, bool MODULATE, bool ROUTER, bool OUT_F32, bool XBF, bool TAILK = false, bool OUT_F8 = false>
__device__ __forceinline__ void norm_phase(const Frame& F0, const NormArgs& A) {
    Frame F = F0; asm volatile("" : "+v"(F.tid)); F.lane = F.tid & 63;
    LAS int* sE = (LAS int*)(F.lds + RING_OFF); LAS int* sR = sE + 128; LAS int* sB = sE + 256;
    for (int rb = F.vcu; rb < NTOK / 64; rb += F.G) {
        const int b = (rb * 64) / SEQ;
        f32x4 gs[4], shv[4], cg[4];
#pragma unroll
        for (int q = 0; q < 4; ++q) { const int col = 4 * F.lane + 256 * q; gs[q] = *(const f32x4*)(A.g + col);
            if (MODULATE) { gs[q] = gs[q] * (1.f + *(const f32x4*)(A.sc + (size_t)b * MODB + col)); shv[q] = *(const f32x4*)(A.sh + (size_t)b * MODB + col); }
            if (COMBINE) cg[q] = *(const f32x4*)(A.cgate + (size_t)b * MODB + col); }
        f32x4 rwv[ROUTER ? 16 : 1][2];
        if (ROUTER) {
#pragma unroll
            for (int q = 0; q < 4; ++q)
#pragma unroll
                for (int t = 0; t < 4; ++t) { const float* wp = A.rw + (size_t)(4 * F.lane + 256 * q + t) * 8; rwv[q * 4 + t][0] = *(const f32x4*)wp; rwv[q * 4 + t][1] = *(const f32x4*)(wp + 4); }
        }
#pragma unroll 1
        for (int j = 0; j < 8; j += 2) {
            const int row0 = rb * 64 + F.wave * 8 + j;
            f32x4 v[2][4];
#pragma unroll
            for (int u = 0; u < 2; ++u) {
                if (XBF) { const GAS unsigned long long* xr = (const GAS unsigned long long*)(A.xinb + (size_t)(row0 + u) * DM) + F.lane;
#pragma unroll
                    for (int q = 0; q < 4; ++q) { const unsigned long long w = xr[64 * q]; const unsigned wl = (unsigned)w, wh = (unsigned)(w >> 32);
                        v[u][q] = (f32x4){__uint_as_float(wl << 16), __uint_as_float(wl & 0xffff0000u), __uint_as_float(wh << 16), __uint_as_float(wh & 0xffff0000u)}; }
                } else { const GAS f32x4* xr = (const GAS f32x4*)(A.xin + (size_t)(row0 + u) * DM) + F.lane;
#pragma unroll
                    for (int q = 0; q < 4; ++q) v[u][q] = xr[64 * q]; } }
            if (COMBINE) {
                unsigned long long ya[2][4], yb[2][4]; float w0[2], w1[2]; int dd0[2], dd1[2];
#pragma unroll
                for (int u = 0; u < 2; ++u) { const int row = row0 + u; const LAS int* tab_ = (const LAS int*)(F.lds + TAB_OFF);
                    const int d0 = tab_[A.cslot_e[row * 2]] + A.cslot_pos[row * 2], d1 = tab_[A.cslot_e[row * 2 + 1]] + A.cslot_pos[row * 2 + 1]; w0[u] = A.slot_w[row * 2]; w1[u] = A.slot_w[row * 2 + 1];
                    dd0[u] = d0; dd1[u] = d1;
                    const GAS unsigned long long* y0 = (const GAS unsigned long long*)(A.ys + (size_t)d0 * DM) + F.lane; const GAS unsigned long long* y1 = (const GAS unsigned long long*)(A.ys + (size_t)d1 * DM) + F.lane;
#pragma unroll
                    for (int q = 0; q < 4; ++q) { ya[u][q] = y0[64 * q]; yb[u][q] = y1[64 * q]; } }
#pragma unroll
                for (int u = 0; u < 2; ++u) { GAS f32x4* xo = (GAS f32x4*)(A.xout + (size_t)(row0 + u) * DM) + F.lane; GAS unsigned long long* xob = (GAS unsigned long long*)(A.xoutb + (size_t)(row0 + u) * DM) + F.lane;
                    f32x4 ta[4], tb[4];
                    if (TAILK) {
#pragma unroll
                        for (int q = 0; q < 4; ++q) { ta[q] = (f32x4){0.f, 0.f, 0.f, 0.f}; tb[q] = ta[q]; }
                        const int t0 = __builtin_amdgcn_readfirstlane(dd0[u]) - A.tail0, t1 = __builtin_amdgcn_readfirstlane(dd1[u]) - A.tail0;
                        if (t0 >= 0) {
#pragma unroll 1
                            for (int k = 0; k < A.tails - 1; ++k) { const GAS unsigned long long* yp = (const GAS unsigned long long*)(A.ysp + ((size_t)k * pg8::TAILROWS + t0) * DM) + F.lane;
#pragma unroll
                                for (int q = 0; q < 4; ++q) { const unsigned long long w = yp[64 * q]; const unsigned wl = (unsigned)w, wh = (unsigned)(w >> 32);
                                    ta[q] = ta[q] + (f32x4){__uint_as_float(wl << 16), __uint_as_float(wl & 0xffff0000u), __uint_as_float(wh << 16), __uint_as_float(wh & 0xffff0000u)}; } } }
                        if (t1 >= 0) {
#pragma unroll 1
                            for (int k = 0; k < A.tails - 1; ++k) { const GAS unsigned long long* yp = (const GAS unsigned long long*)(A.ysp + ((size_t)k * pg8::TAILROWS + t1) * DM) + F.lane;
#pragma unroll
                                for (int q = 0; q < 4; ++q) { const unsigned long long w = yp[64 * q]; const unsigned wl = (unsigned)w, wh = (unsigned)(w >> 32);
                                    tb[q] = tb[q] + (f32x4){__uint_as_float(wl << 16), __uint_as_float(wl & 0xffff0000u), __uint_as_float(wh << 16), __uint_as_float(wh & 0xffff0000u)}; } } }
                    }
#pragma unroll
                    for (int q = 0; q < 4; ++q) {
                        const unsigned al = (unsigned)ya[u][q], ah = (unsigned)(ya[u][q] >> 32), cl = (unsigned)yb[u][q], ch = (unsigned)(yb[u][q] >> 32);
                        f32x4 fa = {__uint_as_float(al << 16), __uint_as_float(al & 0xffff0000u), __uint_as_float(ah << 16), __uint_as_float(ah & 0xffff0000u)};
                        f32x4 fb = {__uint_as_float(cl << 16), __uint_as_float(cl & 0xffff0000u), __uint_as_float(ch << 16), __uint_as_float(ch & 0xffff0000u)};
                        if (TAILK) { fa = fa + ta[q]; fb = fb + tb[q]; }
                        v[u][q] = v[u][q] + cg[q] * (fa * w0[u] + fb * w1[u]);
                        if (!OUT_F32) { if (XBF) xob[64 * q] = (unsigned long long)pk2(v[u][q].x, v[u][q].y) | ((unsigned long long)pk2(v[u][q].z, v[u][q].w) << 32); else xo[64 * q] = v[u][q]; }
                    } }
            }
#pragma unroll
            for (int u = 0; u < 2; ++u) {
                const int row = row0 + u;
                float s = 0.f;
#pragma unroll
                for (int q = 0; q < 4; ++q) s += (v[u][q].x * v[u][q].x + v[u][q].y * v[u][q].y) + (v[u][q].z * v[u][q].z + v[u][q].w * v[u][q].w);
                const float r = 1.f / sqrtf(wave_sum(s) * (1.f / DM) + EPS);
#pragma unroll
                for (int q = 0; q < 4; ++q) {
                    const int col = 4 * F.lane + 256 * q;
                    v[u][q] = v[u][q] * r * gs[q];
                    if (MODULATE) v[u][q] = v[u][q] + shv[q];
                    if (OUT_F32) *(GAS f32x4*)(A.of32 + (size_t)row * DM + col) = (PROBE >= 30) ? v[u][q] * A.oscale : v[u][q];
                    else if (OUT_F8) *(GAS unsigned*)((GAS unsigned char*)A.ha + (size_t)row * DM + col) = pg8::pack4_fp8(v[u][q].x * pg8::F8_SA, v[u][q].y * pg8::F8_SA, v[u][q].z * pg8::F8_SA, v[u][q].w * pg8::F8_SA);
                    else *(GAS unsigned long long*)(A.ha + (size_t)row * DM + col) = (unsigned long long)pk2(v[u][q].x, v[u][q].y) | ((unsigned long long)pk2(v[u][q].z, v[u][q].w) << 32);
                }
                if (ROUTER) {
                    float lg[8];
#pragma unroll
                    for (int e = 0; e < 8; ++e) lg[e] = 0.f;
#pragma unroll
                    for (int q = 0; q < 4; ++q)
#pragma unroll
                        for (int t = 0; t < 4; ++t) { const float hv = v[u][q][t]; const f32x4 w0 = rwv[q * 4 + t][0], w1 = rwv[q * 4 + t][1];
                            lg[0] += hv * w0.x; lg[1] += hv * w0.y; lg[2] += hv * w0.z; lg[3] += hv * w0.w; lg[4] += hv * w1.x; lg[5] += hv * w1.y; lg[6] += hv * w1.z; lg[7] += hv * w1.w; }
#pragma unroll
                    for (int e = 0; e < 8; ++e) lg[e] = wave_sum(lg[e]);
                    if (F.lane == 0) {
                        int e0 = 0; float v0 = lg[0];
#pragma unroll
                        for (int e = 1; e < 8; ++e) if (lg[e] > v0) { v0 = lg[e]; e0 = e; }
                        int e1 = 0; float v1 = -INFINITY;
#pragma unroll
                        for (int e = 0; e < 8; ++e) if (e != e0 && lg[e] > v1) { v1 = lg[e]; e1 = e; }
                        const float p1 = __expf(v1 - v0), inv = 1.f / (1.f + p1);
                        A.slot_w_out[row * 2] = inv; A.slot_w_out[row * 2 + 1] = p1 * inv;
                        sE[(F.wave * 8 + j + u) * 2] = e0; sE[(F.wave * 8 + j + u) * 2 + 1] = e1;
                    }
                }
            }
        }
        if (ROUTER) {
            __syncthreads();
            if (F.tid < 8) { const int e = F.tid; int n = 0; for (int s = 0; s < 128; ++s) if (sE[s] == e) sR[s] = n++;
                sB[e] = n ? (int)__hip_atomic_fetch_add(A.cnt + e, (unsigned)n, __ATOMIC_RELAXED, __HIP_MEMORY_SCOPE_AGENT) : 0; }
            __syncthreads();
            if (F.tid < 128) { const int s = F.tid, tok = rb * 64 + (s >> 1), slot = tok * 2 + (s & 1), e = sE[s], pos = sB[e] + sR[s]; A.slot_e[slot] = e; A.slot_pos[slot] = pos; A.row_list[e * 16384 + pos] = tok; }
            __syncthreads();
        }
    }
}
__device__ __forceinline__ void moe_table(const Frame& F0, const unsigned* cnt) {
    Frame F = F0; asm volatile("" : "+v"(F.tid)); F.lane = F.tid & 63;
    LAS int* tab = (LAS int*)(F.lds + TAB_OFF);
    if (F.tid == 0) { int acc = 0;
        for (int e = 0; e < NE; ++e) { const int c = (int)__hip_atomic_load(cnt + e, __ATOMIC_RELAXED, __HIP_MEMORY_SCOPE_AGENT); tab[e] = acc; tab[160 + e] = c; const int pd = (c + 255) / 256 * 256; for (int ch = acc / 256; ch < (acc + pd) / 256 && ch < NCHUNK_MAX; ++ch) tab[16 + ch] = e; acc += pd; }
        tab[8] = acc / 256 < NCHUNK_MAX ? acc / 256 : NCHUNK_MAX; }
    __syncthreads();
}
__device__ __forceinline__ void gather_phase(const Frame& F0, const bf16* ha, bf16* xs, const int* slot_e, const int* slot_pos, int* dest_of) {
    Frame F = F0; asm volatile("" : "+v"(F.tid)); F.lane = F.tid & 63;
    const LAS int* tab = (const LAS int*)(F.lds + TAB_OFF);
    for (int s = F.vcu * NWAVES + F.wave; s < NTOK * 2; s += F.G * NWAVES) {
        const int tok = s >> 1, e = slot_e[s], dest = tab[e] + slot_pos[s];
        const GAS v4u* src = (const GAS v4u*)(ha + (size_t)tok * DM); GAS v4u* dst = (GAS v4u*)(xs + (size_t)dest * DM);
        const v4u a = src[F.lane], b = src[F.lane + 64]; dst[F.lane] = a; dst[F.lane + 64] = b;
        if (F.lane == 0) dest_of[s] = dest;
    }
}
__device__ __forceinline__ void vt_phase(const Frame& F0, const unsigned char* p8, unsigned char* vt) {
    Frame F = F0; asm volatile("" : "+v"(F.tid)); F.lane = F.tid & 63;
    constexpr int LP = 528;
    LAS unsigned char* tile = (LAS unsigned char*)(F.lds + RING_OFF);
    for (int rb = F.vcu; rb < NTOK / 64; rb += F.G) {
        const int tok0 = rb * 64, b = tok0 / SEQ, t0 = tok0 - b * SEQ;
        __syncthreads();
#pragma unroll
        for (int pss = 0; pss < 4; ++pss) { const int tk = pss * 16 + (F.tid >> 5), ch = F.tid & 31;
            const v4u v = *(const GAS v4u*)(p8 + (size_t)(tok0 + tk) * 1536 + 1024 + ch * 16); *(LAS v4u*)(tile + tk * LP + ch * 16) = v; }
        __syncthreads();
        const int col = F.tid, hh = col >> 7, d = col & 127;
        unsigned w[16];
#pragma unroll
        for (int j = 0; j < 16; ++j) { unsigned acc = 0u;
#pragma unroll
            for (int e = 0; e < 4; ++e) { const int pos = 4 * j + e, hi_ = pos >> 5, tl = (pos >> 4) & 1, r = pos & 15, key = 32 * tl + (r & 3) + 8 * (r >> 2) + 4 * hi_;
                acc |= (unsigned)tile[key * LP + col] << (8 * e); }
            w[j] = acc; }
        GAS v4u* dst = (GAS v4u*)(vt + ((size_t)((b * 4 + hh) * 128 + d)) * SEQ + t0);
#pragma unroll
        for (int q = 0; q < 4; ++q) { v4u o; o.x = w[4 * q]; o.y = w[4 * q + 1]; o.z = w[4 * q + 2]; o.w = w[4 * q + 3]; dst[q] = o; }
    }
    __syncthreads();
}
__device__ __forceinline__ void diff_combine(const Frame& F0, const bf16* od, bf16* att, int b, int h, int q0, float lam, float omli, const float* subg) {
    Frame F = F0; asm volatile("" : "+v"(F.tid)); F.lane = F.tid & 63;
    const float g0 = subg[2 * F.lane], g1 = subg[2 * F.lane + 1];
    for (int j = 0; j < 32; ++j) {
        const int tok = b * SEQ + q0 + F.wave * 32 + j;
        const unsigned w1 = __hip_atomic_load((const unsigned*)(od + (size_t)tok * 512 + h * 128) + F.lane, __ATOMIC_RELAXED, __HIP_MEMORY_SCOPE_AGENT);
        const unsigned w2 = __hip_atomic_load((const unsigned*)(od + ((size_t)NTOK + tok) * 512 + h * 128) + F.lane, __ATOMIC_RELAXED, __HIP_MEMORY_SCOPE_AGENT);
        const float v0 = __uint_as_float(w1 << 16) - lam * __uint_as_float(w2 << 16), v1 = __uint_as_float(w1 & 0xffff0000u) - lam * __uint_as_float(w2 & 0xffff0000u);
        const float r = 1.f / sqrtf(wave_sum(v0 * v0 + v1 * v1) * (1.f / 128.f) + EPS);
        *((GAS unsigned*)(att + (size_t)tok * DM + 512 + h * 128) + F.lane) = pk2(v0 * r * g0 * omli, v1 * r * g1 * omli);
    }
}

#ifndef CONV_NB
#define CONV_NB 64
#endif
#define REP(k) _Pragma("unroll 1") for (int rep_ = 0; rep_ < ((PROBE == (k)) ? 2 : 1); ++rep_)
constexpr int PH_PRO = 0, PH_FINAL = 1 + DEPTH * 10, PH_END = PH_FINAL + 1;
#define WSP(T, off) ((T*)(ws + (off)))
#define IN(k) (lo <= (k) && (k) < hi)
#define SEAM(k) do { if ((k) + 1 < hi) { xcd_barrier(bar); if (PROBE == 12) xcd_barrier(bar); } } while (0)
#define PH() Frame Fp = F; int bx = (int)blockIdx.x; asm volatile("" : "+s"(Fp.G), "+s"(Fp.vcu), "+s"(bx)); constexpr int l = l_, i2 = l_ >> 1; (void)l; (void)i2; (void)bx
template <int L> __device__ __forceinline__ void run_layer(const Frame& F, const XcdBarrier& bar, const int lo, const int hi, unsigned char* lds) {
    constexpr int l_ = L; constexpr int pb = 1 + L * 10; constexpr bool moe = (L & 1) != 0;
        if (IN(pb + 0)) { PH();
            CArgs ka = kargs(); unsigned char* ws = ka->p.ws; const float* ml = WSP(float, WS_MOD) + (size_t)l * 2 * MODB;
            if (l > 0) queue_convert(Fp, ka, l == 1 ? Q2 : (l == 2 ? Q6 : Q8), 1 << 20);
            NormArgs A; A.g = ka->p.in[5] + l * DM; A.sh = ml + 0 * DM; A.sc = ml + 1 * DM; A.ha = WSP(bf16, WS_HA); A.of32 = nullptr;
            A.rw = nullptr; A.slot_e = nullptr; A.slot_pos = nullptr; A.slot_w_out = nullptr; A.cnt = nullptr; A.row_list = nullptr;
            if (l > 0 && ((l - 1) & 1)) {
                unsigned char* pr = ws + WS_ROUTE + (size_t)((l - 1) >> 1) * ROUTE_LAYER;
                A.xin = nullptr; A.xout = nullptr; A.xinb = WSP(bf16, WS_XB); A.xoutb = WSP(bf16, WS_XB); A.ys = WSP(bf16, WS_YS); A.cslot_e = (const int*)pr; A.cslot_pos = (const int*)(pr + 128 * 1024); A.slot_w = (const float*)(pr + 256 * 1024); A.cgate = WSP(float, WS_MOD) + (size_t)(l - 1) * 2 * MODB + 5 * DM;
                moe_table(Fp, (const unsigned*)(F.ctl + CW_CNT + 64 * ((l - 1) >> 1)));
                norm_phase<true, true, false, false, true, false, pg8::F8_IN>(Fp, A);
            } else {
                A.xin = ka->p.in[0]; A.xout = nullptr; A.xinb = WSP(bf16, WS_XB); A.xoutb = nullptr; A.ys = nullptr; A.cslot_e = nullptr; A.cslot_pos = nullptr; A.slot_w = nullptr; A.cgate = nullptr;
                REP(7) norm_phase<false, true, false, false, (L > 0), false, pg8::F8_IN>(Fp, A);
            }
            SEAM(pb + 0);
        }
        if (IN(pb + 1)) { PH();
            CArgs ka = kargs(); unsigned char* ws = ka->p.ws;
            constexpr int nwg = (NTOK / 256) * (INC / 256); const int rounds = (nwg + Fp.G - 1) / Fp.G; int GW = (((nwg + rounds - 1) / rounds) + 7) & ~7; if ((Fp.G & 7) || GW > Fp.G) GW = Fp.G;
            if (bx < GW) {
                constexpr bool FI = pg8::F8_IN;
                pg8::Gemm g{WSP(bf16, WS_HA), (const bf16*)(ws + WS_WIN + (size_t)l * INC * DM * (FI ? 1 : 2)), NTOK, INC, DM}; pg8::StaticOrder S; S.init(NTOK, INC, GW, bx);
                pg8::EpiRope E{WSP(bf16, WS_PROJ), WSP(const float, WS_RC), WSP(const float, WS_RS), FI ? pg8::F8_INV1 : 1.f, pg8::F8_ATT ? ws + WS_PROJ8 : nullptr};
                REP(2) pg8::gemm_phase<pg8::EpiRope, pg8::StaticOrder, true, true, pg8::NoGather, FI>(F.lds + RING_OFF, g, S, E);
                if (GW == Fp.G && (rounds - 1) * Fp.G + bx >= nwg) queue_convert(Fp, kargs(), QEND, 2);
                __syncthreads(); if (threadIdx.x == 0) __hip_atomic_fetch_add(F.ctl + CW_IPDONE + l, 1u, __ATOMIC_RELAXED, __HIP_MEMORY_SCOPE_AGENT);
            } else queue_convert(Fp, kargs(), QEND, CONV_NB, F.ctl + CW_IPDONE + l, (unsigned)GW);
            SEAM(pb + 1);
        }
        if (IN(pb + 2)) { PH();
            if constexpr (pg8::F8_ATT) { CArgs ka = kargs(); unsigned char* ws = ka->p.ws; vt_phase(Fp, ws + WS_PROJ8, ws + WS_VT); if (hi - lo > 1) xcd_barrier(bar); }
            REP(3) for (int su = Fp.vcu; su < 256; su += Fp.G) {
                const int bh = su >> 5, b = bh >> 2, h = bh & 3, q0 = (su & 31) * 256;
#pragma unroll 1
                for (int u2 = 0; u2 < 2; ++u2) {
                    CArgs ka = kargs(); unsigned char* ws = ka->p.ws; const attn_body::bf16* pj = WSP(const attn_body::bf16, WS_PROJ) + (size_t)b * SEQ * INC;
                    const int ln = (int)(threadIdx.x & 63); const float li = ka->lam_init[l];
                    const float lam = __expf(wave_sum(ka->p.in[10][l * 64 + ln] * ka->p.in[11][l * 64 + ln])) - __expf(wave_sum(ka->p.in[12][l * 64 + ln] * ka->p.in[13][l * 64 + ln])) + li;
                    if constexpr (pg8::F8_ATT) attn_body::dattn_unit_f8<8>(ws + WS_PROJ8 + (size_t)b * SEQ * 1536, ws + WS_VT + (size_t)(b * 4 + h) * 128 * SEQ, h,
                        WSP(attn_body::bf16, WS_ATT) + (size_t)b * SEQ * DM + 512 + h * 128, q0 + u2 * 128, lam, 1.f - li, ka->p.in[14] + l * 128, (char*)lds + RING_OFF);
                    else attn_body::dattn_unit<8>(pj + COL_QD + h * 128, pj + COL_KD + h * 128, pj + COL_VD + h * 128,
                        WSP(attn_body::bf16, WS_ATT) + (size_t)b * SEQ * DM + 512 + h * 128, q0 + u2 * 128, lam, 1.f - li, ka->p.in[14] + l * 128, (char*)lds + RING_OFF);
                }
#pragma unroll 1
                for (int i_ = 0; i_ < ((PROBE == 13) ? 6 : 2); ++i_) { const int i = i_ & 1;
                    CArgs ka = kargs(); unsigned char* ws = ka->p.ws; const attn_body::bf16* pj = WSP(const attn_body::bf16, WS_PROJ) + (size_t)b * SEQ * INC;
                    const int hq = 2 * h + i, hkv = hq >> 2;
                    attn_body::attn_unit<8, true>(pj + COL_QA + hq * 64, pj + COL_KA + hkv * 64, pj + COL_VA + hkv * 64,
                        WSP(attn_body::bf16, WS_ATT) + (size_t)b * SEQ * DM + hq * 64, DM, q0, ka->p.in[9][l * 8 + hq] * 1.4426950408889634f, (char*)lds + RING_OFF);
                }
            }
            SEAM(pb + 2);
        }
        if (IN(pb + 3)) { PH();
            CArgs ka = kargs(); unsigned char* ws = ka->p.ws; const float* ml = WSP(float, WS_MOD) + (size_t)l * 2 * MODB;
            pg8::Gemm g{WSP(bf16, WS_ATT), WSP(const bf16, WS_WOUT) + (size_t)l * DM * DM, NTOK, DM, DM}; pg8::StaticOrder S; S.init(NTOK, DM, Fp.G, bx);
            using EpiO = pg8::EpiResGateB<(L == 0)>;
            EpiO E{(l == 0) ? (const void*)ka->p.in[0] : (const void*)WSP(bf16, WS_XB), WSP(pg8::bf16_t, WS_XB), ml + 2 * DM};
            pg8::gemm_phase<EpiO, pg8::StaticOrder, true, true>(F.lds + RING_OFF, g, S, E);
            SEAM(pb + 3);
        }
        if (IN(pb + 4)) { PH();
            CArgs ka = kargs(); unsigned char* ws = ka->p.ws; const float* ml = WSP(float, WS_MOD) + (size_t)l * 2 * MODB;
            unsigned char* route = ws + WS_ROUTE + (size_t)i2 * ROUTE_LAYER;
            NormArgs A; A.xin = nullptr; A.xout = nullptr; A.xinb = WSP(bf16, WS_XB); A.xoutb = nullptr; A.g = ka->p.in[6] + l * DM; A.sh = ml + 3 * DM; A.sc = ml + 4 * DM; A.ha = WSP(bf16, WS_HA); A.of32 = nullptr;
            A.ys = nullptr; A.cslot_e = nullptr; A.cslot_pos = nullptr; A.slot_w = nullptr; A.cgate = nullptr; A.row_list = nullptr;
            if (moe) { A.rw = ka->p.in[18] + (size_t)i2 * DM * NE; A.slot_e = (int*)route; A.slot_pos = (int*)(route + 128 * 1024); A.slot_w_out = (float*)(route + 256 * 1024); A.cnt = (unsigned*)(F.ctl + CW_CNT + 64 * i2); A.row_list = (int*)(route + 512 * 1024); norm_phase<false, true, true, false, true, false, pg8::F8_M1>(Fp, A);
                queue_convert(Fp, ka, l == 1 ? Q3A : Q8A, 1 << 20); }
            else { A.rw = nullptr; A.slot_e = nullptr; A.slot_pos = nullptr; A.slot_w_out = nullptr; A.cnt = nullptr; REP(11) norm_phase<false, true, false, false, true, false, pg8::F8_D1>(Fp, A); }
            SEAM(pb + 4);
        }
        if constexpr (!moe) {
            if (IN(pb + 5)) { PH();
                CArgs ka = kargs(); unsigned char* ws = ka->p.ws;
                constexpr bool F1 = pg8::F8_D1, F2 = pg8::F8_D2;
                pg8::Gemm g{WSP(bf16, WS_HA), (const bf16*)(ws + WS_WGU_D + (size_t)i2 * 2 * FF * DM * (F1 ? 1 : 2)), NTOK, 2 * FF, DM}; pg8::StaticOrder S; S.init(NTOK, 2 * FF, Fp.G, bx);
                if constexpr (F2) { pg8::EpiSwigluF8 E{ws + WS_HMID, FF, F1 ? pg8::F8_INV1 : 1.f, pg8::F8_SH}; REP(4) pg8::gemm_phase<pg8::EpiSwigluF8, pg8::StaticOrder, true, true, pg8::NoGather, F1>(F.lds + RING_OFF, g, S, E); }
                else { pg8::EpiSwiglu E{WSP(bf16, WS_HMID), FF, F1 ? pg8::F8_INV1 : 1.f}; REP(4) pg8::gemm_phase<pg8::EpiSwiglu, pg8::StaticOrder, true, true, pg8::NoGather, F1>(F.lds + RING_OFF, g, S, E); }
                SEAM(pb + 5);
            }
            if (IN(pb + 6)) { PH();
                CArgs ka = kargs(); unsigned char* ws = ka->p.ws; const float* ml = WSP(float, WS_MOD) + (size_t)l * 2 * MODB;
                constexpr bool F2 = pg8::F8_D2;
                pg8::Gemm g{WSP(bf16, WS_HMID), (const bf16*)(ws + WS_WD_D + (size_t)i2 * DM * FF * (F2 ? 1 : 2)), NTOK, DM, FF}; pg8::StaticOrder S; S.init(NTOK, DM, Fp.G, bx);
                using EpiF = pg8::EpiResGateB<false>;
                EpiF E{(const void*)WSP(bf16, WS_XB), WSP(pg8::bf16_t, WS_XB), ml + 5 * DM, F2 ? pg8::F8_INV2 : 1.f};
                pg8::gemm_phase<EpiF, pg8::StaticOrder, true, true, pg8::NoGather, F2>(F.lds + RING_OFF, g, S, E);
                SEAM(pb + 6);
            }
        } else {
            const int* tabp = (const int*)(lds + TAB_OFF);
            if (IN(pb + 6)) { PH();
                CArgs ka = kargs(); unsigned char* ws = ka->p.ws;
                moe_table(Fp, (const unsigned*)(F.ctl + CW_CNT + 64 * i2)); const int nch = tabp[8];
                constexpr bool F1 = pg8::F8_M1, F2 = pg8::F8_M2;
                pg8::Gemm g{WSP(bf16, WS_HA), (const bf16*)(ws + WS_WGU_M + (size_t)i2 * NE * 2 * FF * DM * (F1 ? 1 : 2)), nch * 256, 2 * FF, DM}; pg8::StaticOrder S; S.init(nch * 256, 2 * FF, Fp.G, bx, tabp + 16);
                { const int* rl = (const int*)(ws + WS_ROUTE + (size_t)i2 * ROUTE_LAYER + 512 * 1024); LAS int* idx = (LAS int*)(F.lds + IDX_OFF); const LAS int* tb = (const LAS int*)(F.lds + TAB_OFF);
                  pg8::Unit uu; int tl_ = (int)threadIdx.x; asm volatile("" : "+v"(tl_));
                  for (int i = 0; i < IDX_UNITS && S.next(i, uu); ++i) {
                      const int e = tb[16 + uu.pm], rbase = (uu.pm << 8) - tb[e], cnt_e = tb[160 + e];
                      if (tl_ < 256) { const int rr = rbase + tl_; idx[i * 256 + tl_] = rr < cnt_e ? rl[e * 16384 + rr] : 0; } }
                  __syncthreads(); }
                pg8::LdsGather GA{(const LAS int*)(F.lds + IDX_OFF)};
                if constexpr (F2) { pg8::EpiSwigluF8 E{ws + WS_HMID, FF, F1 ? pg8::F8_INV1 : 1.f, pg8::F8_SH}; REP(5) pg8::gemm_phase<pg8::EpiSwigluF8, pg8::StaticOrder, true, true, pg8::LdsGather, F1>(F.lds + RING_OFF, g, S, E, GA); }
                else { pg8::EpiSwiglu E{WSP(bf16, WS_HMID), FF, F1 ? pg8::F8_INV1 : 1.f}; REP(5) pg8::gemm_phase<pg8::EpiSwiglu, pg8::StaticOrder, true, true, pg8::LdsGather, F1>(F.lds + RING_OFF, g, S, E, GA); }
                queue_convert(Fp, kargs(), l == 1 ? Q3 : QEND, 1 << 20);
                SEAM(pb + 6);
            }
            if (IN(pb + 7)) { PH();
                CArgs ka = kargs(); unsigned char* ws = ka->p.ws;
                moe_table(Fp, (const unsigned*)(F.ctl + CW_CNT + 64 * i2)); const int nch = tabp[8];
                constexpr bool F2 = pg8::F8_M2; constexpr int KT = F2 ? 128 : 64;
                pg8::Gemm g{WSP(bf16, WS_HMID), (const bf16*)(ws + WS_WD_M + (size_t)i2 * NE * DM * FF * (F2 ? 1 : 2)), nch * 256, DM, FF};
                if constexpr (L == DEPTH - 1) {
                    pg8::TailOrder S; S.init(nch, DM, FF * 64 / KT, Fp.G, bx, Fp.vcu, tabp + 16);
                    pg8::EpiBf16T E{WSP(pg8::bf16_t, WS_YS), DM, WSP(pg8::bf16_t, WS_YSP), S.pm0, F2 ? pg8::F8_INV2 : 1.f};
                    pg8::gemm_phase<pg8::EpiBf16T, pg8::TailOrder, true, true, pg8::NoGather, F2>(F.lds + RING_OFF, g, S, E);
                } else {
                    pg8::StaticOrder S; S.init(nch * 256, DM, Fp.G, bx, tabp + 16);
                    pg8::EpiBf16 E{WSP(bf16, WS_YS), DM, F2 ? pg8::F8_INV2 : 1.f};
                    REP(6) pg8::gemm_phase<pg8::EpiBf16, pg8::StaticOrder, true, true, pg8::NoGather, F2>(F.lds + RING_OFF, g, S, E);
                    { const int nwg = nch * (DM / 256), rounds = (nwg + Fp.G - 1) / Fp.G; if ((rounds - 1) * Fp.G + bx >= nwg) queue_convert(Fp, kargs(), QEND, 7); }
                }
                SEAM(pb + 7);
            }
        }
}

__global__ void __launch_bounds__(NWAVES * 64, 2) mk_fwd(Args args_by_value_unused) {
    extern __shared__ __attribute__((aligned(16))) unsigned char lds[];
    Frame F;
    F.lds = (LAS unsigned char*)lds;
    F.MISC = (volatile LAS unsigned*)(F.lds + MISC_OFF);
    F.tid = threadIdx.x; F.lane = F.tid & 63; F.wave = __builtin_amdgcn_readfirstlane(F.tid >> 6);
    F.G = gridDim.x; { const int bx = blockIdx.x; F.vcu = (F.G % 8 == 0) ? (bx % 8) * (F.G / 8) + bx / 8 : bx; }
    int lo, hi_full; { CArgs ka = kargs(); lo = ka->ph_lo; hi_full = ka->ph_hi; F.ctl = (gu32*)(ka->p.ws + WS_CTL); }
    { const int hi = hi_full; (void)hi; }
    for (int u = F.tid; u < (LDS_BYTES - LDSCTL_OFF) / 4; u += NWAVES * 64) ((LAS unsigned*)(F.lds + LDSCTL_OFF))[u] = 0u;
    __syncthreads();
    XcdBarrier bar; bar.bar = (unsigned*)(F.ctl + CW_BAR); bar.x = 0; bar.st = nullptr;
    if (hi_full - lo > 1) bar = xcd_barrier_post((unsigned*)(F.ctl + CW_BAR), F.MISC + 8);
#if PROBE >= 100
    { constexpr int hi = PROBE - 100;
      if (IN(PH_PRO)) { p0_prologue(F, kargs()); SEAM(PH_PRO); }
      run_layer<0>(F, bar, lo, hi, lds); run_layer<1>(F, bar, lo, hi, lds); run_layer<2>(F, bar, lo, hi, lds); run_layer<3>(F, bar, lo, hi, lds);
      xcd_barrier(bar); if (blockIdx.x == 0 && F.tid < 128) F.ctl[CW_CNT + F.tid] = 0u; __syncthreads(); if (F.tid == 0) *(LAS int*)(F.lds + LDSCTL_OFF) = 0; __syncthreads(); }
#endif
    { const int hi = hi_full;
    if (IN(PH_PRO)) { REP(1) { p0_prologue(F, kargs()); if (PROBE == 1) { __syncthreads(); if (F.tid == 0) *(LAS int*)(F.lds + LDSCTL_OFF) = 0; __syncthreads(); } } SEAM(PH_PRO); }

    run_layer<0>(F, bar, lo, hi, lds); run_layer<1>(F, bar, lo, hi, lds); run_layer<2>(F, bar, lo, hi, lds); run_layer<3>(F, bar, lo, hi, lds);
    if (IN(PH_FINAL)) {
        constexpr int l_ = DEPTH; PH();
        CArgs ka = kargs(); unsigned char* ws = ka->p.ws;
        unsigned char* pr = ws + WS_ROUTE + (size_t)((DEPTH - 1) >> 1) * ROUTE_LAYER;
        NormArgs A; A.xin = nullptr; A.xout = nullptr; A.xinb = WSP(bf16, WS_XB); A.xoutb = nullptr; A.g = ka->p.in[22]; A.sh = nullptr; A.sc = nullptr; A.ha = nullptr; A.of32 = ka->p.out;
        A.ys = WSP(bf16, WS_YS); A.cslot_e = (const int*)pr; A.cslot_pos = (const int*)(pr + 128 * 1024); A.slot_w = (const float*)(pr + 256 * 1024); A.cgate = WSP(float, WS_MOD) + (size_t)(DEPTH - 1) * 2 * MODB + 5 * DM;
        moe_table(Fp, (const unsigned*)(F.ctl + CW_CNT + 64 * ((DEPTH - 1) >> 1)));
        A.rw = nullptr; A.slot_e = nullptr; A.slot_pos = nullptr; A.slot_w_out = nullptr; A.cnt = nullptr; A.row_list = nullptr;
        A.oscale = 1.f;
        { int MC, ts; pg8::tail_params(((const LAS int*)(F.lds + TAB_OFF))[8], DM / 256, FF / (pg8::F8_M2 ? 128 : 64), Fp.G, MC, ts); A.ysp = WSP(bf16, WS_YSP); A.tail0 = MC * 256; A.tails = ts; }
        norm_phase<true, false, false, true, true, true>(Fp, A);
    }
    }
#undef IN
#undef SEAM
}

#ifndef MK_PER_PHASE
#define MK_PER_PHASE 0
#endif
extern "C" void kernel_launch(void* const* d_in, const int* in_sizes, int n_in, void* d_out, int out_size, void* d_ws, size_t ws_size, hipStream_t stream) {
    static int grid = 0;
    if (grid == 0) {
        if (n_in != 23 || out_size != NTOK * DM || ws_size < WS_END) { fprintf(stderr, "kernel_launch: unexpected problem (n_in %d out %d ws %zu)\n", n_in, out_size, ws_size); grid = -1; return; }
        int dev = 0, cus = 0, per_cu = 0;
        if (hipGetDevice(&dev) != hipSuccess || hipDeviceGetAttribute(&cus, hipDeviceAttributeMultiprocessorCount, dev) != hipSuccess) { grid = -1; return; }
        if (hipFuncSetAttribute((const void*)mk_fwd, hipFuncAttributeMaxDynamicSharedMemorySize, LDS_BYTES) != hipSuccess) { grid = -1; return; }
        if (hipOccupancyMaxActiveBlocksPerMultiprocessor(&per_cu, (const void*)mk_fwd, NWAVES * 64, LDS_BYTES) != hipSuccess || per_cu < 1) { fprintf(stderr, "kernel_launch: occupancy query reports %d\n", per_cu); }
        (void)hipGetLastError();
        grid = cus;
    }
    if (grid < 0) return;
    if (hipMemsetAsync((char*)d_ws + WS_CTL, 0, CTL_ZERO_BYTES, stream) != hipSuccess) return;
    Args a; memset(&a, 0, sizeof(a));
    for (int i = 0; i < 23; ++i) a.p.in[i] = (const float*)d_in[i];
    a.p.out = (float*)d_out; a.p.ws = (unsigned char*)d_ws;
    for (int i = 0; i < 32; ++i) a.rf.inv[i] = (float)(1.0 / pow(10000.0, (double)((float)(2 * i) / 64.0f)));
    for (int l = 0; l < DEPTH; ++l) a.lam_init[l] = (float)(0.8 - 0.6 * exp(-0.3 * (double)l));
#if MK_PER_PHASE
    for (int ph = 0; ph < PH_END; ++ph) { a.ph_lo = ph; a.ph_hi = ph + 1; hipLaunchKernelGGL(mk_fwd, dim3(grid), dim3(NWAVES * 64), LDS_BYTES, stream, a); }
#else
    a.ph_lo = 0; a.ph_hi = PH_END;
    hipLaunchKernelGGL(mk_fwd, dim3(grid), dim3(NWAVES * 64), LDS_BYTES, stream, a);
#endif
}
```

```cpp
#include <hip/hip_runtime.h>
#ifndef PROBE
#define PROBE 0
#endif
#ifndef RESC_DRAIN
#define RESC_DRAIN 1
#endif
#ifndef RESC_NOPS
#define RESC_NOPS 10
#endif
#ifndef LEAD_WAVES
#define LEAD_WAVES 8
#endif
#include <hip/hip_bf16.h>
#include <cstdio>
#include <cstdint>
#include <cmath>
#include <cstring>

constexpr int BATCH = 2, SEQ = 8192, DM = 1024, NTOK = BATCH * SEQ, DEPTH = 4;
constexpr int INC = 2304, FF = 3584, NE = 8, NMOD = 6;
constexpr int COL_QA = 0, COL_KA = 512, COL_VA = 640, COL_QD = 768, COL_KD = 1280, COL_VD = 1792;
constexpr int PMAX = NTOK * 2 + NE * 256;
constexpr int NCHUNK_MAX = PMAX / 256;
constexpr float EPS = 1e-6f;
constexpr float QK_C2 = 0.125f * 1.4426950408889634f;
constexpr int MODB = NMOD * DM;

namespace pg8 {
#define PG8_LAS __attribute__((address_space(3)))
typedef unsigned short bf16_t;
typedef short bf16x8 __attribute__((ext_vector_type(8)));
typedef float f32x4 __attribute__((ext_vector_type(4)));
typedef unsigned u32x4 __attribute__((ext_vector_type(4)));
constexpr int BM = 256, BK = 64, HALF = 128, HTB = HALF * BK * 2  , STAGE_BYTES = 8 * HTB, NXCD = 8, WGM = 8;

__host__ __device__ __forceinline__ int lds_byte(int r, int c) { const int st = (r >> 4) * 2 + (c >> 5), rr = r & 15, cc = c & 31, ob = rr * 64 + cc * 2; return st * 1024 + (ob ^ (((ob >> 9) & 1) << 5)); }
__host__ __device__ __forceinline__ void stage_rc(int b, int& R, int& C) { const int st = b / 1024, sb = b % 1024, swz = sb ^ (((sb >> 9) & 1) << 5); R = (st >> 1) * 16 + swz / 64; C = (st & 1) * 32 + (swz % 64) / 2; }
__host__ __device__ __forceinline__ int perm32(int rho) { const int n = rho >> 4, i = rho & 15; return 8 * (i >> 2) + 4 * n + (i & 3); }

struct Unit { int pm, pn, pnb; int koff, nt, ks; };
struct Gemm { const bf16_t* A; const bf16_t* Bt; int M, N, K; };

struct StaticOrder {
    static constexpr bool VARK = false;
    int nM, nN, nwg, G, c; const int* chunk_e;
    __device__ __forceinline__ void init(int M, int N, int G_, int c_, const int* ce = nullptr) { nM = M / BM; nN = N / BM; nwg = nM * nN; G = G_; c = c_; chunk_e = ce; }
    __device__ __forceinline__ bool next(int i, Unit& u) const {
        const long L = (long)i * G + c; if (L >= nwg) return false;
        int wgid = (int)L; { const int q = nwg / NXCD, r = nwg % NXCD, xcd = wgid % NXCD, off = wgid / NXCD; wgid = (xcd < r ? xcd * (q + 1) : r * (q + 1) + (xcd - r) * q) + off; }
        const int nig = WGM * nN, gid = wgid / nig, fm = gid * WGM, gsz = (nM - fm) < WGM ? (nM - fm) : WGM;
        u.pm = fm + ((wgid % nig) % gsz); u.pn = (wgid % nig) / gsz; u.pnb = chunk_e ? chunk_e[u.pm] * nN + u.pn : u.pn; return true;
    }
    __device__ __forceinline__ void a_ready(const Unit&) const {}
    __device__ __forceinline__ void done(const Unit&) const {}
};
__host__ __device__ __forceinline__ void tail_params(int nch, int nN, int nt_all, int G, int& MC, int& s) {
    MC = ((nch * nN) / G) * G / nN; const int T = nch - MC;
    s = (T * nN * 7 <= G && nt_all % 14 == 0) ? 7 : (T * nN * 4 <= G && nt_all % 8 == 0) ? 4 : (T * nN * 2 <= G && nt_all % 4 == 0) ? 2 : 1;
}
struct TailOrder {
    static constexpr bool VARK = true;
    StaticOrder main; int G, vcu, nmine, npieces, s, kt, pm0, nN; const int* chunk_e;
    __device__ __forceinline__ void init(int nch, int N, int K, int G_, int c_, int vcu_, const int* ce) {
        nN = N / BM; G = G_; vcu = vcu_; chunk_e = ce; int MC; tail_params(nch, nN, K / BK, G, MC, s);
        main.init(MC * BM, N, G, c_, ce); const int nmain = MC * nN; nmine = c_ < nmain ? (nmain - c_ + G - 1) / G : 0;
        pm0 = MC; kt = (K / BK) / s; npieces = (nch - MC) * nN * s;
    }
    __device__ __forceinline__ bool next(int i, Unit& u) const {
        if (i < nmine) { main.next(i, u); u.koff = 0; u.nt = kt * s; u.ks = 0; return true; }
        const int q = (i - nmine) * G + vcu; if (q >= npieces) return false;
        const int pn = q % nN, r = q / nN, ks = r % s, ch = r / s;
        u.pm = pm0 + ch; u.pn = pn; u.pnb = chunk_e[u.pm] * nN + pn; u.koff = ks * kt * BK * 2; u.nt = kt; u.ks = ks; return true;
    }
    __device__ __forceinline__ void a_ready(const Unit&) const {}
    __device__ __forceinline__ void done(const Unit&) const {}
};
constexpr int TAILROWS = 8 * 256;

#ifndef F8CFG
#define F8CFG 62
#endif
constexpr bool F8_D1 = (F8CFG & 1) != 0, F8_D2 = (F8CFG & 2) != 0, F8_M1 = (F8CFG & 4) != 0, F8_M2 = (F8CFG & 8) != 0, F8_IN = (F8CFG & 16) != 0, F8_ATT = (F8CFG & 32) != 0;
constexpr float F8_SA = 8.f, F8_SW1 = 128.f, F8_SH = 4.f, F8_SW2 = 256.f;
constexpr float F8_INV1 = 1.f / (F8_SA * F8_SW1), F8_INV2 = 1.f / (F8_SH * F8_SW2);
__device__ __forceinline__ unsigned pack4_fp8(float a, float b, float c, float d) {
    a = __builtin_amdgcn_fmed3f(a, -448.f, 448.f); b = __builtin_amdgcn_fmed3f(b, -448.f, 448.f); c = __builtin_amdgcn_fmed3f(c, -448.f, 448.f); d = __builtin_amdgcn_fmed3f(d, -448.f, 448.f);
    unsigned r = 0u; r = (unsigned)__builtin_amdgcn_cvt_pk_fp8_f32(a, b, (int)r, false); r = (unsigned)__builtin_amdgcn_cvt_pk_fp8_f32(c, d, (int)r, true); return r; }
__device__ __forceinline__ unsigned cvt_pk_bf16(float lo, float hi) { unsigned r; asm volatile("v_cvt_pk_bf16_f32 %0, %1, %2" : "=v"(r) : "v"(lo), "v"(hi)); return r; }

struct EpiBf16 {
    static constexpr bool PERM = true, AFTER_DRAIN = false;
    bf16_t* O; int ldc; float ascale = 1.f;
    __device__ __forceinline__ void operator()(const f32x4 (&acc)[2][2][4][2], const Unit& u, int wr, int wc, int fr, int fq) const {
        const int row0 = u.pm * BM + wr * 64 + fr, col0 = u.pn * BM + wc * 32 + 8 * fq;
#pragma unroll
        for (int ai = 0; ai < 2; ++ai)
#pragma unroll
            for (int m = 0; m < 4; ++m) { bf16_t* rowp = O + (size_t)(row0 + ai * HALF + m * 16) * ldc + col0;
#pragma unroll
                for (int bj = 0; bj < 2; ++bj) { const f32x4 v0 = acc[ai][bj][m][0] * ascale, v1 = acc[ai][bj][m][1] * ascale;
                    u32x4 w; w.x = cvt_pk_bf16(v0[0], v0[1]); w.y = cvt_pk_bf16(v0[2], v0[3]); w.z = cvt_pk_bf16(v1[0], v1[1]); w.w = cvt_pk_bf16(v1[2], v1[3]);
                    *(u32x4*)(rowp + bj * HALF) = w; } }
    }
};
struct EpiBf16T {
    static constexpr bool PERM = true, AFTER_DRAIN = false;
    bf16_t* O; int ldc; bf16_t* P; int pm0; float ascale = 1.f;
    __device__ __forceinline__ void operator()(const f32x4 (&acc)[2][2][4][2], const Unit& u, int wr, int wc, int fr, int fq) const {
        bf16_t* base = O; int rowb = u.pm * BM;
        if (u.ks != 0) { base = P + (size_t)(u.ks - 1) * TAILROWS * ldc; rowb = (u.pm - pm0) * BM; }
        const int row0 = rowb + wr * 64 + fr, col0 = u.pn * BM + wc * 32 + 8 * fq;
#pragma unroll
        for (int ai = 0; ai < 2; ++ai)
#pragma unroll
            for (int m = 0; m < 4; ++m) { bf16_t* rowp = base + (size_t)(row0 + ai * HALF + m * 16) * ldc + col0;
#pragma unroll
                for (int bj = 0; bj < 2; ++bj) { const f32x4 v0 = acc[ai][bj][m][0] * ascale, v1 = acc[ai][bj][m][1] * ascale;
                    u32x4 w; w.x = cvt_pk_bf16(v0[0], v0[1]); w.y = cvt_pk_bf16(v0[2], v0[3]); w.z = cvt_pk_bf16(v1[0], v1[1]); w.w = cvt_pk_bf16(v1[2], v1[3]);
                    *(u32x4*)(rowp + bj * HALF) = w; } }
    }
};
struct EpiRope {
    static constexpr bool PERM = true, AFTER_DRAIN = false;
    bf16_t* O; const float* rc; const float* rs; float ascale = 1.f; unsigned char* O8 = nullptr;
    __device__ __forceinline__ void operator()(const f32x4 (&acc)[2][2][4][2], const Unit& u, int wr, int wc, int fr, int fq) const {
        const int row0 = u.pm * BM + wr * 64 + fr;
#pragma unroll
        for (int bj = 0; bj < 2; ++bj) {
            const int cbase = u.pn * BM + bj * HALF;
            const bool rope = (cbase < COL_VA) || (cbase >= COL_QD && cbase < COL_VD);
            const bool f8o = O8 != nullptr && cbase >= COL_QD;
            const float sc = (((cbase < COL_KA) || (cbase >= COL_QD && cbase < COL_KD)) ? QK_C2 : 1.0f) * ascale * (f8o ? (cbase < COL_KD ? 8.f : (cbase < COL_VD ? 0.125f : 1.f)) : 1.f);
            const int col0 = cbase + wc * 32 + 8 * fq, i0 = (col0 & 63) >> 1;
#pragma unroll
            for (int ai = 0; ai < 2; ++ai)
#pragma unroll
                for (int m = 0; m < 4; ++m) {
                    const int row = row0 + ai * HALF + m * 16;
                    f32x4 v0 = acc[ai][bj][m][0], v1 = acc[ai][bj][m][1];
                    if (rope) {
                        const f32x4 c4 = *(const f32x4*)(rc + (size_t)row * 32 + i0), s4 = *(const f32x4*)(rs + (size_t)row * 32 + i0);
                        const f32x4 a0 = v0, a1 = v1;
                        v0[0] = a0[0] * c4[0] - a0[1] * s4[0]; v0[1] = a0[1] * c4[0] + a0[0] * s4[0];
                        v0[2] = a0[2] * c4[1] - a0[3] * s4[1]; v0[3] = a0[3] * c4[1] + a0[2] * s4[1];
                        v1[0] = a1[0] * c4[2] - a1[1] * s4[2]; v1[1] = a1[1] * c4[2] + a1[0] * s4[2];
                        v1[2] = a1[2] * c4[3] - a1[3] * s4[3]; v1[3] = a1[3] * c4[3] + a1[2] * s4[3];
                    }
                    v0 = v0 * sc; v1 = v1 * sc;
                    if (f8o) { *(unsigned long long*)(O8 + (size_t)row * (INC - COL_QD) + (col0 - COL_QD)) = (unsigned long long)pack4_fp8(v0[0], v0[1], v0[2], v0[3]) | ((unsigned long long)pack4_fp8(v1[0], v1[1], v1[2], v1[3]) << 32); }
                    else { u32x4 w; w.x = cvt_pk_bf16(v0[0], v0[1]); w.y = cvt_pk_bf16(v0[2], v0[3]); w.z = cvt_pk_bf16(v1[0], v1[1]); w.w = cvt_pk_bf16(v1[2], v1[3]);
                        *(u32x4*)(O + (size_t)row * INC + col0) = w; }
                }
        }
    }
};
struct EpiSwiglu {
    static constexpr bool PERM = true, AFTER_DRAIN = false;
    bf16_t* O; int ldc; float ain = 1.f;
    __device__ __forceinline__ static float silu_mul(float g, float u) { return g * u * __builtin_amdgcn_rcpf(1.0f + __builtin_amdgcn_exp2f(-1.4426950408889634f * g)); }
    __device__ __forceinline__ void operator()(const f32x4 (&acc)[2][2][4][2], const Unit& u, int wr, int wc, int fr, int fq) const {
        const int row0 = u.pm * BM + wr * 64 + fr, col0 = u.pn * HALF + wc * 32 + 8 * fq;
#pragma unroll
        for (int ai = 0; ai < 2; ++ai)
#pragma unroll
            for (int m = 0; m < 4; ++m) {
                const f32x4 g0 = acc[ai][0][m][0] * ain, g1 = acc[ai][0][m][1] * ain, u0 = acc[ai][1][m][0] * ain, u1 = acc[ai][1][m][1] * ain;
                u32x4 w; w.x = cvt_pk_bf16(silu_mul(g0[0], u0[0]), silu_mul(g0[1], u0[1])); w.y = cvt_pk_bf16(silu_mul(g0[2], u0[2]), silu_mul(g0[3], u0[3]));
                w.z = cvt_pk_bf16(silu_mul(g1[0], u1[0]), silu_mul(g1[1], u1[1])); w.w = cvt_pk_bf16(silu_mul(g1[2], u1[2]), silu_mul(g1[3], u1[3]));
                *(u32x4*)(O + (size_t)(row0 + ai * HALF + m * 16) * ldc + col0) = w;
            }
    }
};
struct EpiSwigluF8 {
    static constexpr bool PERM = true, AFTER_DRAIN = false;
    unsigned char* O; int ldc; float ain, oscale;
    __device__ __forceinline__ void operator()(const f32x4 (&acc)[2][2][4][2], const Unit& u, int wr, int wc, int fr, int fq) const {
        const int row0 = u.pm * BM + wr * 64 + fr, col0 = u.pn * HALF + wc * 32 + 8 * fq;
#pragma unroll
        for (int ai = 0; ai < 2; ++ai)
#pragma unroll
            for (int m = 0; m < 4; ++m) {
                const f32x4 g0 = acc[ai][0][m][0] * ain, g1 = acc[ai][0][m][1] * ain, u0 = acc[ai][1][m][0] * (ain * oscale), u1 = acc[ai][1][m][1] * (ain * oscale);
                unsigned long long w = (unsigned long long)pack4_fp8(EpiSwiglu::silu_mul(g0[0], u0[0]), EpiSwiglu::silu_mul(g0[1], u0[1]), EpiSwiglu::silu_mul(g0[2], u0[2]), EpiSwiglu::silu_mul(g0[3], u0[3]))
                    | ((unsigned long long)pack4_fp8(EpiSwiglu::silu_mul(g1[0], u1[0]), EpiSwiglu::silu_mul(g1[1], u1[1]), EpiSwiglu::silu_mul(g1[2], u1[2]), EpiSwiglu::silu_mul(g1[3], u1[3])) << 32);
                *(unsigned long long*)(O + (size_t)(row0 + ai * HALF + m * 16) * ldc + col0) = w;
            }
    }
};
struct EpiResGate {
    static constexpr bool PERM = false, AFTER_DRAIN = false;
    const float* base; float* out; const float* gate;
    __device__ __forceinline__ void operator()(const f32x4 (&acc)[2][2][4][2], const Unit& u, int wr, int wc, int fr, int fq) const {
        const int row0 = u.pm * BM + wr * 64 + fr, col0 = u.pn * BM + wc * 32 + 4 * fq;
        const float* gp = gate + (size_t)((u.pm * BM) / SEQ) * MODB + col0;
        f32x4 gv[2][2];
#pragma unroll
        for (int bj = 0; bj < 2; ++bj)
#pragma unroll
            for (int n = 0; n < 2; ++n) gv[bj][n] = *(const f32x4*)(gp + bj * HALF + n * 16);
#pragma unroll
        for (int ai = 0; ai < 2; ++ai)
#pragma unroll
            for (int m = 0; m < 4; ++m) { const size_t off = (size_t)(row0 + ai * HALF + m * 16) * DM + col0;
#pragma unroll
                for (int bj = 0; bj < 2; ++bj)
#pragma unroll
                    for (int n = 0; n < 2; ++n) { const f32x4 bs = *(const f32x4*)(base + off + bj * HALF + n * 16); *(f32x4*)(out + off + bj * HALF + n * 16) = bs + gv[bj][n] * acc[ai][bj][m][n]; } }
    }
};

template <bool BASE_F32>
struct EpiResGateB {
    static constexpr bool PERM = true, AFTER_DRAIN = false;
    const void* base; bf16_t* out; const float* gate; float ascale = 1.f;
    __device__ __forceinline__ void operator()(const f32x4 (&acc)[2][2][4][2], const Unit& u, int wr, int wc, int fr, int fq) const {
        const int row0 = u.pm * BM + wr * 64 + fr, col0 = u.pn * BM + wc * 32 + 8 * fq;
        const float* gp = gate + (size_t)((u.pm * BM) / SEQ) * MODB + col0;
        f32x4 gv[2][2];
#pragma unroll
        for (int bj = 0; bj < 2; ++bj)
#pragma unroll
            for (int n = 0; n < 2; ++n) gv[bj][n] = *(const f32x4*)(gp + bj * HALF + n * 4) * ascale;
#pragma unroll
        for (int ai = 0; ai < 2; ++ai)
#pragma unroll
            for (int m = 0; m < 4; ++m) { const size_t off = (size_t)(row0 + ai * HALF + m * 16) * DM + col0;
#pragma unroll
                for (int bj = 0; bj < 2; ++bj) { f32x4 b0, b1;
                    if (BASE_F32) { b0 = *(const f32x4*)((const float*)base + off + bj * HALF); b1 = *(const f32x4*)((const float*)base + off + bj * HALF + 4); }
                    else { const u32x4 w = *(const u32x4*)((const bf16_t*)base + off + bj * HALF);
                        b0 = (f32x4){__uint_as_float(w.x << 16), __uint_as_float(w.x & 0xffff0000u), __uint_as_float(w.y << 16), __uint_as_float(w.y & 0xffff0000u)};
                        b1 = (f32x4){__uint_as_float(w.z << 16), __uint_as_float(w.z & 0xffff0000u), __uint_as_float(w.w << 16), __uint_as_float(w.w & 0xffff0000u)}; }
                    const f32x4 v0 = b0 + gv[bj][0] * acc[ai][bj][m][0], v1 = b1 + gv[bj][1] * acc[ai][bj][m][1];
                    u32x4 o; o.x = cvt_pk_bf16(v0[0], v0[1]); o.y = cvt_pk_bf16(v0[2], v0[3]); o.z = cvt_pk_bf16(v1[0], v1[1]); o.w = cvt_pk_bf16(v1[2], v1[3]);
                    *(u32x4*)(out + off + bj * HALF) = o; } }
    }
};

struct NoGather { static constexpr bool ON = false; __device__ __forceinline__ int tok(int, int) const { return 0; } };
struct LdsGather { static constexpr bool ON = true; const PG8_LAS int* idx; __device__ __forceinline__ int tok(int ui, int r) const { return idx[ui * 256 + r]; } };
typedef int v4i_t __attribute__((ext_vector_type(4)));
typedef int v8i_t __attribute__((ext_vector_type(8)));
template <class Epi, class Sched, bool ALIGN_EPI = false, bool SP2 = false, class Gath = NoGather, bool F8 = false>
__device__ __forceinline__ void gemm_phase(PG8_LAS unsigned char* lds, const Gemm g, const Sched& S, const Epi& E, const Gath GA = Gath()) {
    static_assert(!Gath::ON || SP2, "the row gather is written for the SP2 loop");
    int tid_ = threadIdx.x; asm volatile("" : "+v"(tid_));
    const int tid = tid_, wid = __builtin_amdgcn_readfirstlane(tid >> 6), lane = tid & 63, wr = wid >> 2, wc = wid & 3, fr = lane & 15, fq = lane >> 4;
    const int K = g.K, RB = F8 ? K : 2 * K  , nt = RB / (2 * BK);
    unsigned voffA[2], voffB[2];
#pragma unroll
    for (int i = 0; i < 2; ++i) { int R, C; stage_rc(tid * 16 + i * 8192, R, C); const int Rb = Epi::PERM ? ((R & ~31) + perm32(R & 31)) : R;
        voffA[i] = (unsigned)(R * RB + C * 2); voffB[i] = (unsigned)(Rb * RB + C * 2); }
    unsigned voffG[2][2], voffN[2][2];
#define PG8_GOFF(dst, uidx) do { _Pragma("unroll") for (int i_ = 0; i_ < 2; ++i_) { int R_, C_; stage_rc(tid * 16 + i_ * 8192, R_, C_); _Pragma("unroll") for (int h_ = 0; h_ < 2; ++h_) dst[h_][i_] = (unsigned)(GA.tok(uidx, h_ * HALF + R_) * RB + C_ * 2); } } while (0)
#define PG8_STAGE_A(bufoff, gbase, h, NX) do { if constexpr (Gath::ON) { PG8_STAGE(bufoff, gbase, ((NX) ? voffN : voffG)[h]); } else { PG8_STAGE(bufoff, (gbase) + (h) * hstep, voffA); } } while (0)
    const size_t kstep = (size_t)(BK * 2);
    const size_t hstep = (size_t)HALF * RB;
    const size_t tstep = 2 * hstep;
    const unsigned ldsw = (unsigned)wid * 1024u;
    const int aoff = lds_byte(wr * 64 + fr, fq * 8), boff = lds_byte(wc * 32 + fr, fq * 8);
#define PG8_SA(b, h) (((b) * 2 + (h)) * HTB)
#define PG8_SB(b, h) ((4 + (b) * 2 + (h)) * HTB)
#define PG8_STAGE(bufoff, gbase, voff) do { _Pragma("unroll") for (int _i = 0; _i < 2; ++_i) \
        __builtin_amdgcn_global_load_lds((const unsigned*)((const char*)(gbase) + (voff)[_i]), (PG8_LAS unsigned*)(lds + (bufoff) + ldsw + _i * 8192), 16, 0, 0); } while (0)
#define PG8_LDA(dst, b, h) do { _Pragma("unroll") for (int m = 0; m < 4; ++m) _Pragma("unroll") for (int k = 0; k < 2; ++k) dst[m][k] = *(const PG8_LAS bf16x8*)(lds + PG8_SA(b, h) + aoff + m * 2048 + k * 1024); } while (0)
#define PG8_LDB(dst, b, h) do { _Pragma("unroll") for (int n = 0; n < 2; ++n) _Pragma("unroll") for (int k = 0; k < 2; ++k) dst[n][k] = *(const PG8_LAS bf16x8*)(lds + PG8_SB(b, h) + boff + n * 2048 + k * 1024); } while (0)
#define PG8_CAT8(x) __builtin_shufflevector(__builtin_bit_cast(v4i_t, (x)[0]), __builtin_bit_cast(v4i_t, (x)[1]), 0, 1, 2, 3, 4, 5, 6, 7)
#define PG8_MMA(ai, bj, At, Bt) do { __builtin_amdgcn_s_setprio(1); if constexpr (F8) { _Pragma("unroll") for (int m = 0; m < 4; ++m) _Pragma("unroll") for (int n = 0; n < 2; ++n) \
        asm("v_mfma_f32_16x16x128_f8f6f4 %0, %1, %2, %0" : "+v"(acc[ai][bj][m][n]) : "v"(PG8_CAT8(Bt[n])), "v"(PG8_CAT8(At[m]))); } else { \
        _Pragma("unroll") for (int m = 0; m < 4; ++m) _Pragma("unroll") for (int n = 0; n < 2; ++n) _Pragma("unroll") for (int k = 0; k < 2; ++k) \
        acc[ai][bj][m][n] = __builtin_amdgcn_mfma_f32_16x16x32_bf16(Bt[n][k], At[m][k], acc[ai][bj][m][n], 0, 0, 0); } __builtin_amdgcn_s_setprio(0); } while (0)
#define PG8_WAIT_V(n) asm volatile("s_waitcnt vmcnt(" #n ")" ::: "memory")
#define PG8_WAIT_L(n) asm volatile("s_waitcnt lgkmcnt(" #n ")" ::: "memory")
#define PG8_BAR __builtin_amdgcn_s_barrier()
#define PG8_SCHED __builtin_amdgcn_sched_barrier(0)
    Unit cur, nxt; int ui = 0;
    if (!S.next(0, cur)) return;
    float zf_ = 0.f; asm volatile("" : "+v"(zf_));
    f32x4 acc[2][2][4][2];
#pragma unroll
    for (int a = 0; a < 2; ++a)
#pragma unroll
        for (int b = 0; b < 2; ++b)
#pragma unroll
            for (int m = 0; m < 4; ++m)
#pragma unroll
                for (int n = 0; n < 2; ++n) acc[a][b][m][n] = (f32x4){zf_, zf_, zf_, zf_};
    bf16x8 At[4][2], B0[2][2], B1[2][2];
    const char* cA = (const char*)g.A + (Gath::ON ? (size_t)0 : (size_t)cur.pm * tstep) + (Sched::VARK ? cur.koff : 0); const char* cB = (const char*)g.Bt + (size_t)cur.pnb * tstep + (Sched::VARK ? cur.koff : 0);
    if constexpr (Gath::ON) { PG8_GOFF(voffG, 0); }
    S.a_ready(cur);
    if constexpr (SP2) {
        PG8_STAGE(PG8_SB(0, 0), cB, voffB); PG8_STAGE(PG8_SB(0, 1), cB + hstep, voffB); PG8_STAGE_A(PG8_SA(0, 0), cA, 0, false); PG8_STAGE_A(PG8_SA(0, 1), cA, 1, false);
        if (wr == 1) PG8_BAR;
        PG8_WAIT_V(2); PG8_BAR;
        PG8_STAGE(PG8_SB(1, 0), cB + kstep, voffB); PG8_STAGE_A(PG8_SA(1, 0), cA + kstep, 0, false); PG8_STAGE(PG8_SB(1, 1), cB + hstep + kstep, voffB);
        PG8_WAIT_V(6); PG8_BAR;
    } else {
        PG8_STAGE(PG8_SB(0, 0), cB, voffB); PG8_STAGE(PG8_SA(0, 0), cA, voffA); PG8_STAGE(PG8_SB(0, 1), cB + hstep, voffB); PG8_STAGE(PG8_SA(0, 1), cA + hstep, voffA);
        if (wr == 1) PG8_BAR;
        PG8_WAIT_V(4); PG8_BAR;
        PG8_STAGE(PG8_SB(1, 0), cB + kstep, voffB); PG8_STAGE(PG8_SA(1, 0), cA + kstep, voffA); PG8_STAGE(PG8_SB(1, 1), cB + hstep + kstep, voffB);
        PG8_WAIT_V(6); PG8_BAR;
    }
    for (;;) {
        const bool has_next = S.next(ui + 1, nxt);
        const char* nA = (has_next && !Gath::ON) ? (const char*)g.A + (size_t)nxt.pm * tstep + (Sched::VARK ? nxt.koff : 0) : cA; const char* nB = has_next ? (const char*)g.Bt + (size_t)nxt.pnb * tstep + (Sched::VARK ? nxt.koff : 0) : cB;
        const int ntu = Sched::VARK ? cur.nt : nt;
        for (int t = 0; t < ntu; t += 2) {
            const bool last = (t == ntu - 2);
            const char* a1 = cA + (size_t)(t + 1) * kstep;
            const char* a2 = last ? nA : cA + (size_t)(t + 2) * kstep; const char* b2 = last ? nB : cB + (size_t)(t + 2) * kstep;
            const char* a3 = a2 + kstep; const char* b3 = b2 + kstep;
            if (last && has_next) S.a_ready(nxt);
            if constexpr (Gath::ON) { if (last) { PG8_GOFF(voffN, has_next ? ui + 1 : ui); } }
            if constexpr (SP2) {
            PG8_LDB(B0, 0, 0); PG8_LDB(B1, 0, 1); PG8_SCHED; PG8_LDA(At, 0, 0); PG8_STAGE_A(PG8_SA(1, 1), a1, 1, false);
            PG8_WAIT_V(8); PG8_WAIT_L(0); PG8_BAR; PG8_MMA(0, 0, At, B0); PG8_MMA(0, 1, At, B1); PG8_BAR; PG8_SCHED;
            PG8_LDA(At, 0, 1); PG8_STAGE(PG8_SB(0, 0), b2, voffB); PG8_STAGE(PG8_SB(0, 1), b2 + hstep, voffB); PG8_STAGE_A(PG8_SA(0, 0), a2, 0, last);
            PG8_WAIT_V(8); PG8_WAIT_L(0); PG8_BAR; PG8_MMA(1, 0, At, B0); PG8_MMA(1, 1, At, B1); PG8_BAR; PG8_SCHED;
            PG8_LDB(B0, 1, 0); PG8_LDB(B1, 1, 1); PG8_SCHED; PG8_LDA(At, 1, 0); PG8_STAGE_A(PG8_SA(0, 1), a2, 1, last);
            PG8_WAIT_V(8); PG8_WAIT_L(0); PG8_BAR; PG8_MMA(0, 0, At, B0); PG8_MMA(0, 1, At, B1); PG8_BAR; PG8_SCHED;
            PG8_LDA(At, 1, 1); PG8_STAGE(PG8_SB(1, 0), b3, voffB); PG8_STAGE(PG8_SB(1, 1), b3 + hstep, voffB); PG8_STAGE_A(PG8_SA(1, 0), a3, 0, last);
            PG8_WAIT_V(8); PG8_WAIT_L(0); PG8_BAR; PG8_MMA(1, 0, At, B0); PG8_MMA(1, 1, At, B1); PG8_BAR; PG8_SCHED;
            } else {
            PG8_LDB(B0, 0, 0); PG8_SCHED; PG8_LDA(At, 0, 0); PG8_STAGE(PG8_SA(1, 1), a1 + hstep, voffA);
            PG8_WAIT_L(8); PG8_BAR; PG8_WAIT_L(0); PG8_MMA(0, 0, At, B0); PG8_BAR; PG8_SCHED;
            PG8_LDB(B1, 0, 1); PG8_STAGE(PG8_SB(0, 0), b2, voffB);
            PG8_BAR; PG8_WAIT_L(0); PG8_MMA(0, 1, At, B1); PG8_BAR;
            PG8_LDA(At, 0, 1); PG8_STAGE(PG8_SA(0, 0), a2, voffA);
            PG8_BAR; PG8_WAIT_L(0); PG8_MMA(1, 0, At, B0); PG8_BAR; PG8_SCHED;
            PG8_STAGE(PG8_SB(0, 1), b2 + hstep, voffB);
            PG8_WAIT_V(6); PG8_BAR; PG8_MMA(1, 1, At, B1); PG8_BAR;
            PG8_LDB(B0, 1, 0); PG8_SCHED; PG8_LDA(At, 1, 0); PG8_STAGE(PG8_SA(0, 1), a2 + hstep, voffA);
            PG8_WAIT_L(8); PG8_BAR; PG8_WAIT_L(0); PG8_MMA(0, 0, At, B0); PG8_BAR; PG8_SCHED;
            PG8_LDB(B1, 1, 1); PG8_STAGE(PG8_SB(1, 0), b3, voffB);
            PG8_BAR; PG8_WAIT_L(0); PG8_MMA(0, 1, At, B1); PG8_BAR;
            PG8_LDA(At, 1, 1); PG8_STAGE(PG8_SA(1, 0), a3, voffA);
            PG8_BAR; PG8_WAIT_L(0); PG8_MMA(1, 0, At, B0); PG8_BAR; PG8_SCHED;
            PG8_STAGE(PG8_SB(1, 1), b3 + hstep, voffB);
            PG8_WAIT_V(6); PG8_BAR; PG8_MMA(1, 1, At, B1); PG8_BAR;
            }
        }
        if constexpr (F8) { asm volatile("s_nop 15\n\ts_nop 15" ::: "memory"); PG8_SCHED; }
        if constexpr (ALIGN_EPI) { if (wr == 0) PG8_BAR; }
        if constexpr (!Epi::AFTER_DRAIN) { E(acc, cur, wr, wc, fr, fq); S.done(cur); }
        if (!has_next) break;
#pragma unroll
        for (int a = 0; a < 2; ++a)
#pragma unroll
            for (int b = 0; b < 2; ++b)
#pragma unroll
                for (int m = 0; m < 4; ++m)
#pragma unroll
                    for (int n = 0; n < 2; ++n) acc[a][b][m][n] = (f32x4){zf_, zf_, zf_, zf_};
        cur = nxt; cA = nA; cB = nB; ++ui;
        if constexpr (Gath::ON) { _Pragma("unroll") for (int h_ = 0; h_ < 2; ++h_) _Pragma("unroll") for (int i_ = 0; i_ < 2; ++i_) voffG[h_][i_] = voffN[h_][i_]; }
        if constexpr (ALIGN_EPI) { if (wr == 1) PG8_BAR; }
    }
    PG8_WAIT_V(0);
    if constexpr (!ALIGN_EPI) { if (wr == 0) PG8_BAR; }
    PG8_BAR;
    if constexpr (Epi::AFTER_DRAIN) { E.fused(acc, cur, wr, wc, fr, fq, lds, wid, lane); S.done(cur); }
#undef PG8_SA
#undef PG8_SB
#undef PG8_STAGE
#undef PG8_STAGE_A
#undef PG8_GOFF
#undef PG8_LDA
#undef PG8_LDB
#undef PG8_MMA
#undef PG8_CAT8
#undef PG8_WAIT_V
#undef PG8_WAIT_L
#undef PG8_BAR
#undef PG8_SCHED
}
}

#include <hip/hip_bf16.h>
#include <cmath>
namespace attn_body {
using bf16=__hip_bfloat16;
using bf16x8=__attribute__((ext_vector_type(8)))short;
using s16x4=__attribute__((ext_vector_type(4)))short;
using f32x16=__attribute__((ext_vector_type(16)))float;
using u32x4=__attribute__((ext_vector_type(4)))unsigned;
constexpr int SEQ=8192,D=64,PITCH=2304;
constexpr int NW=8,QBLK=32,QB=QBLK*NW,KVBLK=64,NQB=SEQ/QB;
constexpr int ATTN_UNIT_ROWS=QB;
__device__ __forceinline__ int crow(int r,int hi){return (r&3)+8*(r>>2)+4*hi;}
#define SBAR() __builtin_amdgcn_sched_barrier(0)
__device__ __forceinline__ void bmask(f32x16&p0,f32x16&p1,int T,int qw,int qabs,int hi){
  if(64*T+63-qw<=128 && qw+31-64*T<=128) return;
  const float NEG=-INFINITY; const int kb=64*T+4*hi-qabs;
  #pragma unroll
  for(int r=0;r<16;++r){const int d=kb+(r&3)+8*(r>>2); if(d>128||d<-128)p0[r]=NEG; if(d+32>128||d+32<-128)p1[r]=NEG;}
}
__device__ __forceinline__ void cmask(f32x16&p0,f32x16&p1,int jb,int qrel,int hi){
  const float NEG=-INFINITY; int kb=64*jb+4*hi;
  #pragma unroll
  for(int r=0;r<16;++r){int kv=kb+(r&3)+8*(r>>2); if(kv>qrel)p0[r]=NEG; if(kv+32>qrel)p1[r]=NEG;}
}

constexpr int NSLOT=3, SLOTB=8192;
constexpr int LDS_K=0, LDS_V=NSLOT*SLOTB, LDS_WS=2*NSLOT*SLOTB, LDS_OST=LDS_WS+NW*64*4, LDS_BYTES=LDS_OST+NW*4096;
constexpr float C2=0.125f*1.4426950408889634f;
__device__ __forceinline__ void glds16(const void*gsrc,unsigned lds_dst){unsigned keep;
  asm volatile("s_mov_b32 %0, m0\n\ts_mov_b32 m0, %2\n\ts_nop 0\n\tglobal_load_lds_dwordx4 %1, off\n\ts_mov_b32 m0, %0":"=&s"(keep):"v"(gsrc),"s"(lds_dst):"memory");}
__device__ __forceinline__ void glds16s(const void*sbase,unsigned voff,unsigned lds_dst){unsigned keep;
  asm volatile("s_mov_b32 %0, m0\n\ts_mov_b32 m0, %3\n\ts_nop 0\n\tglobal_load_lds_dwordx4 %1, %2\n\ts_mov_b32 m0, %0":"=&s"(keep):"v"(voff),"s"(sbase),"s"(lds_dst):"memory");}
__device__ __forceinline__ float max3f(float a,float b,float c){float r;asm("v_max3_f32 %0, %1, %2, %3":"=v"(r):"v"(a),"v"(b),"v"(c));return r;}
__device__ __forceinline__ float max2f(float a,float b){float r;asm("v_max_f32_e32 %0, %1, %2":"=v"(r):"v"(a),"v"(b));return r;}
__device__ __forceinline__ float fadd_s(float a,float b){float r;asm("v_add_f32_e32 %0, %1, %2":"=v"(r):"v"(a),"v"(b));return r;}
__device__ __forceinline__ float fsub_s(float a,float b){float r;asm("v_sub_f32_e32 %0, %1, %2":"=v"(r):"v"(a),"v"(b));return r;}
typedef float f32x2_t __attribute__((ext_vector_type(2))); typedef __bf16 bf16x2_t __attribute__((ext_vector_type(2)));
__device__ __forceinline__ unsigned cvtpk_s(float lo,float hi){f32x2_t v={lo,hi};bf16x2_t b=__builtin_convertvector(v,bf16x2_t);return __builtin_bit_cast(unsigned,b);}
#define WAIT_BAR(N) asm volatile("s_waitcnt vmcnt(" #N ") lgkmcnt(0)\n\ts_barrier":::"memory")

__device__ __forceinline__ void qkt(f32x16&p0,f32x16&p1,const char*Kslot,const bf16x8*qr,const f32x16&negm,int r32,int hi){
  const char*kb=Kslot+hi*1024+r32*16;
  #pragma unroll
  for(int d0=0;d0<4;++d0){
    const bf16x8 b0=*reinterpret_cast<const bf16x8*>(kb+d0*2048);
    const bf16x8 b1=*reinterpret_cast<const bf16x8*>(kb+d0*2048+512);
    if(d0==0){p0=__builtin_amdgcn_mfma_f32_32x32x16_bf16(b0,qr[0],negm,0,0,0);p1=__builtin_amdgcn_mfma_f32_32x32x16_bf16(b1,qr[0],negm,0,0,0);}
    else{p0=__builtin_amdgcn_mfma_f32_32x32x16_bf16(b0,qr[d0],p0,0,0,0);p1=__builtin_amdgcn_mfma_f32_32x32x16_bf16(b1,qr[d0],p1,0,0,0);}}
}
typedef __attribute__((address_space(3))) const char* lds_cptr;
typedef short v4i16_t __attribute__((ext_vector_type(4)));
__device__ __forceinline__ void kload8(bf16x8*kf,lds_cptr kp){
  kf[0]=*(const __attribute__((address_space(3))) bf16x8*)(kp);      kf[1]=*(const __attribute__((address_space(3))) bf16x8*)(kp+512);
  kf[2]=*(const __attribute__((address_space(3))) bf16x8*)(kp+2048); kf[3]=*(const __attribute__((address_space(3))) bf16x8*)(kp+2560);
  kf[4]=*(const __attribute__((address_space(3))) bf16x8*)(kp+4096); kf[5]=*(const __attribute__((address_space(3))) bf16x8*)(kp+4608);
  kf[6]=*(const __attribute__((address_space(3))) bf16x8*)(kp+6144); kf[7]=*(const __attribute__((address_space(3))) bf16x8*)(kp+6656);
}
__device__ __forceinline__ void kload2(bf16x8*kf,lds_cptr kp,int j){ kf[2*j]=*(const __attribute__((address_space(3))) bf16x8*)(kp+j*2048); kf[2*j+1]=*(const __attribute__((address_space(3))) bf16x8*)(kp+j*2048+512); }
__device__ __forceinline__ s16x4 vtr(lds_cptr p){ return __builtin_bit_cast(s16x4,__builtin_amdgcn_ds_read_tr16_b64_v4i16((__attribute__((address_space(3))) v4i16_t*)p)); }
__device__ __forceinline__ float rowmax(const f32x16&p0,const f32x16&p1){
  float a=max3f(p0[0],p0[1],p1[0]),b=max3f(p0[2],p0[3],p1[1]);a=max3f(a,p1[2],p1[3]);
  #pragma unroll
  for(int r=4;r<16;r+=4){a=max3f(a,p0[r],p0[r+1]);b=max3f(b,p0[r+2],p0[r+3]);a=max3f(a,p1[r],p1[r+1]);b=max3f(b,p1[r+2],p1[r+3]);}
  const float m=max2f(a,b);
  auto rr=__builtin_amdgcn_permlane32_swap(__float_as_uint(m),__float_as_uint(m),false,false);
  return max2f(__uint_as_float(rr[0]),__uint_as_float(rr[1]));
}
__device__ __forceinline__ void pv(f32x16*o,int vb,bf16x8 pa0,bf16x8 pa1,bf16x8 pa2,bf16x8 pa3){
  #pragma unroll
  for(int d0=0;d0<2;++d0){s16x4 lo[4],hi[4];
    #pragma unroll
    for(int ks=0;ks<4;++ks){
      asm volatile("ds_read_b64_tr_b16 %0,%1 offset:%c2":"=&v"(lo[ks]):"v"(vb),"i"(d0*4096+ks*1024):"memory");
      asm volatile("ds_read_b64_tr_b16 %0,%1 offset:%c2":"=&v"(hi[ks]):"v"(vb),"i"(d0*4096+ks*1024+512):"memory");}
    asm volatile("s_waitcnt lgkmcnt(0)":::"memory");SBAR();
    #define PK(k) (bf16x8){lo[k][0],lo[k][1],lo[k][2],lo[k][3],hi[k][0],hi[k][1],hi[k][2],hi[k][3]}
    o[d0]=__builtin_amdgcn_mfma_f32_32x32x16_bf16(pa0,PK(0),o[d0],0,0,0);
    o[d0]=__builtin_amdgcn_mfma_f32_32x32x16_bf16(pa1,PK(1),o[d0],0,0,0);
    o[d0]=__builtin_amdgcn_mfma_f32_32x32x16_bf16(pa2,PK(2),o[d0],0,0,0);
    o[d0]=__builtin_amdgcn_mfma_f32_32x32x16_bf16(pa3,PK(3),o[d0],0,0,0);
    #undef PK
  }
}

#ifndef ATTN_STORE16
#define ATTN_STORE16(p,v) (*(u32x4*)(p)=(v))
#endif
template<int THRL,bool WIN> __device__ __forceinline__ void attn_unit(const bf16*Qb,const bf16*__restrict__ Kb,const bf16*__restrict__ Vb,bf16*Ob,int opitch,int q0,float sink_l2,char*shm){
  int tid_=threadIdx.x; asm volatile("":"+v"(tid_)); const int tid=tid_,lane=tid&63,r32=lane&31,hi=lane>>5; const int wid=__builtin_amdgcn_readfirstlane(tid>>6);
  const bf16*Qw=Qb+(long)(q0+wid*QBLK)*PITCH;
  const int tq=q0/KVBLK; const int ta=WIN?(tq-2<0?0:tq-2):0; const int tb=WIN?(tq+6>SEQ/KVBLK?SEQ/KVBLK:tq+6):SEQ/KVBLK;
  const int NT=tb-ta; const int s0=WIN?(tq+1-ta):0;
  #define TMAP(t) (WIN?(ta+(((t)+s0>=NT)?(t)+s0-NT:(t)+s0)):(t))
  const unsigned lds0=(unsigned)(uintptr_t)shm;
  float*wsf=(float*)(shm+LDS_WS)+wid*64;
  const bf16*ksrc=Kb+(long)lane*PITCH+wid*8;
  const bf16*vsrc=Vb+(long)(16*(wid&3)+(lane>>2))*PITCH+(wid>>2)*32+(lane&3)*8;
  const unsigned kdst=lds0+LDS_K+wid*1024, vdst=lds0+LDS_V+wid*1024;
  #define DMA_K(t,slot) glds16(ksrc+(long)TMAP(t)*KVBLK*PITCH,(unsigned)__builtin_amdgcn_readfirstlane(kdst+(slot)))
  #define DMA_V(t,slot) glds16(vsrc+(long)TMAP(t)*KVBLK*PITCH,(unsigned)__builtin_amdgcn_readfirstlane(vdst+(slot)))
  const int vb0=(int)(lds0+LDS_V)+((lane>>4)&1)*32+(lane&3)*8+(4*hi+((lane&15)>>2))*64;
  const char*Kbase=shm+LDS_K; bf16x8 kf[8];
  const lds_cptr shm3=(lds_cptr)shm; const lds_cptr kp0=shm3+LDS_K+hi*1024+r32*16; const lds_cptr vp0=shm3+LDS_V+((lane>>4)&1)*32+(lane&3)*8+(4*hi+((lane&15)>>2))*64;
  DMA_K(0,0);DMA_V(0,0);DMA_K(1,SLOTB);
  bf16x8 qr[4];
  #pragma unroll
  for(int d0=0;d0<4;++d0)qr[d0]=*reinterpret_cast<const bf16x8*>(&Qw[(long)r32*PITCH+d0*16+hi*8]);
  float zf_=0.f; asm volatile("":"+v"(zf_)); f32x16 zz_; _Pragma("unroll") for(int r=0;r<16;++r)zz_[r]=zf_;
  float mhat=0.f,l_reg=0.f;f32x16 o[2];o[0]=zz_;o[1]=zz_;f32x16 negm=zz_;asm volatile("":"+v"(negm));
  const int qw=q0+wid*QBLK, qabs=qw+r32;
  #define CMASK(P0,P1,t) do{ if constexpr(WIN) bmask(P0,P1,TMAP(t),qw,qabs,hi); }while(0)
  bool resc=false;
  #define START(P0,P1) do{ const float rm=rowmax(P0,P1); resc=false; \
    { const float dl=rm; mhat=fadd_s(mhat,dl); \
      _Pragma("unroll") for(int r=0;r<16;++r){P0[r]=fsub_s(P0[r],dl);P1[r]=fsub_s(P1[r],dl);} \
      _Pragma("unroll") for(int r=0;r<16;++r)negm[r]=-mhat; asm volatile("":"+v"(negm)); } \
    _Pragma("unroll") for(int r=0;r<16;++r)P0[r]=__builtin_amdgcn_exp2f(P0[r]); }while(0)
  #define RESC() do{ if(resc){ asm volatile("s_waitcnt lgkmcnt(0)":::"memory"); \
      _Pragma("unroll") for(int d_=0;d_<2;++d_) _Pragma("unroll") for(int r=0;r<16;++r)o[d_][r]*=wsf[crow(r,hi)]; } }while(0)
  f32x16 pA0,pA1,pB0,pB1;
  int sl_prev=0,sl_cur=0,sl_next=SLOTB;
  #define ROT() do{sl_prev=sl_cur;sl_cur=sl_next;sl_next=(sl_next==(NSLOT-1)*SLOTB)?0:sl_next+SLOTB;}while(0)
  DMA_K(2,2*SLOTB);
  WAIT_BAR(3);
  qkt(pA0,pA1,Kbase,qr,negm,r32,hi);asm volatile("s_nop 15\n\ts_nop 7":"+v"(pA0),"+v"(pA1));CMASK(pA0,pA1,0);
  START(pA0,pA1);
  _Pragma("unroll") for(int r=0;r<16;++r)pA1[r]=__builtin_amdgcn_exp2f(pA1[r]);
  WAIT_BAR(0);
  DMA_K(3,0);DMA_V(1,SLOTB);
  ROT();
  kload8(kf,kp0+sl_cur);
  WAIT_BAR(2);
  u32x4 pw0,pw1,pw2,pw3; { const unsigned zu_=__float_as_uint(zf_); pw0=(u32x4){zu_,zu_,zu_,zu_}; pw1=pw0; pw2=pw0; pw3=pw0; }
  #define PKW(P,B) cvtpk_s(P[B],P[B+1])
  #define PAF(k) __builtin_bit_cast(bf16x8,pw##k)
  #define VFR(i) (bf16x8){vlo[i][0],vlo[i][1],vlo[i][2],vlo[i][3],vhi[i][0],vhi[i][1],vhi[i][2],vhi[i][3]}
  #define PIN(x) asm volatile("":"+v"(x))
  #define MX3(a,b,c) __builtin_fmaxf(__builtin_fmaxf((a),(b)),(c))
  #define GAPA(MF,A0,A1,A2,A3,W0,W1,PW) do{ MF; sacc+=A0; sacc+=A1; sacc+=A2; sacc+=A3; PIN(sacc); W0; W1; PIN(PW); SBAR(); }while(0)
  #define EX(v) __builtin_amdgcn_exp2f(v)
  #define GAPB(MF,X,B) do{ MF; X[B]=EX(X[B]); X[B+1]=EX(X[B+1]); X[B+2]=EX(X[B+2]); X[B+3]=EX(X[B+3]); PIN(X); SBAR(); }while(0)
  #define VRD(i) do{ vlo[i]=vtr(vp_+(((i)>>2)*4096+((i)&3)*1024)); vhi[i]=vtr(vp_+(((i)>>2)*4096+((i)&3)*1024+512)); }while(0)
  #define KRD(G,j) do{ if(G){ kload2(kf,kp0+sl_next,j); SBAR(); } }while(0)
  #define STEP(C0,C1,P0,P1,t,GK,GV,GL) do{ SBAR(); s16x4 vlo[8],vhi[8]; \
    const lds_cptr vp_=vp0+sl_prev; \
    VRD(0); SBAR(); float sacc=(P0[0]+P0[1]); \
    GAPA(C0=__builtin_amdgcn_mfma_f32_32x32x16_bf16(kf[0],qr[0],negm,0,0,0), P0[2],P0[3],P0[4],P0[5],     pw0[0]=PKW(P0,0), pw0[1]=PKW(P0,2), pw0); \
    VRD(4); SBAR(); GAPA(C1=__builtin_amdgcn_mfma_f32_32x32x16_bf16(kf[1],qr[0],negm,0,0,0), P0[6],P0[7],P0[8],P0[9],     pw0[2]=PKW(P0,4), pw0[3]=PKW(P0,6), pw0); \
    VRD(1); SBAR(); GAPA(C0=__builtin_amdgcn_mfma_f32_32x32x16_bf16(kf[2],qr[1],C0,0,0,0),   P0[10],P0[11],P0[12],P0[13], pw1[0]=PKW(P0,8), pw1[1]=PKW(P0,10), pw1); \
    VRD(5); SBAR(); GAPA(C1=__builtin_amdgcn_mfma_f32_32x32x16_bf16(kf[3],qr[1],C1,0,0,0),   P0[14],P0[15],P1[0],P1[1],   pw1[2]=PKW(P0,12),pw1[3]=PKW(P0,14), pw1); \
    VRD(2); SBAR(); GAPA(C0=__builtin_amdgcn_mfma_f32_32x32x16_bf16(kf[4],qr[2],C0,0,0,0),   P1[2],P1[3],P1[4],P1[5],     pw2[0]=PKW(P1,0), pw2[1]=PKW(P1,2), pw2); \
    VRD(6); SBAR(); GAPA(C1=__builtin_amdgcn_mfma_f32_32x32x16_bf16(kf[5],qr[2],C1,0,0,0),   P1[6],P1[7],P1[8],P1[9],     pw2[2]=PKW(P1,4), pw2[3]=PKW(P1,6), pw2); \
    VRD(3); SBAR(); GAPA(C0=__builtin_amdgcn_mfma_f32_32x32x16_bf16(kf[6],qr[3],C0,0,0,0),   P1[10],P1[11],P1[12],P1[13], pw3[0]=PKW(P1,8), pw3[1]=PKW(P1,10), pw3); \
    VRD(7); SBAR(); GAPA(C1=__builtin_amdgcn_mfma_f32_32x32x16_bf16(kf[7],qr[3],C1,0,0,0),   P1[14],P1[15],0.f,0.f,       pw3[2]=PKW(P1,12),pw3[3]=PKW(P1,14), pw3); \
    l_reg+=sacc; \
    if(GK){DMA_K((t)+3,sl_cur);} if(GV){DMA_V((t)+1,sl_next);} \
    CMASK(C0,C1,t); \
    { float a=MX3(C0[0],C0[1],C1[0]),b=MX3(C0[2],C0[3],C1[1]); a=MX3(a,C1[2],C1[3]); \
      _Pragma("unroll") for(int r=4;r<16;r+=4){a=MX3(a,C0[r],C0[r+1]);b=MX3(b,C0[r+2],C0[r+3]);a=MX3(a,C1[r],C1[r+1]);b=MX3(b,C1[r+2],C1[r+3]);} \
      float rm=__builtin_fmaxf(a,b); { auto rr=__builtin_amdgcn_permlane32_swap(__float_as_uint(rm),__float_as_uint(rm),false,false); rm=__builtin_fmaxf(__uint_as_float(rr[0]),__uint_as_float(rr[1])); } \
      resc=false; \
      if(__builtin_expect(__any(rm>(float)THRL),0)){ const float dl=__builtin_fmaxf(rm,0.f); mhat+=dl; \
        _Pragma("unroll") for(int r=0;r<16;++r){C0[r]-=dl;C1[r]-=dl;} \
        _Pragma("unroll") for(int r=0;r<16;++r)negm[r]=-mhat; asm volatile("":"+v"(negm)); \
        const float f=__builtin_amdgcn_exp2f(-dl); l_reg*=f; if(hi==0)wsf[r32]=f; resc=true; } } \
    SBAR(); \
    GAPB(o[0]=__builtin_amdgcn_mfma_f32_32x32x16_bf16(PAF(0),VFR(0),o[0],0,0,0), C0,0); \
    GAPB(o[1]=__builtin_amdgcn_mfma_f32_32x32x16_bf16(PAF(0),VFR(4),o[1],0,0,0), C0,4); \
    KRD(GL,0); GAPB(o[0]=__builtin_amdgcn_mfma_f32_32x32x16_bf16(PAF(1),VFR(1),o[0],0,0,0), C0,8); \
    KRD(GL,1); GAPB(o[1]=__builtin_amdgcn_mfma_f32_32x32x16_bf16(PAF(1),VFR(5),o[1],0,0,0), C0,12); \
    KRD(GL,2); GAPB(o[0]=__builtin_amdgcn_mfma_f32_32x32x16_bf16(PAF(2),VFR(2),o[0],0,0,0), C1,0); \
    KRD(GL,3); GAPB(o[1]=__builtin_amdgcn_mfma_f32_32x32x16_bf16(PAF(2),VFR(6),o[1],0,0,0), C1,4); \
    GAPB(o[0]=__builtin_amdgcn_mfma_f32_32x32x16_bf16(PAF(3),VFR(3),o[0],0,0,0), C1,8); \
    GAPB(o[1]=__builtin_amdgcn_mfma_f32_32x32x16_bf16(PAF(3),VFR(7),o[1],0,0,0), C1,12); \
    }while(0)
  int t=1;
  for(;t+5<NT;t+=2){
    STEP(pB0,pB1,pA0,pA1,t,true,true,true);     WAIT_BAR(2); RESC(); ROT();
    STEP(pA0,pA1,pB0,pB1,t+1,true,true,true);   WAIT_BAR(2); RESC(); ROT();
  }
  #define ENDW(tt) do{ if((tt)+3<NT){WAIT_BAR(2);} else if((tt)+2<NT){WAIT_BAR(1);} else {WAIT_BAR(0);} }while(0)
  for(;t+1<NT;t+=2){
    STEP(pB0,pB1,pA0,pA1,t,(t+3<NT),(t+1<NT),(t+1<NT));       ENDW(t);   RESC(); ROT();
    STEP(pA0,pA1,pB0,pB1,t+1,(t+4<NT),(t+2<NT),(t+2<NT));     ENDW(t+1); RESC(); ROT();
  }
  STEP(pB0,pB1,pA0,pA1,NT-1,false,false,false); RESC();
  { float sacc=pB0[0]+pB0[1]; _Pragma("unroll") for(int r=2;r<16;++r)sacc+=pB0[r]; _Pragma("unroll") for(int r=0;r<16;++r)sacc+=pB1[r]; l_reg+=sacc;
    pw0=(u32x4){PKW(pB0,0),PKW(pB0,2),PKW(pB0,4),PKW(pB0,6)};pw1=(u32x4){PKW(pB0,8),PKW(pB0,10),PKW(pB0,12),PKW(pB0,14)};pw2=(u32x4){PKW(pB1,0),PKW(pB1,2),PKW(pB1,4),PKW(pB1,6)};pw3=(u32x4){PKW(pB1,8),PKW(pB1,10),PKW(pB1,12),PKW(pB1,14)};
    SBAR(); pv(o,vb0+sl_cur,PAF(0),PAF(1),PAF(2),PAF(3)); }
  #undef PKW
  #undef PAF
  #undef VFR
  #undef PIN
  #undef MX3
  #undef GAPA
  #undef GAPB
  #undef EX
  #undef VRD
  #undef KRD
  #undef STEP
  #undef ENDW
  {auto rr=__builtin_amdgcn_permlane32_swap(__float_as_uint(l_reg),__float_as_uint(l_reg),false,false);l_reg=__uint_as_float(rr[0])+__uint_as_float(rr[1]);}
  if constexpr(WIN) l_reg+=__builtin_amdgcn_exp2f(sink_l2-mhat);
  if(hi==0)wsf[32+r32]=l_reg;asm volatile("s_waitcnt lgkmcnt(0)":::"memory");
  float rli[16];
  #pragma unroll
  for(int r=0;r<16;++r)rli[r]=__builtin_amdgcn_rcpf(wsf[32+crow(r,hi)]);
  bf16*Ow=Ob+(long)(q0+wid*QBLK)*opitch;
  { bf16*stg=(bf16*)(shm+LDS_OST)+wid*2048;
    #pragma unroll
    for(int r=0;r<16;++r){const int orow=crow(r,hi);
      #pragma unroll
      for(int d0=0;d0<2;++d0)stg[orow*64+d0*32+r32]=__float2bfloat16(o[d0][r]*rli[r]);}
    asm volatile("s_waitcnt lgkmcnt(0)":::"memory");
    #pragma unroll
    for(int i=0;i<4;++i){const int row=i*8+(lane>>3),ch=lane&7; const u32x4 v=*(const u32x4*)(stg+row*64+ch*8); ATTN_STORE16(Ow+(long)row*opitch+ch*8,v);} }
  asm volatile("s_waitcnt lgkmcnt(0)\n\ts_barrier":::"memory");
  #undef DMA_K
  #undef TMAP
  #undef DMA_V
  #undef CMASK
  #undef START
  #undef RESC
  #undef ROT
}
constexpr int DSLOT=16384, D_LDS_K=0, D_LDS_V=3*DSLOT, D_LDS_WS=6*DSLOT, D_LDS_Q=D_LDS_WS+NW*256, D_LDS_BYTES=D_LDS_Q+NW*4096;
typedef __attribute__((address_space(3))) char* lds_ptr;
__device__ __forceinline__ void pv4(f32x16*o,int vb,bf16x8 pa0,bf16x8 pa1,bf16x8 pa2,bf16x8 pa3){
  #pragma unroll
  for(int d0=0;d0<4;++d0){s16x4 lo[4],hi[4];
    #pragma unroll
    for(int ks=0;ks<4;++ks){
      asm volatile("ds_read_b64_tr_b16 %0,%1 offset:%c2":"=&v"(lo[ks]):"v"(vb),"i"(d0*4096+ks*1024):"memory");
      asm volatile("ds_read_b64_tr_b16 %0,%1 offset:%c2":"=&v"(hi[ks]):"v"(vb),"i"(d0*4096+ks*1024+512):"memory");}
    asm volatile("s_waitcnt lgkmcnt(0)":::"memory");SBAR();
    #define PK(k) (bf16x8){lo[k][0],lo[k][1],lo[k][2],lo[k][3],hi[k][0],hi[k][1],hi[k][2],hi[k][3]}
    o[d0]=__builtin_amdgcn_mfma_f32_32x32x16_bf16(pa0,PK(0),o[d0],0,0,0);
    o[d0]=__builtin_amdgcn_mfma_f32_32x32x16_bf16(pa1,PK(1),o[d0],0,0,0);
    o[d0]=__builtin_amdgcn_mfma_f32_32x32x16_bf16(pa2,PK(2),o[d0],0,0,0);
    o[d0]=__builtin_amdgcn_mfma_f32_32x32x16_bf16(pa3,PK(3),o[d0],0,0,0);
    #undef PK
  }
}
__device__ __forceinline__ float half_sum(float v){
  #define HS_DPP(ctrl) v+=__builtin_bit_cast(float,__builtin_amdgcn_update_dpp(0,__builtin_bit_cast(int,v),ctrl,0xF,0xF,true))
  HS_DPP(0xB1); HS_DPP(0x4E); HS_DPP(0x141); HS_DPP(0x140);
  #undef HS_DPP
  v+=__builtin_bit_cast(float,__builtin_amdgcn_ds_swizzle(__builtin_bit_cast(int,v),0x401F));
  return v;
}
template<int THRL> __device__ __forceinline__ void dattn_unit(const bf16*Qb,const bf16*__restrict__ Kb,const bf16*__restrict__ Vb,bf16*Ob,int q0,float lam,float omli,const float*subg,char*shm){
  constexpr int OPITCH=1024; constexpr float DEPS=1e-6f;
  int tid_=threadIdx.x; asm volatile("":"+v"(tid_)); const int tid=tid_,lane=tid&63,r32=lane&31,hi=lane>>5; const int wid=__builtin_amdgcn_readfirstlane(tid>>6);
  const int qg=wid>>1,c=wid&1;
  const bf16*Qw=Qb+(long)(q0+qg*QBLK)*PITCH+c*64;
  constexpr int NT=SEQ/KVBLK;
  const unsigned lds0=(unsigned)(uintptr_t)shm;
  float*wsf=(float*)(shm+D_LDS_WS)+wid*64;
  const unsigned ksoff=(unsigned)(lane*PITCH+wid*8)*2u;
  const unsigned vsoff=(unsigned)((16*(wid&3)+(lane>>2))*PITCH+(wid>>2)*32+(lane&3)*8)*2u;
  const unsigned kdst=lds0+D_LDS_K+wid*1024, vdst=lds0+D_LDS_V+wid*1024;
  #define WB(a,b) do{ if(PROBE==20){WAIT_BAR(b);}else{WAIT_BAR(a);} if(PROBE==22){asm volatile("s_barrier":::"memory");} }while(0)
  #define RFL(x) ((unsigned)__builtin_amdgcn_readfirstlane(x))
  #define DMA_K1(t,slot) do{ glds16s(Kb+(long)(t)*KVBLK*PITCH,ksoff,RFL(kdst+(slot))); glds16s(Kb+64+(long)(t)*KVBLK*PITCH,ksoff,RFL(kdst+8192+(slot))); }while(0)
  #define DMA_K(t,slot) do{ DMA_K1(t,slot); if(PROBE==20){DMA_K1(t,slot);} }while(0)
  #define DMA_KA(t,slot) glds16s(Kb+(long)(t)*KVBLK*PITCH,ksoff,RFL(kdst+(slot)))
  #define DMA_KB(t,slot) glds16s(Kb+64+(long)(t)*KVBLK*PITCH,ksoff,RFL(kdst+8192+(slot)))
  #define DMA_VA(t,slot) glds16s(Vb+(long)(t)*KVBLK*PITCH,vsoff,RFL(vdst+(slot)))
  #define DMA_VB(t,slot) glds16s(Vb+64+(long)(t)*KVBLK*PITCH,vsoff,RFL(vdst+8192+(slot)))
  #define DMA_V1(t,slot) do{ glds16s(Vb+(long)(t)*KVBLK*PITCH,vsoff,RFL(vdst+(slot))); glds16s(Vb+64+(long)(t)*KVBLK*PITCH,vsoff,RFL(vdst+8192+(slot))); }while(0)
  #define DMA_V(t,slot) do{ DMA_V1(t,slot); if(PROBE==20){DMA_V1(t,slot);} }while(0)
  const int vb0=(int)(lds0+D_LDS_V)+((lane>>4)&1)*32+(lane&3)*8+(4*hi+((lane&15)>>2))*64;
  const char*Kbase=shm+D_LDS_K+c*8192; bf16x8 kf[8];
  const lds_cptr shm3=(lds_cptr)shm; const lds_cptr kp0=shm3+D_LDS_K+c*8192+hi*1024+r32*16; const lds_cptr vp0=shm3+D_LDS_V+((lane>>4)&1)*32+(lane&3)*8+(4*hi+((lane&15)>>2))*64;
  DMA_K(0,0);DMA_V(0,0);DMA_K(1,DSLOT);
  const __attribute__((address_space(3))) bf16x8*qsp=(const __attribute__((address_space(3))) bf16x8*)((lds_ptr)shm+D_LDS_Q+wid*4096)+lane;
  { bf16x8 qr[4];
    #pragma unroll
    for(int d0=0;d0<4;++d0)qr[d0]=*reinterpret_cast<const bf16x8*>(&Qw[(long)r32*PITCH+d0*16+hi*8]);
    #pragma unroll
    for(int d0=0;d0<4;++d0)((__attribute__((address_space(3))) bf16x8*)qsp)[64*d0]=qr[d0];
    asm volatile("s_waitcnt lgkmcnt(0)":::"memory"); }
  #define QF(d0) (qsp[64*(d0)])
  float zf_=0.f; asm volatile("":"+v"(zf_)); f32x16 zz_; _Pragma("unroll") for(int r=0;r<16;++r)zz_[r]=zf_;
  float mhat=0.f,l_reg=0.f;f32x16 o[4];o[0]=zz_;o[1]=zz_;o[2]=zz_;o[3]=zz_;f32x16 negm=zz_;asm volatile("":"+v"(negm));
  bool resc=false;
  #define START(P0,P1) do{ const float rm=rowmax(P0,P1); resc=false; \
    { const float dl=rm; mhat=fadd_s(mhat,dl); \
      _Pragma("unroll") for(int r=0;r<16;++r){P0[r]=fsub_s(P0[r],dl);P1[r]=fsub_s(P1[r],dl);} \
      _Pragma("unroll") for(int r=0;r<16;++r)negm[r]=-mhat; asm volatile("":"+v"(negm)); } \
    _Pragma("unroll") for(int r=0;r<16;++r)P0[r]=__builtin_amdgcn_exp2f(P0[r]); }while(0)
  #define RESC() do{ if(resc){ asm volatile("s_waitcnt lgkmcnt(0)":::"memory"); \
      _Pragma("unroll") for(int d_=0;d_<4;++d_) _Pragma("unroll") for(int r=0;r<16;++r)o[d_][r]*=wsf[crow(r,hi)]; } }while(0)
  f32x16 pA0,pA1,pB0,pB1;
  int sl_prev=0,sl_cur=0,sl_next=DSLOT;
  #define ROT() do{sl_prev=sl_cur;sl_cur=sl_next;sl_next=(sl_next==2*DSLOT)?0:sl_next+DSLOT;}while(0)
  DMA_K(2,2*DSLOT);
  WB(6,12);
  { bf16x8 qr[4]; _Pragma("unroll") for(int d0=0;d0<4;++d0)qr[d0]=QF(d0); qkt(pA0,pA1,Kbase,qr,negm,r32,hi); }asm volatile("s_nop 15\n\ts_nop 7":"+v"(pA0),"+v"(pA1));
  START(pA0,pA1);
  _Pragma("unroll") for(int r=0;r<16;++r)pA1[r]=__builtin_amdgcn_exp2f(pA1[r]);
  WAIT_BAR(0);
  DMA_K(3,0);DMA_V(1,DSLOT);
  ROT();
  kload8(kf,kp0+sl_cur);
  WB(4,8);
  u32x4 pw0,pw1,pw2,pw3; { const unsigned zu_=__float_as_uint(zf_); pw0=(u32x4){zu_,zu_,zu_,zu_}; pw1=pw0; pw2=pw0; pw3=pw0; }
  #define PKW(P,B) cvtpk_s(P[B],P[B+1])
  #define PAF(k) __builtin_bit_cast(bf16x8,pw##k)
  #define VFR(i) (bf16x8){vlo[i][0],vlo[i][1],vlo[i][2],vlo[i][3],vhi[i][0],vhi[i][1],vhi[i][2],vhi[i][3]}
  #define PIN(x) asm volatile("":"+v"(x))
  #define MX3(a,b,c) __builtin_fmaxf(__builtin_fmaxf((a),(b)),(c))
  #define GAPA(MF,A0,A1,A2,A3,W0,W1,PW) do{ MF; sacc+=A0; sacc+=A1; sacc+=A2; sacc+=A3; PIN(sacc); if(PROBE==23){float d0_; asm volatile("v_add_f32 %0, %1, %1\n\tv_add_f32 %0, %1, %1\n\tv_add_f32 %0, %1, %1\n\tv_add_f32 %0, %1, %1":"=&v"(d0_):"v"(sacc));} W0; W1; PIN(PW); SBAR(); }while(0)
  #define EX(v) __builtin_amdgcn_exp2f(v)
  #define GAPB(MF,X,B) do{ MF; X[B]=EX(X[B]); X[B+1]=EX(X[B+1]); if(PROBE==21){float d0_,d1_; asm volatile("v_exp_f32 %0, %2\n\tv_exp_f32 %1, %3":"=&v"(d0_),"=&v"(d1_):"v"(X[B]),"v"(X[B+1]));} PIN(X); SBAR(); }while(0)
  #define GAPM(MF,OPS) do{ MF; OPS; SBAR(); }while(0)
  #define MXG(X0,X1,r) mxa=MX3(mxa,X0[r],X0[(r)+1]); mxb=MX3(mxb,X0[(r)+2],X0[(r)+3]); mxa=MX3(mxa,X1[r],X1[(r)+1]); mxb=MX3(mxb,X1[(r)+2],X1[(r)+3]); PIN(mxa); PIN(mxb)
  #define GAPE2(MF,X,i0,i1) do{ MF; X[i0]=EX(X[i0]); X[i1]=EX(X[i1]); PIN(X); SBAR(); }while(0)
  #define GAPE3(MF,X,i0,i1,i2) do{ MF; X[i0]=EX(X[i0]); X[i1]=EX(X[i1]); X[i2]=EX(X[i2]); PIN(X); SBAR(); }while(0)
  #define VRD(i) do{ vlo[i]=vtr(vp_+(((i)>>2)*4096+((i)&3)*1024)); vhi[i]=vtr(vp_+(((i)>>2)*4096+((i)&3)*1024+512)); }while(0)
  #define VRD2(i) do{ vlo[i]=vtr(vp_+(((i)>>2)*4096+8192+((i)&3)*1024)); vhi[i]=vtr(vp_+(((i)>>2)*4096+8192+((i)&3)*1024+512)); SBAR(); }while(0)
  #define KRD(G,j) do{ if(G){ kload2(kf,kp0+sl_next,j); SBAR(); } }while(0)
  #define MF32(a,b,cc) __builtin_amdgcn_mfma_f32_32x32x16_bf16(a,b,cc,0,0,0)
  #define STEP(C0,C1,P0,P1,t,GK,GV,GL) do{ SBAR(); s16x4 vlo[8],vhi[8]; \
    const lds_cptr vp_=vp0+sl_prev; \
    VRD(0); SBAR(); float sacc=(P0[0]+P0[1]); \
    GAPA(C0=MF32(kf[0],qa,negm), P0[2],P0[3],P0[4],P0[5],     pw0[0]=PKW(P0,0), pw0[1]=PKW(P0,2), pw0); \
    VRD(4); SBAR(); GAPA(C1=MF32(kf[1],qa,negm), P0[6],P0[7],P0[8],P0[9],     pw0[2]=PKW(P0,4), pw0[3]=PKW(P0,6), pw0); \
    VRD(1); qa=QF(2); SBAR(); GAPA(C0=MF32(kf[2],qb,C0),   P0[10],P0[11],P0[12],P0[13], pw1[0]=PKW(P0,8), pw1[1]=PKW(P0,10), pw1); \
    VRD(5); SBAR(); GAPA(C1=MF32(kf[3],qb,C1),   P0[14],P0[15],P1[0],P1[1],   pw1[2]=PKW(P0,12),pw1[3]=PKW(P0,14), pw1); \
    VRD(2); qb=QF(3); SBAR(); GAPA(C0=MF32(kf[4],qa,C0),   P1[2],P1[3],P1[4],P1[5],     pw2[0]=PKW(P1,0), pw2[1]=PKW(P1,2), pw2); \
    VRD(6); SBAR(); GAPA(C1=MF32(kf[5],qa,C1),   P1[6],P1[7],P1[8],P1[9],     pw2[2]=PKW(P1,4), pw2[3]=PKW(P1,6), pw2); \
    VRD(3); SBAR(); GAPA(C0=MF32(kf[6],qb,C0),   P1[10],P1[11],P1[12],P1[13], pw3[0]=PKW(P1,8), pw3[1]=PKW(P1,10), pw3); \
    VRD(7); SBAR(); GAPA(C1=MF32(kf[7],qb,C1),   P1[14],P1[15],0.f,0.f,       pw3[2]=PKW(P1,12),pw3[3]=PKW(P1,14), pw3); \
    l_reg+=sacc; \
    float mxa,mxb; SBAR(); \
    GAPM(o[0]=MF32(PAF(0),VFR(0),o[0]), mxa=MX3(C0[0],C0[1],C1[0]); mxb=MX3(C0[2],C0[3],C1[1]); mxa=MX3(mxa,C1[2],C1[3]); PIN(mxa); PIN(mxb));  VRD2(0); \
    GAPM(o[1]=MF32(PAF(0),VFR(4),o[1]), MXG(C0,C1,4));  VRD2(4); if(GK){DMA_KA((t)+3,sl_cur);} \
    GAPM(o[0]=MF32(PAF(1),VFR(1),o[0]), MXG(C0,C1,8));  VRD2(1); \
    GAPM(o[1]=MF32(PAF(1),VFR(5),o[1]), MXG(C0,C1,12)); VRD2(5); \
    { float rm=__builtin_fmaxf(mxa,mxb); { auto rr=__builtin_amdgcn_permlane32_swap(__float_as_uint(rm),__float_as_uint(rm),false,false); rm=__builtin_fmaxf(__uint_as_float(rr[0]),__uint_as_float(rr[1])); } \
      resc=false; \
      if(__builtin_expect(__any(rm>(float)THRL),0)){ const float dl=__builtin_fmaxf(rm,0.f); mhat+=dl; \
        _Pragma("unroll") for(int r=0;r<16;++r){C0[r]-=dl;C1[r]-=dl;} \
        _Pragma("unroll") for(int r=0;r<16;++r)negm[r]=-mhat; asm volatile("":"+v"(negm)); \
        const float f=__builtin_amdgcn_exp2f(-dl); l_reg*=f; if(hi==0)wsf[r32]=f; resc=true; } } \
    SBAR(); \
    GAPE3(o[0]=MF32(PAF(2),VFR(2),o[0]), C0,0,1,2);    VRD2(2); \
    GAPE3(o[1]=MF32(PAF(2),VFR(6),o[1]), C0,3,4,5);    VRD2(6); if(GK){DMA_KB((t)+3,sl_cur);} \
    GAPE2(o[0]=MF32(PAF(3),VFR(3),o[0]), C0,6,7);      VRD2(3); \
    GAPE3(o[1]=MF32(PAF(3),VFR(7),o[1]), C0,8,9,10);   VRD2(7); \
    GAPE3(o[2]=MF32(PAF(0),VFR(0),o[2]), C0,11,12,13); \
    GAPE2(o[3]=MF32(PAF(0),VFR(4),o[3]), C0,14,15); if(GV){DMA_VA((t)+1,sl_next);} \
    KRD(GL,0); GAPE3(o[2]=MF32(PAF(1),VFR(1),o[2]), C1,0,1,2); \
    KRD(GL,1); GAPE3(o[3]=MF32(PAF(1),VFR(5),o[3]), C1,3,4,5); \
    KRD(GL,2); GAPE2(o[2]=MF32(PAF(2),VFR(2),o[2]), C1,6,7); \
    KRD(GL,3); GAPE3(o[3]=MF32(PAF(2),VFR(6),o[3]), C1,8,9,10); if(GV){DMA_VB((t)+1,sl_next);} \
    qa=QF(0); SBAR(); GAPE3(o[2]=MF32(PAF(3),VFR(3),o[2]), C1,11,12,13); \
    qb=QF(1); SBAR(); GAPE2(o[3]=MF32(PAF(3),VFR(7),o[3]), C1,14,15); \
    }while(0)
  bf16x8 qa=QF(0),qb=QF(1);
  int t=1;
  for(;t+5<NT;t+=2){
    STEP(pB0,pB1,pA0,pA1,t,true,true,true);     WB(4,8); RESC(); ROT();
    STEP(pA0,pA1,pB0,pB1,t+1,true,true,true);   WB(4,8); RESC(); ROT();
  }
  #define ENDW(tt) do{ if((tt)+3<NT){WB(4,8);} else if((tt)+2<NT){WB(2,4);} else {WAIT_BAR(0);} }while(0)
  for(;t+1<NT;t+=2){
    STEP(pB0,pB1,pA0,pA1,t,(t+3<NT),(t+1<NT),(t+1<NT));       ENDW(t);   RESC(); ROT();
    STEP(pA0,pA1,pB0,pB1,t+1,(t+4<NT),(t+2<NT),(t+2<NT));     ENDW(t+1); RESC(); ROT();
  }
  STEP(pB0,pB1,pA0,pA1,NT-1,false,false,false); RESC();
  { float sacc=pB0[0]+pB0[1]; _Pragma("unroll") for(int r=2;r<16;++r)sacc+=pB0[r]; _Pragma("unroll") for(int r=0;r<16;++r)sacc+=pB1[r]; l_reg+=sacc;
    pw0=(u32x4){PKW(pB0,0),PKW(pB0,2),PKW(pB0,4),PKW(pB0,6)};pw1=(u32x4){PKW(pB0,8),PKW(pB0,10),PKW(pB0,12),PKW(pB0,14)};pw2=(u32x4){PKW(pB1,0),PKW(pB1,2),PKW(pB1,4),PKW(pB1,6)};pw3=(u32x4){PKW(pB1,8),PKW(pB1,10),PKW(pB1,12),PKW(pB1,14)};
    SBAR(); pv4(o,vb0+sl_cur,PAF(0),PAF(1),PAF(2),PAF(3)); }
  #undef PKW
  #undef PAF
  #undef VFR
  #undef PIN
  #undef MX3
  #undef GAPA
  #undef GAPB
  #undef GAPM
  #undef MXG
  #undef GAPE2
  #undef GAPE3
  #undef EX
  #undef VRD
  #undef VRD2
  #undef KRD
  #undef MF32
  #undef QF
  #undef STEP
  #undef ENDW
  {auto rr=__builtin_amdgcn_permlane32_swap(__float_as_uint(l_reg),__float_as_uint(l_reg),false,false);l_reg=__uint_as_float(rr[0])+__uint_as_float(rr[1]);}
  if(hi==0)wsf[32+r32]=l_reg;asm volatile("s_waitcnt lgkmcnt(0)":::"memory");
  float rli[16];
  #pragma unroll
  for(int r=0;r<16;++r)rli[r]=__builtin_amdgcn_rcpf(wsf[32+crow(r,hi)]);
  asm volatile("s_waitcnt lgkmcnt(0)\n\ts_barrier":::"memory");
  int tide_=threadIdx.x; asm volatile("":"+v"(tide_)); const int lane_e=tide_&63;
  __attribute__((address_space(3))) float*xf=(__attribute__((address_space(3))) float*)((lds_ptr)shm+qg*16384)+lane_e;
  if(c==1){
    #pragma unroll
    for(int d_=0;d_<4;++d_)
      #pragma unroll
      for(int r=0;r<16;++r)xf[(d_*16+r)*64]=o[d_][r]*rli[r];
  }
  asm volatile("s_waitcnt lgkmcnt(0)\n\ts_barrier":::"memory");
  if(c==0){
    float ss[16];
    #pragma unroll
    for(int r=0;r<16;++r)ss[r]=0.f;
    #pragma unroll
    for(int d_=0;d_<4;++d_)
      #pragma unroll
      for(int r=0;r<16;++r){const float v=o[d_][r]*rli[r]-lam*xf[(d_*16+r)*64];o[d_][r]=v;ss[r]+=v*v;}
    #pragma unroll
    for(int r=0;r<16;++r){const float s=half_sum(ss[r]);ss[r]=omli/sqrtf(s*(1.f/128.f)+DEPS);}
    __attribute__((address_space(3))) unsigned short*sb=(__attribute__((address_space(3))) unsigned short*)((lds_ptr)shm+65536+qg*8192);
    #pragma unroll
    for(int d_=0;d_<4;++d_){const float g=subg[d_*32+r32];
      #pragma unroll
      for(int r=0;r<16;++r){const float y=o[d_][r]*ss[r]*g; sb[crow(r,hi)*128+d_*32+r32]=(unsigned short)(cvtpk_s(y,y)&0xffffu);}}
    asm volatile("s_waitcnt lgkmcnt(0)":::"memory");
    bf16*Ow=Ob+(long)(q0+qg*QBLK)*OPITCH;
    #pragma unroll
    for(int i=0;i<8;++i){const int row=i*4+(lane_e>>4),ch=lane_e&15; const u32x4 v=*(const __attribute__((address_space(3))) u32x4*)(sb+row*128+ch*8); ATTN_STORE16(Ow+(long)row*OPITCH+ch*8,v);}
  }
  asm volatile("s_waitcnt lgkmcnt(0)\n\ts_barrier":::"memory");
  #undef DMA_K
  #undef DMA_V
  #undef RFL
  #undef WB
  #undef DMA_K1
  #undef DMA_KA
  #undef DMA_KB
  #undef DMA_VA
  #undef DMA_VB
  #undef DMA_V1
  #undef START
  #undef RESC
  #undef ROT
}

typedef int v4i_a __attribute__((ext_vector_type(4)));
typedef int v8i_a __attribute__((ext_vector_type(8)));
#define CAT8A(a,b) __builtin_shufflevector((a),(b),0,1,2,3,4,5,6,7)
template<int THRL> __device__ __forceinline__ void dattn_unit_f8(const unsigned char*P8,const unsigned char*VTh,int h,bf16*Ob,int q0,float lam,float omli,const float*subg,char*shm){
  constexpr int OPITCH=1024,P8P=1536; constexpr float DEPS=1e-6f; constexpr int NT=SEQ/64; constexpr int SLOT=8192,F_K=0,F_V=3*SLOT,F_WS=6*SLOT;
  int tid_=threadIdx.x; asm volatile("":"+v"(tid_)); const int tid=tid_,lane=tid&63,r32=lane&31,hi=lane>>5; const int wid=__builtin_amdgcn_readfirstlane(tid>>6);
  const int qg=wid>>1,c=wid&1;
  const unsigned lds0=(unsigned)(uintptr_t)shm;
  float*wsf=(float*)(shm+F_WS)+wid*64;
  #define RFL(x) ((unsigned)__builtin_amdgcn_readfirstlane(x))
  const unsigned char*Kg=P8+512+h*128;
  const unsigned kvoff=(unsigned)(lane*P8P+(wid&3)*16+(wid>>2)*64);
  const unsigned vvoff=(unsigned)(((wid>>2)*64+lane)*SEQ+(wid&3)*16);
  const unsigned kdst=lds0+F_K+wid*1024, vdst=lds0+F_V+(wid&3)*2048+(wid>>2)*1024;
  #define DMAK(t,slot) glds16s(Kg+(long)(t)*64*P8P,kvoff,RFL(kdst+(slot)))
  #define DMAV(t,slot) glds16s(VTh+(long)(t)*64,vvoff,RFL(vdst+(slot)))
  v8i_a q8; { const unsigned char*Qp=P8+(long)(q0+qg*32+r32)*P8P+h*128+c*64+hi*32; const v4i_a qa=*(const v4i_a*)Qp, qb=*(const v4i_a*)(Qp+16); q8=CAT8A(qa,qb); }
  DMAK(0,0);DMAV(0,0);DMAK(1,SLOT);DMAV(1,SLOT);
  typedef __attribute__((address_space(3))) const v4i_a* lv4;
  const lds_cptr shm3=(lds_cptr)shm; const lds_cptr kp0=shm3+F_K+c*4096+(2*hi)*1024+r32*16, vp0=shm3+F_V+(2*hi)*2048+r32*16;
  float zf_=0.f; asm volatile("":"+v"(zf_)); f32x16 zz_; _Pragma("unroll") for(int r=0;r<16;++r)zz_[r]=zf_;
  float mhat=0.f; f32x16 o[4]; o[0]=zz_;o[1]=zz_;o[2]=zz_;o[3]=zz_; f32x16 lacc=zz_; f32x16 negm=zz_; asm volatile("":"+v"(negm));
  v8i_a ones; { int on_=0x38383838; asm volatile("":"+v"(on_)); _Pragma("unroll") for(int j=0;j<8;++j)ones[j]=on_; }
  #define MFQK(C,KF) asm volatile("v_mfma_f32_32x32x64_f8f6f4 %0, %1, %2, %3":"=&v"(C):"v"(KF),"v"(q8),"v"(negm))
  #define MFPV(O,VF) asm volatile("v_mfma_f32_32x32x64_f8f6f4 %0, %1, %2, %0":"+v"(O):"v"(pw),"v"(VF))
  #define KFRAG(kp) const v8i_a kf0=CAT8A(*(lv4)(kp),*(lv4)((kp)+1024)), kf1=CAT8A(*(lv4)((kp)+512),*(lv4)((kp)+1536))
  #define VFRAG(vp) do{ vf0=CAT8A(*(lv4)(vp),*(lv4)((vp)+2048)); vf1=CAT8A(*(lv4)((vp)+512),*(lv4)((vp)+2560)); vf2=CAT8A(*(lv4)((vp)+1024),*(lv4)((vp)+3072)); vf3=CAT8A(*(lv4)((vp)+1536),*(lv4)((vp)+3584)); }while(0)
  #define SOFTMAX(FIRST,WAITO) do{ const float rm=rowmax(C0,C1); \
    if((FIRST)||__any(rm>(float)THRL)){ const float dl=(FIRST)?rm:__builtin_fmaxf(rm,0.f); mhat+=dl; \
      _Pragma("unroll") for(int r=0;r<16;++r){C0[r]-=dl;C1[r]-=dl;} \
      _Pragma("unroll") for(int r=0;r<16;++r)negm[r]=-mhat; asm volatile("":"+v"(negm)); \
      if(!(FIRST)){ const float f=__builtin_amdgcn_exp2f(-dl); if(hi==0)wsf[r32]=f; \
        if(WAITO){ _Pragma("unroll") for(int rep_=0;rep_<(WAITO);++rep_) asm volatile("s_nop 15\n\ts_nop 15\n\ts_nop 15\n\ts_nop 15\n\ts_nop 15\n\ts_nop 15":"+v"(o[0]),"+v"(o[1]),"+v"(o[2]),"+v"(o[3]),"+v"(lacc)); } \
        asm volatile("s_waitcnt lgkmcnt(0)":::"memory"); \
        _Pragma("unroll") for(int r=0;r<16;++r){ const float fr_=wsf[crow(r,hi)]; o[0][r]*=fr_; o[1][r]*=fr_; o[2][r]*=fr_; o[3][r]*=fr_; lacc[r]*=fr_; } } } \
    _Pragma("unroll") for(int r=0;r<16;++r){C0[r]=__builtin_amdgcn_exp2f(C0[r]);C1[r]=__builtin_amdgcn_exp2f(C1[r]);} \
    _Pragma("unroll") for(int j=0;j<4;++j){ int w0=0,w1=0; \
      w0=__builtin_amdgcn_cvt_pk_fp8_f32(C0[4*j],C0[4*j+1],w0,false); w0=__builtin_amdgcn_cvt_pk_fp8_f32(C0[4*j+2],C0[4*j+3],w0,true); \
      w1=__builtin_amdgcn_cvt_pk_fp8_f32(C1[4*j],C1[4*j+1],w1,false); w1=__builtin_amdgcn_cvt_pk_fp8_f32(C1[4*j+2],C1[4*j+3],w1,true); \
      pw[j]=w0; pw[4+j]=w1; } }while(0)
  #define DRAIN() do{ float d_=lacc[15]; asm volatile("v_mov_b32 %0, %0":"+v"(d_),"+v"(C0),"+v"(C1)::"memory"); }while(0)
  v8i_a pw,vf0,vf1,vf2,vf3; f32x16 C0,C1;
  int sl=0,sl2=2*SLOT;
  #define ROTS() do{ sl=(sl==2*SLOT)?0:sl+SLOT; sl2=(sl2==2*SLOT)?0:sl2+SLOT; }while(0)
  if(wid<LEAD_WAVES){
    WAIT_BAR(2); DMAK(2,sl2);DMAV(2,sl2);
    { KFRAG(kp0); MFQK(C0,kf0); MFQK(C1,kf1); VFRAG(vp0); asm volatile("s_nop 15\n\ts_nop 15":"+v"(C0),"+v"(C1)); SOFTMAX(true,0); }
    ROTS();
    #pragma unroll 1
    for(int t=1;t<NT;++t){
      if(t+1<NT){WAIT_BAR(2);}else{WAIT_BAR(0);}
      if(t+2<NT){DMAK(t+2,sl2);DMAV(t+2,sl2);}
      { KFRAG(kp0+sl); MFQK(C0,kf0); MFQK(C1,kf1); }
      MFPV(o[0],vf0); SBAR();
      asm volatile("":"+v"(C0));
      float ma=max3f(C0[0],C0[1],C0[2]); ma=max3f(ma,C0[3],C0[4]); ma=max3f(ma,C0[5],C0[6]); ma=max3f(ma,C0[7],C0[8]); ma=max3f(ma,C0[9],C0[10]); ma=max3f(ma,C0[11],C0[12]); ma=max3f(ma,C0[13],C0[14]); ma=max2f(ma,C0[15]);
      SBAR(); MFPV(o[1],vf1); SBAR();
      asm volatile("":"+v"(C1));
      float mb=max3f(C1[0],C1[1],C1[2]); mb=max3f(mb,C1[3],C1[4]); mb=max3f(mb,C1[5],C1[6]); mb=max3f(mb,C1[7],C1[8]); mb=max3f(mb,C1[9],C1[10]); mb=max3f(mb,C1[11],C1[12]); mb=max3f(mb,C1[13],C1[14]); mb=max3f(mb,C1[15],ma);
      float rm; { auto rr=__builtin_amdgcn_permlane32_swap(__float_as_uint(mb),__float_as_uint(mb),false,false); rm=max2f(__uint_as_float(rr[0]),__uint_as_float(rr[1])); }
      SBAR(); MFPV(o[2],vf2); SBAR();
      _Pragma("unroll") for(int r=0;r<8;++r)C0[r]=__builtin_amdgcn_exp2f(C0[r]);
      SBAR(); MFPV(o[3],vf3); SBAR();
      _Pragma("unroll") for(int r=8;r<16;++r)C0[r]=__builtin_amdgcn_exp2f(C0[r]);
      SBAR(); MFPV(lacc,ones); SBAR();
      _Pragma("unroll") for(int r=0;r<16;++r)C1[r]=__builtin_amdgcn_exp2f(C1[r]);
      if(__any(rm>(float)THRL)){ const float dl=__builtin_fmaxf(rm,0.f); mhat+=dl;
        _Pragma("unroll") for(int r=0;r<16;++r)negm[r]=-mhat; asm volatile("":"+v"(negm));
        const float f=__builtin_amdgcn_exp2f(-dl); if(hi==0)wsf[r32]=f;
        _Pragma("unroll") for(int r=0;r<16;++r){C0[r]*=f;C1[r]*=f;}
#if RESC_DRAIN
        { const float le_=lacc[15]; float td_;
          asm volatile("v_mov_b32 %5, %6\n\ts_nop 15\n\ts_nop 15":"+v"(o[0]),"+v"(o[1]),"+v"(o[2]),"+v"(o[3]),"+v"(lacc),"=&v"(td_):"v"(le_)); }
#else
        _Pragma("unroll") for(int rep_=0;rep_<RESC_NOPS;++rep_) asm volatile("s_nop 15\n\ts_nop 15\n\ts_nop 15\n\ts_nop 15\n\ts_nop 15\n\ts_nop 15":"+v"(o[0]),"+v"(o[1]),"+v"(o[2]),"+v"(o[3]),"+v"(lacc));
#endif
        asm volatile("s_waitcnt lgkmcnt(0)":::"memory");
        _Pragma("unroll") for(int r=0;r<16;++r){ const float fr_=wsf[crow(r,hi)]; o[0][r]*=fr_; o[1][r]*=fr_; o[2][r]*=fr_; o[3][r]*=fr_; lacc[r]*=fr_; } }
      _Pragma("unroll") for(int j=0;j<4;++j){ int w0=0,w1=0;
        w0=__builtin_amdgcn_cvt_pk_fp8_f32(C0[4*j],C0[4*j+1],w0,false); w0=__builtin_amdgcn_cvt_pk_fp8_f32(C0[4*j+2],C0[4*j+3],w0,true);
        w1=__builtin_amdgcn_cvt_pk_fp8_f32(C1[4*j],C1[4*j+1],w1,false); w1=__builtin_amdgcn_cvt_pk_fp8_f32(C1[4*j+2],C1[4*j+3],w1,true);
        pw[j]=w0; pw[4+j]=w1; }
      VFRAG(vp0+sl);
      ROTS();
    }
    asm volatile("s_waitcnt lgkmcnt(0)":::"memory");
    MFPV(o[0],vf0); MFPV(o[1],vf1); MFPV(o[2],vf2); MFPV(o[3],vf3); MFPV(lacc,ones);
  } else {
    WAIT_BAR(2); DMAK(2,sl2);DMAV(2,sl2);
    { KFRAG(kp0); MFQK(C0,kf0); MFQK(C1,kf1); VFRAG(vp0); asm volatile("s_nop 15\n\ts_nop 15":"+v"(C0),"+v"(C1)); SOFTMAX(true,0); }
    MFPV(o[0],vf0); MFPV(o[1],vf1); MFPV(o[2],vf2); MFPV(o[3],vf3); MFPV(lacc,ones);
    ROTS();
    #pragma unroll 1
    for(int t=1;t<NT;++t){
      if(t+1<NT){WAIT_BAR(2);}else{WAIT_BAR(0);}
      if(t+2<NT){DMAK(t+2,sl2);DMAV(t+2,sl2);}
      { KFRAG(kp0+sl); MFQK(C0,kf0); MFQK(C1,kf1); }
      VFRAG(vp0+sl);
      asm volatile("s_nop 15\n\ts_nop 15":"+v"(C0),"+v"(C1));
      SOFTMAX(false,1);
      MFPV(o[0],vf0); MFPV(o[1],vf1); MFPV(o[2],vf2); MFPV(o[3],vf3); MFPV(lacc,ones);
      ROTS();
    }
  }
  asm volatile("s_nop 15\n\ts_nop 15\n\ts_nop 15\n\ts_nop 15\n\ts_nop 15\n\ts_nop 15":"+v"(o[0]),"+v"(o[1]),"+v"(o[2]),"+v"(o[3]),"+v"(lacc));
  #undef MFQK
  #undef MFPV
  #undef KFRAG
  #undef VFRAG
  #undef SOFTMAX
  #undef ROTS
  #undef DRAIN
  float rli[16];
  #pragma unroll
  for(int r=0;r<16;++r)rli[r]=__builtin_amdgcn_rcpf(lacc[r]);
  asm volatile("s_waitcnt lgkmcnt(0)\n\ts_barrier":::"memory");
  int tide_=threadIdx.x; asm volatile("":"+v"(tide_)); const int lane_e=tide_&63;
  __attribute__((address_space(3))) float*xf=(__attribute__((address_space(3))) float*)((lds_ptr)shm+qg*16384)+lane_e;
  if(c==1){
    #pragma unroll
    for(int d_=0;d_<4;++d_)
      #pragma unroll
      for(int r=0;r<16;++r)xf[(d_*16+r)*64]=o[d_][r]*rli[r];
  }
  asm volatile("s_waitcnt lgkmcnt(0)\n\ts_barrier":::"memory");
  if(c==0){
    float ss[16];
    #pragma unroll
    for(int r=0;r<16;++r)ss[r]=0.f;
    #pragma unroll
    for(int d_=0;d_<4;++d_)
      #pragma unroll
      for(int r=0;r<16;++r){const float v=o[d_][r]*rli[r]-lam*xf[(d_*16+r)*64];o[d_][r]=v;ss[r]+=v*v;}
    #pragma unroll
    for(int r=0;r<16;++r){const float s=half_sum(ss[r]);ss[r]=omli/sqrtf(s*(1.f/128.f)+DEPS);}
    __attribute__((address_space(3))) unsigned short*sb=(__attribute__((address_space(3))) unsigned short*)((lds_ptr)shm+65536+qg*8192);
    #pragma unroll
    for(int d_=0;d_<4;++d_){const float g=subg[d_*32+r32];
      #pragma unroll
      for(int r=0;r<16;++r){const float y=o[d_][r]*ss[r]*g; sb[crow(r,hi)*128+d_*32+r32]=(unsigned short)(cvtpk_s(y,y)&0xffffu);}}
    asm volatile("s_waitcnt lgkmcnt(0)":::"memory");
    bf16*Ow=Ob+(long)(q0+qg*QBLK)*OPITCH;
    #pragma unroll
    for(int i=0;i<8;++i){const int row=i*4+(lane_e>>4),ch=lane_e&15; const u32x4 v=*(const __attribute__((address_space(3))) u32x4*)(sb+row*128+ch*8); ATTN_STORE16(Ow+(long)row*OPITCH+ch*8,v);}
  }
  asm volatile("s_waitcnt lgkmcnt(0)\n\ts_barrier":::"memory");
  #undef RFL
  #undef DMAK
  #undef DMAV
}
#undef CAT8A
constexpr int ATTN_LDS_BYTES=LDS_BYTES;
#undef SBAR
#undef WAIT_BAR
}

constexpr size_t MiB = 1u << 20;
constexpr size_t WS_CTL = 0, CTL_ZERO_BYTES = 1 * MiB;
constexpr size_t WS_MOD = 1 * MiB;
constexpr size_t WS_RC = 2 * MiB, WS_RS = 4 * MiB;
constexpr size_t WS_ROUTE = 6 * MiB, ROUTE_LAYER = 1024 * 1024;
constexpr size_t WS_WIN = 8 * MiB, WS_WOUT = 26 * MiB, WS_WGU_D = 34 * MiB, WS_WD_D = 62 * MiB, WS_WGU_M = 76 * MiB, WS_WD_M = 300 * MiB;
constexpr size_t WS_HA = 412 * MiB;
constexpr size_t WS_PROJ = 444 * MiB;
constexpr size_t WS_ATT = 516 * MiB;
constexpr size_t WS_PROJ8 = 548 * MiB;
constexpr size_t WS_VT = 576 * MiB;
constexpr size_t WS_OD = 548 * MiB;
constexpr size_t WS_HMID = 444 * MiB;
constexpr size_t WS_XS = 682 * MiB;
constexpr size_t WS_XB = 682 * MiB;
constexpr size_t WS_YSP = 716 * MiB;
constexpr size_t WS_YS = 750 * MiB;
constexpr size_t WS_END = 818 * MiB;
static_assert(WS_WD_M + (size_t)2 * NE * DM * FF * 2 <= WS_HA && WS_HMID + (size_t)PMAX * FF * 2 <= WS_XS && WS_XS + (size_t)PMAX * DM * 2 <= WS_YS && WS_YS + (size_t)PMAX * DM * 2 <= WS_END, "d_ws map");
static_assert(WS_XB + (size_t)NTOK * DM * 2 <= WS_YSP && WS_YSP + (size_t)6 * pg8::TAILROWS * DM * 2 <= WS_YS, "d_ws map 3");
static_assert(WS_OD + (size_t)2 * NTOK * 512 * 2 <= WS_HMID + (size_t)NTOK * FF * 2 + 200 * MiB, "d_ws map 2");
constexpr int CW_BAR = 4096;
constexpr int CW_IPDONE = 8192 + 1100;
constexpr int CW_QCTR = 8192 + 1024;
constexpr int CW_CNT = 8192;

constexpr int RING_OFF = 0, RING_BYTES = 135168;
constexpr int LDSCTL_OFF = RING_BYTES, MISC_OFF = LDSCTL_OFF + 320;
constexpr int TAB_OFF = MISC_OFF + 128;
constexpr int IDX_OFF = TAB_OFF + 4 * 176, IDX_UNITS = 16;
constexpr int LDS_BYTES = 155648;
static_assert(16 + NCHUNK_MAX <= 160 && IDX_OFF + IDX_UNITS * 1024 <= LDS_BYTES && (NCHUNK_MAX * (2 * FF / 256) + 255) / 256 <= IDX_UNITS && 8 * 64 * 65 * 4 <= RING_BYTES, "LDS map");

#define GAS __attribute__((address_space(1)))
#define LAS __attribute__((address_space(3)))
typedef unsigned short bf16;
typedef unsigned v4u __attribute__((ext_vector_type(4)));
typedef float f32x4 __attribute__((ext_vector_type(4)));
typedef short bf16x8 __attribute__((ext_vector_type(8)));
typedef GAS unsigned gu32;
typedef GAS unsigned long long gu64;
#define RLX_AGENT __ATOMIC_RELAXED, __HIP_MEMORY_SCOPE_AGENT
#define LDS_WAIT() asm volatile("s_waitcnt lgkmcnt(0)" ::: "memory")
#define VM_WAIT() asm volatile("s_waitcnt vmcnt(0)" ::: "memory")
__device__ __forceinline__ unsigned long long rt() { return __builtin_amdgcn_s_memrealtime(); }
__device__ __forceinline__ unsigned f2bf(float f) { unsigned u = __builtin_bit_cast(unsigned, f); return (u + 0x7fffu + ((u >> 16) & 1u)) >> 16; }
__device__ __forceinline__ unsigned pk2(float lo, float hi) { return f2bf(lo) | (f2bf(hi) << 16); }

#define XB_TMO      128
#define XB_XCNT(j)  (256  + 64 * (j))
#define XB_XSUB(j)  (1280 + 64 * (j))
#define XB_XGEN(j)  (2304 + 64 * (j))
#define XB_TOP      3328
#define XB_TOPGEN   3392
#define XCD_BAR_WORDS 3456
#define XB_SPIN_CAP (1u << 18)

__device__ __forceinline__ unsigned xb_ld(GAS unsigned* p)          { return __hip_atomic_load(p, __ATOMIC_RELAXED, __HIP_MEMORY_SCOPE_AGENT); }
__device__ __forceinline__ unsigned xb_add(GAS unsigned* p, unsigned v) { return __hip_atomic_fetch_add(p, v, __ATOMIC_RELAXED, __HIP_MEMORY_SCOPE_AGENT); }
__device__ __forceinline__ unsigned xb_xcc_id() { return (unsigned)__builtin_amdgcn_s_getreg((3 << 11) | 20) & 0xFu; }
#define XB_SPIN(cond, bar) do { unsigned _sp = 0; while (cond) { __builtin_amdgcn_s_sleep(1); \
    if ((++_sp & 255u) == 0u) { if (xb_ld(&(bar)[XB_TMO])) break; if (_sp > XB_SPIN_CAP) { (void)xb_add(&(bar)[XB_TMO], 1u); break; } } } } while (0)

struct XcdBarrier {
    unsigned* bar; unsigned x;
    volatile LAS unsigned* st;
};

__device__ __forceinline__ XcdBarrier xcd_barrier_post(unsigned* bar, volatile LAS unsigned* st) {
    XcdBarrier b; b.bar = bar; b.x = xb_xcc_id(); b.st = st;
    if (threadIdx.x == 0) (void)xb_add((GAS unsigned*)bar + XB_XCNT(b.x), 1u);
    return b;
}
__device__ __forceinline__ void xcd_barrier_complete(GAS unsigned* bar, unsigned x, unsigned& nloc, unsigned& nx) {
    const unsigned G = gridDim.x * gridDim.y * gridDim.z;
    unsigned sum, cnt, mine, sp = 0u;
    for (;;) {
        sum = 0u; cnt = 0u; mine = 0u;
#pragma unroll
        for (unsigned j = 0; j < 16; ++j) { const unsigned c = xb_ld(&bar[XB_XCNT(j)]); sum += c; cnt += (c > 0u) ? 1u : 0u; mine = (j == x) ? c : mine; }
        if (sum == G) break;
        __builtin_amdgcn_s_sleep(1);
        if ((++sp & 255u) == 0u) { if (xb_ld(&bar[XB_TMO])) break; if (sp > XB_SPIN_CAP) { (void)xb_add(&bar[XB_TMO], 1u); break; } }
    }
    nloc = mine > 0u ? mine : 1u; nx = cnt > 0u ? cnt : 1u;
}

__device__ __forceinline__ void xcd_barrier(const XcdBarrier& b) {
    asm volatile("s_waitcnt vmcnt(0)" ::: "memory");
    __syncthreads();
    if (threadIdx.x == 0) {
        GAS unsigned* bar = (GAS unsigned*)b.bar; unsigned bx_ = b.x; asm volatile("" : "+s"(bar), "+s"(bx_));
        __builtin_amdgcn_s_waitcnt(0);
        unsigned nloc = b.st[0], nx = b.st[1];
        if (nloc == 0u) { xcd_barrier_complete(bar, bx_, nloc, nx); b.st[0] = nloc; b.st[1] = nx; }
        const unsigned old = xb_add(&bar[XB_XSUB(bx_)], 1u);
        const unsigned gen = old / nloc;
        if (old + 1u == (gen + 1u) * nloc) {
            __builtin_amdgcn_fence(__ATOMIC_RELEASE, "agent");
            asm volatile("s_waitcnt vmcnt(0)" ::: "memory");
            const unsigned og = xb_add(&bar[XB_TOP], 1u);
            const unsigned tg = og / nx;
            if (og + 1u == (tg + 1u) * nx) xb_add(&bar[XB_TOPGEN], 1u);
            else XB_SPIN(xb_ld(&bar[XB_TOPGEN]) == tg, bar);
            __builtin_amdgcn_fence(__ATOMIC_ACQUIRE, "agent");
            xb_add(&bar[XB_XGEN(bx_)], 1u);
            asm volatile("s_waitcnt vmcnt(0)" ::: "memory");
        } else {
            XB_SPIN(xb_ld(&bar[XB_XGEN(bx_)]) == gen, bar);
            __builtin_amdgcn_fence(__ATOMIC_ACQUIRE, "agent");
            asm volatile("s_waitcnt vmcnt(0)" ::: "memory");
        }
    }
    __syncthreads();
}


constexpr int NWAVES = 8;
struct Frame {
    LAS unsigned char* lds;
    volatile LAS unsigned* MISC;
    gu32* ctl;
    int tid, lane, wave;
    int vcu, G;
};
__device__ __forceinline__ float wave_sum(float v) {
#define WS_DPP(ctrl) v += __builtin_bit_cast(float, __builtin_amdgcn_update_dpp(0, __builtin_bit_cast(int, v), ctrl, 0xF, 0xF, true))
    WS_DPP(0xB1); WS_DPP(0x4E); WS_DPP(0x141); WS_DPP(0x140);
#undef WS_DPP
    v += __builtin_bit_cast(float, __builtin_amdgcn_ds_swizzle(__builtin_bit_cast(int, v), 0x401F));
    const auto rr = __builtin_amdgcn_permlane32_swap(__builtin_bit_cast(unsigned, v), __builtin_bit_cast(unsigned, v), false, false);
    return __uint_as_float(rr[0]) + __uint_as_float(rr[1]);
}
__device__ __forceinline__ void sincos_acc(float angf, float& s, float& c) {
    const double a = (double)angf;
    const double k = rint(a * 0.63661977236758134308);
    double r = fma(-k, 1.57079632679489655800e+00, a); r = fma(-k, 6.12323399573676603587e-17, r);
    const double r2 = r * r;
    double sp = -2.5052108385441718775e-08; sp = sp * r2 + 2.7557319223985890653e-06; sp = sp * r2 - 1.9841269841269841253e-04; sp = sp * r2 + 8.3333333333333332177e-03; sp = sp * r2 - 1.6666666666666665741e-01;
    const double sn = r + r * r2 * sp;
    double cp = 2.0876756987868098979e-09; cp = cp * r2 - 2.7557319223985888e-07; cp = cp * r2 + 2.4801587301587301566e-05; cp = cp * r2 - 1.3888888888888889419e-03; cp = cp * r2 + 4.1666666666666664354e-02; cp = cp * r2 - 0.5;
    const double cs = 1.0 + r2 * cp;
    const int q = ((int)k) & 3;
    const double ss = (q == 0) ? sn : (q == 1) ? cs : (q == 2) ? -sn : -cs;
    const double cc = (q == 0) ? cs : (q == 1) ? -sn : (q == 2) ? -cs : sn;
    s = (float)ss; c = (float)cc;
}

template <int MAP> __device__ __forceinline__ int rowmap(int n) {
    if (MAP == 1) { const bool rope = (n < COL_VA) || (n >= COL_QD && n < COL_VD); if (!rope) return n; const int d = n & 63; return (n & ~63) + ((d < 32) ? 2 * d : 2 * (d - 32) + 1); }
    if (MAP == 2) return ((n >> 7) << 8) + (n & 127);
    if (MAP == 3) return ((n >> 7) << 8) + 128 + (n & 127);
    return n;
}
template <int MAP, bool F8 = false> __device__ __forceinline__ void cvt_item(const float* W, int K, int N, bf16* WT, LAS float* scr, int item, int lane, float f8s = 1.f) {
    const int kblk = K >> 6, nb = item / kblk, kb = item - nb * kblk, k0 = kb * 64, n0 = nb * 64;
    const GAS float* src = (const GAS float*)W + (size_t)k0 * N + n0 + lane;
    float tv[64];
#pragma unroll
    for (int kk = 0; kk < 64; ++kk) tv[kk] = __builtin_nontemporal_load(src + (size_t)kk * N);
#pragma unroll
    for (int kk = 0; kk < 64; ++kk) scr[kk * 65 + lane] = tv[kk];
    LDS_WAIT(); asm volatile("" ::: "memory");
    const int c = lane & 7;
#pragma unroll
    for (int j = 0; j < 8; ++j) { const int n = (lane >> 3) + 8 * j; const LAS float* s = scr + (8 * c) * 65 + n;
        if (F8) { const unsigned long long o8 = (unsigned long long)pg8::pack4_fp8(s[0 * 65] * f8s, s[1 * 65] * f8s, s[2 * 65] * f8s, s[3 * 65] * f8s) | ((unsigned long long)pg8::pack4_fp8(s[4 * 65] * f8s, s[5 * 65] * f8s, s[6 * 65] * f8s, s[7 * 65] * f8s) << 32);
            *(GAS unsigned long long*)((GAS unsigned char*)WT + (size_t)rowmap<MAP>(n0 + n) * K + k0 + 8 * c) = o8; }
        else { v4u o; o.x = pk2(s[0 * 65], s[1 * 65]); o.y = pk2(s[2 * 65], s[3 * 65]); o.z = pk2(s[4 * 65], s[5 * 65]); o.w = pk2(s[6 * 65], s[7 * 65]);
            *(GAS v4u*)(WT + (size_t)rowmap<MAP>(n0 + n) * K + k0 + 8 * c) = o; } }
    LDS_WAIT(); asm volatile("" ::: "memory");
}
constexpr int IT_IN = (DM / 64) * (INC / 64)  , IT_OUT = (DM / 64) * (DM / 64)  , IT_FF = (DM / 64) * (FF / 64)  ;
constexpr int IT_A = DEPTH * IT_IN, IT_B = IT_A + DEPTH * IT_OUT, IT_SET = 3 * IT_FF, NITEMS = IT_B + 18 * IT_SET;
struct Ptrs {
    const float* in[23]; float* out; unsigned char* ws;
};
struct RopeFreq { float inv[32]; };
struct Args { Ptrs p; RopeFreq rf; float lam_init[4]; int ph_lo, ph_hi; };
typedef const __attribute__((address_space(4))) Args* CArgs;
__device__ __forceinline__ CArgs kargs() { CArgs a = (CArgs)__builtin_amdgcn_kernarg_segment_ptr(); asm volatile("" : "+s"(a)); return a; }
__device__ __forceinline__ void convert_item(CArgs ka, int it, LAS float* scr, int lane) {
    const auto& P = ka->p; unsigned char* ws = P.ws;
    if (it < IT_A) { const int l = it / IT_IN, r = it - l * IT_IN; if (pg8::F8_IN) cvt_item<1, true>(P.in[7] + (size_t)l * DM * INC, DM, INC, (bf16*)(ws + WS_WIN + (size_t)l * INC * DM), scr, r, lane, pg8::F8_SW1); else cvt_item<1>(P.in[7] + (size_t)l * DM * INC, DM, INC, (bf16*)(ws + WS_WIN) + (size_t)l * INC * DM, scr, r, lane); return; }
    if (it < IT_B) { it -= IT_A; const int l = it / IT_OUT, r = it - l * IT_OUT; cvt_item<0>(P.in[8] + (size_t)l * DM * DM, DM, DM, (bf16*)(ws + WS_WOUT) + (size_t)l * DM * DM, scr, r, lane); return; }
    it -= IT_B; const int set = it / IT_SET; int r = it - set * IT_SET; const int kind = r / IT_FF; r -= kind * IT_FF;
    const float *wg, *wu, *wd; bf16 *dgu, *dd;
    bool f1, f2;
    if (set < 2) { f1 = pg8::F8_D1; f2 = pg8::F8_D2; const size_t o = (size_t)set * DM * FF; wg = P.in[15] + o; wu = P.in[16] + o; wd = P.in[17] + o; dgu = (bf16*)(ws + WS_WGU_D + (size_t)set * 2 * FF * DM * (f1 ? 1 : 2)); dd = (bf16*)(ws + WS_WD_D + (size_t)set * DM * FF * (f2 ? 1 : 2)); }
    else { f1 = pg8::F8_M1; f2 = pg8::F8_M2; const size_t o = (size_t)(set - 2) * DM * FF; wg = P.in[19] + o; wu = P.in[20] + o; wd = P.in[21] + o; dgu = (bf16*)(ws + WS_WGU_M + (size_t)(set - 2) * 2 * FF * DM * (f1 ? 1 : 2)); dd = (bf16*)(ws + WS_WD_M + (size_t)(set - 2) * DM * FF * (f2 ? 1 : 2)); }
    if (kind == 0) { if (f1) cvt_item<2, true>(wg, DM, FF, dgu, scr, r, lane, pg8::F8_SW1); else cvt_item<2>(wg, DM, FF, dgu, scr, r, lane); }
    else if (kind == 1) { if (f1) cvt_item<3, true>(wu, DM, FF, dgu, scr, r, lane, pg8::F8_SW1); else cvt_item<3>(wu, DM, FF, dgu, scr, r, lane); }
    else { if (f2) cvt_item<0, true>(wd, FF, DM, dd, scr, r, lane, pg8::F8_SW2); else cvt_item<0>(wd, FF, DM, dd, scr, r, lane); }
}
__device__ __forceinline__ void mod_item(const Frame& F, CArgs ka, int it) {
    const auto& P = ka->p;
    const int l = it / (MODB / 64), cg = it - l * (MODB / 64), col = cg * 64 + F.lane, k0 = F.wave * 128;
    const GAS float* w = (const GAS float*)P.in[3] + (size_t)l * DM * MODB + (size_t)k0 * MODB + col; const float* c = P.in[1] + k0;
    float a0 = 0.f, a1 = 0.f;
#pragma unroll 32
    for (int k = 0; k < 128; ++k) { const float wv = w[(size_t)k * MODB]; const float c0 = c[k], c1 = c[DM + k];
        a0 += (c0 / (1.f + __expf(-c0))) * wv; a1 += (c1 / (1.f + __expf(-c1))) * wv; }
    LAS float* red = (LAS float*)(F.lds + RING_OFF);
    red[(F.wave * 2 + 0) * 64 + F.lane] = a0; red[(F.wave * 2 + 1) * 64 + F.lane] = a1;
    __syncthreads();
    if (F.wave < 2) { float t = P.in[4][l * MODB + col];
#pragma unroll
        for (int w8 = 0; w8 < 8; ++w8) t += red[(w8 * 2 + F.wave) * 64 + F.lane];
        ((float*)(P.ws + WS_MOD))[((size_t)l * 2 + F.wave) * MODB + col] = t; }
    __syncthreads();
}
constexpr int PRO_ITEMS = IT_IN + IT_OUT + IT_SET;
constexpr int Q1 = IT_IN, Q2 = Q1 + IT_OUT, Q3 = Q2 + 8 * IT_SET, Q4 = Q3 + IT_IN, Q5 = Q4 + IT_OUT, Q6 = Q5 + IT_SET, Q7 = Q6 + IT_IN, Q8 = Q7 + IT_OUT, QEND = Q8 + 8 * IT_SET;
constexpr int Q3A = Q2 + 8 * 2 * IT_FF, Q8A = Q8 + 8 * 2 * IT_FF;
static_assert(QEND + PRO_ITEMS == NITEMS, "queue covers every item once");
__device__ __forceinline__ int pro_item(int p) { return p < IT_IN ? p : (p < IT_IN + IT_OUT ? IT_A + (p - IT_IN) : IT_B + (p - IT_IN - IT_OUT)); }
__device__ __forceinline__ int qitem(int q) {
    if (q < Q1) return 1 * IT_IN + q;
    if (q < Q2) return IT_A + 1 * IT_OUT + (q - Q1);
    if (q < Q3) { const int m = q - Q2; if (m < 8 * 2 * IT_FF) return IT_B + (2 + m / (2 * IT_FF)) * IT_SET + m % (2 * IT_FF);
        const int d = m - 8 * 2 * IT_FF; return IT_B + (2 + d / IT_FF) * IT_SET + 2 * IT_FF + d % IT_FF; }
    if (q < Q4) return 2 * IT_IN + (q - Q3);
    if (q < Q5) return IT_A + 2 * IT_OUT + (q - Q4);
    if (q < Q6) return IT_B + 1 * IT_SET + (q - Q5);
    if (q < Q7) return 3 * IT_IN + (q - Q6);
    if (q < Q8) return IT_A + 3 * IT_OUT + (q - Q7);
    { const int m = q - Q8; if (m < 8 * 2 * IT_FF) return IT_B + (10 + m / (2 * IT_FF)) * IT_SET + m % (2 * IT_FF);
      const int d = m - 8 * 2 * IT_FF; return IT_B + (10 + d / IT_FF) * IT_SET + 2 * IT_FF + d % IT_FF; }
}
struct CvtJob { const float* src; bf16* WT; int K, N, n0, k0, map; bool valid; float f8s; };
__device__ __forceinline__ CvtJob make_job(CArgs ka, int q) {
    CvtJob j; j.valid = q < QEND; j.src = nullptr; j.WT = nullptr; j.K = DM; j.N = DM; j.n0 = 0; j.k0 = 0; j.map = 0; j.f8s = 0.f; if (!j.valid) return j;
    const auto& P = ka->p; unsigned char* ws = P.ws; int it = qitem(q), r;
    if (it < IT_A) { const int l = it / IT_IN; r = it - l * IT_IN; j.src = P.in[7] + (size_t)l * DM * INC; j.K = DM; j.N = INC; j.WT = (bf16*)(ws + WS_WIN + (size_t)l * INC * DM * (pg8::F8_IN ? 1 : 2)); j.map = 1; j.f8s = pg8::F8_IN ? pg8::F8_SW1 : 0.f; }
    else if (it < IT_B) { it -= IT_A; const int l = it / IT_OUT; r = it - l * IT_OUT; j.src = P.in[8] + (size_t)l * DM * DM; j.K = DM; j.N = DM; j.WT = (bf16*)(ws + WS_WOUT) + (size_t)l * DM * DM; j.map = 0; }
    else { it -= IT_B; const int set = it / IT_SET; r = it - set * IT_SET; const int kind = r / IT_FF; r -= kind * IT_FF;
        const float *wg, *wu, *wd; bf16 *dgu, *dd;
        bool f1, f2;
        if (set < 2) { f1 = pg8::F8_D1; f2 = pg8::F8_D2; const size_t o = (size_t)set * DM * FF; wg = P.in[15] + o; wu = P.in[16] + o; wd = P.in[17] + o; dgu = (bf16*)(ws + WS_WGU_D + (size_t)set * 2 * FF * DM * (f1 ? 1 : 2)); dd = (bf16*)(ws + WS_WD_D + (size_t)set * DM * FF * (f2 ? 1 : 2)); }
        else { f1 = pg8::F8_M1; f2 = pg8::F8_M2; const size_t o = (size_t)(set - 2) * DM * FF; wg = P.in[19] + o; wu = P.in[20] + o; wd = P.in[21] + o; dgu = (bf16*)(ws + WS_WGU_M + (size_t)(set - 2) * 2 * FF * DM * (f1 ? 1 : 2)); dd = (bf16*)(ws + WS_WD_M + (size_t)(set - 2) * DM * FF * (f2 ? 1 : 2)); }
        if (kind == 0) { j.src = wg; j.K = DM; j.N = FF; j.WT = dgu; j.map = 2; j.f8s = f1 ? pg8::F8_SW1 : 0.f; } else if (kind == 1) { j.src = wu; j.K = DM; j.N = FF; j.WT = dgu; j.map = 3; j.f8s = f1 ? pg8::F8_SW1 : 0.f; } else { j.src = wd; j.K = FF; j.N = DM; j.WT = dd; j.map = 0; j.f8s = f2 ? pg8::F8_SW2 : 0.f; } }
    const int kblk = j.K >> 6, nb = r / kblk, kb = r - nb * kblk; j.k0 = kb * 64; j.n0 = nb * 64;
    return j;
}
__device__ __forceinline__ int rowmap_rt(int map, int n) { return map == 1 ? rowmap<1>(n) : (map == 2 ? rowmap<2>(n) : (map == 3 ? rowmap<3>(n) : n)); }
#define CVT_LOAD(J, tv) do { const GAS float* src_ = (const GAS float*)(J).src + (size_t)(J).k0 * (J).N + (J).n0 + F.lane; const size_t N_ = (size_t)(J).N; \
        _Pragma("unroll") for (int kk = 0; kk < 64; ++kk) tv[kk] = __builtin_nontemporal_load(src_ + (size_t)kk * N_); } while (0)
__device__ __forceinline__ void queue_convert(const Frame& F0, CArgs ka, int limit, int batches, const gu32* stop = nullptr, unsigned stop_at = 0u) {
    Frame F = F0; asm volatile("" : "+v"(F.tid)); F.lane = F.tid & 63;
    gu32* qc = F.ctl + CW_QCTR;
    LAS float* scr = (LAS float*)(F.lds + RING_OFF + F.wave * (64 * 65 * 4));
    volatile LAS int* slot = (volatile LAS int*)(F.lds + LDSCTL_OFF + 16);
    constexpr int SENT = 0x7fffffff;
    __syncthreads();
    if (F.tid == 0) *slot = (int)__hip_atomic_load(qc, __ATOMIC_RELAXED, __HIP_MEMORY_SCOPE_AGENT);
    __syncthreads();
    if (*slot >= limit) return;
#define QC_CLAIM(dst) do { __syncthreads(); \
        if (F.tid == 0) *slot = (stop && __hip_atomic_load(stop, __ATOMIC_RELAXED, __HIP_MEMORY_SCOPE_AGENT) >= stop_at) ? SENT : (int)__hip_atomic_fetch_add(qc, 8u, __ATOMIC_RELAXED, __HIP_MEMORY_SCOPE_AGENT); \
        __syncthreads(); dst = *slot; } while (0)
    int base; QC_CLAIM(base);
    if (base != SENT) {
        CvtJob job = make_job(ka, base + F.wave);
        float tv[64];
        if (job.valid) CVT_LOAD(job, tv);
        for (int nb = 1;; ++nb) {
            int nbase = SENT;
            if (nb < batches && base + 8 < limit) QC_CLAIM(nbase);
            CvtJob nj; nj.valid = false; if (nbase != SENT) nj = make_job(ka, nbase + F.wave);
            if (job.valid) {
#pragma unroll
                for (int kk = 0; kk < 64; ++kk) scr[kk * 65 + F.lane] = tv[kk];
                LDS_WAIT(); asm volatile("" ::: "memory"); }
            if (nj.valid) CVT_LOAD(nj, tv);
            if (job.valid) {
                const int c = F.lane & 7;
#pragma unroll
                for (int j = 0; j < 8; ++j) { const int n = (F.lane >> 3) + 8 * j; const LAS float* sp = scr + (8 * c) * 65 + n;
                    if (job.f8s != 0.f) { const float fs = job.f8s;
                        const unsigned long long o8 = (unsigned long long)pg8::pack4_fp8(sp[0 * 65] * fs, sp[1 * 65] * fs, sp[2 * 65] * fs, sp[3 * 65] * fs) | ((unsigned long long)pg8::pack4_fp8(sp[4 * 65] * fs, sp[5 * 65] * fs, sp[6 * 65] * fs, sp[7 * 65] * fs) << 32);
                        *(GAS unsigned long long*)((GAS unsigned char*)job.WT + (size_t)rowmap_rt(job.map, job.n0 + n) * job.K + job.k0 + 8 * c) = o8; }
                    else { v4u o; o.x = pk2(sp[0 * 65], sp[1 * 65]); o.y = pk2(sp[2 * 65], sp[3 * 65]); o.z = pk2(sp[4 * 65], sp[5 * 65]); o.w = pk2(sp[6 * 65], sp[7 * 65]);
                        *(GAS v4u*)(job.WT + (size_t)rowmap_rt(job.map, job.n0 + n) * job.K + job.k0 + 8 * c) = o; } }
                LDS_WAIT(); asm volatile("" ::: "memory"); }
            if (nbase == SENT) break;
            base = nbase; job = nj;
        }
    }
#undef QC_CLAIM
    __syncthreads();
}
__device__ __forceinline__ void p0_prologue(const Frame& F0, CArgs ka) {
    Frame F = F0; asm volatile("" : "+v"(F.tid)); F.lane = F.tid & 63; const auto& P = ka->p;
    { const int* pos = (const int*)P.in[2]; float* rc = (float*)(P.ws + WS_RC); float* rs = (float*)(P.ws + WS_RS);
      for (int idx = F.vcu * 512 + F.tid; idx < NTOK * 32; idx += F.G * 512) { const int tok = idx >> 5, i = idx & 31; float s, c; sincos_acc((float)pos[tok] * ka->rf.inv[i], s, c); rc[idx] = c; rs[idx] = s; } }
    for (int it = (int)blockIdx.x; it < DEPTH * (MODB / 64); it += F.G) mod_item(F, ka, it);
    LAS float* scr = (LAS float*)(F.lds + RING_OFF + F.wave * (64 * 65 * 4));
    LAS int* ctr = (LAS int*)(F.lds + LDSCTL_OFF);
    const int ipb = (PRO_ITEMS + F.G - 1) / F.G, lo = (int)blockIdx.x * ipb, hi = (lo + ipb < PRO_ITEMS) ? lo + ipb : PRO_ITEMS;
    for (;;) {
        int it = 0; if (F.lane == 0) it = __hip_atomic_fetch_add(ctr, 1, __ATOMIC_RELAXED, __HIP_MEMORY_SCOPE_WORKGROUP);
        it = lo + __builtin_amdgcn_readfirstlane(it);
        if (it >= hi) break;
        convert_item(ka, pro_item(it), scr, F.lane);
    }
    __syncthreads();
}

struct NormArgs {
    const float* xin; float* xout;
    const bf16* xinb; bf16* xoutb;
    const float* g; const float* sh; const float* sc;
    bf16* ha; float* of32;
    const bf16* ys; const float* slot_w; const float* cgate;
    const bf16* ysp; int tail0, tails;
    const float* rw; int* slot_e; int* slot_pos; float* slot_w_out; unsigned* cnt; int* row_list;
    const int* cslot_e; const int* cslot_pos;
    float oscale;
};
template <bool COMBINE, bool MODULATE, bool ROUTER, bool OUT_F32, bool XBF, bool TAILK = false, bool OUT_F8 = false>
__device__ __forceinline__ void norm_phase(const Frame& F0, const NormArgs& A) {
    Frame F = F0; asm volatile("" : "+v"(F.tid)); F.lane = F.tid & 63;
    LAS int* sE = (LAS int*)(F.lds + RING_OFF); LAS int* sR = sE + 128; LAS int* sB = sE + 256;
    for (int rb = F.vcu; rb < NTOK / 64; rb += F.G) {
        const int b = (rb * 64) / SEQ;
        f32x4 gs[4], shv[4], cg[4];
#pragma unroll
        for (int q = 0; q < 4; ++q) { const int col = 4 * F.lane + 256 * q; gs[q] = *(const f32x4*)(A.g + col);
            if (MODULATE) { gs[q] = gs[q] * (1.f + *(const f32x4*)(A.sc + (size_t)b * MODB + col)); shv[q] = *(const f32x4*)(A.sh + (size_t)b * MODB + col); }
            if (COMBINE) cg[q] = *(const f32x4*)(A.cgate + (size_t)b * MODB + col); }
        f32x4 rwv[ROUTER ? 16 : 1][2];
        if (ROUTER) {
#pragma unroll
            for (int q = 0; q < 4; ++q)
#pragma unroll
                for (int t = 0; t < 4; ++t) { const float* wp = A.rw + (size_t)(4 * F.lane + 256 * q + t) * 8; rwv[q * 4 + t][0] = *(const f32x4*)wp; rwv[q * 4 + t][1] = *(const f32x4*)(wp + 4); }
        }
#pragma unroll 1
        for (int j = 0; j < 8; j += 2) {
            const int row0 = rb * 64 + F.wave * 8 + j;
            f32x4 v[2][4];
#pragma unroll
            for (int u = 0; u < 2; ++u) {
                if (XBF) { const GAS unsigned long long* xr = (const GAS unsigned long long*)(A.xinb + (size_t)(row0 + u) * DM) + F.lane;
#pragma unroll
                    for (int q = 0; q < 4; ++q) { const unsigned long long w = xr[64 * q]; const unsigned wl = (unsigned)w, wh = (unsigned)(w >> 32);
                        v[u][q] = (f32x4){__uint_as_float(wl << 16), __uint_as_float(wl & 0xffff0000u), __uint_as_float(wh << 16), __uint_as_float(wh & 0xffff0000u)}; }
                } else { const GAS f32x4* xr = (const GAS f32x4*)(A.xin + (size_t)(row0 + u) * DM) + F.lane;
#pragma unroll
                    for (int q = 0; q < 4; ++q) v[u][q] = xr[64 * q]; } }
            if (COMBINE) {
                unsigned long long ya[2][4], yb[2][4]; float w0[2], w1[2]; int dd0[2], dd1[2];
#pragma unroll
                for (int u = 0; u < 2; ++u) { const int row = row0 + u; const LAS int* tab_ = (const LAS int*)(F.lds + TAB_OFF);
                    const int d0 = tab_[A.cslot_e[row * 2]] + A.cslot_pos[row * 2], d1 = tab_[A.cslot_e[row * 2 + 1]] + A.cslot_pos[row * 2 + 1]; w0[u] = A.slot_w[row * 2]; w1[u] = A.slot_w[row * 2 + 1];
                    dd0[u] = d0; dd1[u] = d1;
                    const GAS unsigned long long* y0 = (const GAS unsigned long long*)(A.ys + (size_t)d0 * DM) + F.lane; const GAS unsigned long long* y1 = (const GAS unsigned long long*)(A.ys + (size_t)d1 * DM) + F.lane;
#pragma unroll
                    for (int q = 0; q < 4; ++q) { ya[u][q] = y0[64 * q]; yb[u][q] = y1[64 * q]; } }
#pragma unroll
                for (int u = 0; u < 2; ++u) { GAS f32x4* xo = (GAS f32x4*)(A.xout + (size_t)(row0 + u) * DM) + F.lane; GAS unsigned long long* xob = (GAS unsigned long long*)(A.xoutb + (size_t)(row0 + u) * DM) + F.lane;
                    f32x4 ta[4], tb[4];
                    if (TAILK) {
#pragma unroll
                        for (int q = 0; q < 4; ++q) { ta[q] = (f32x4){0.f, 0.f, 0.f, 0.f}; tb[q] = ta[q]; }
                        const int t0 = __builtin_amdgcn_readfirstlane(dd0[u]) - A.tail0, t1 = __builtin_amdgcn_readfirstlane(dd1[u]) - A.tail0;
                        if (t0 >= 0) {
#pragma unroll 1
                            for (int k = 0; k < A.tails - 1; ++k) { const GAS unsigned long long* yp = (const GAS unsigned long long*)(A.ysp + ((size_t)k * pg8::TAILROWS + t0) * DM) + F.lane;
#pragma unroll
                                for (int q = 0; q < 4; ++q) { const unsigned long long w = yp[64 * q]; const unsigned wl = (unsigned)w, wh = (unsigned)(w >> 32);
                                    ta[q] = ta[q] + (f32x4){__uint_as_float(wl << 16), __uint_as_float(wl & 0xffff0000u), __uint_as_float(wh << 16), __uint_as_float(wh & 0xffff0000u)}; } } }
                        if (t1 >= 0) {
#pragma unroll 1
                            for (int k = 0; k < A.tails - 1; ++k) { const GAS unsigned long long* yp = (const GAS unsigned long long*)(A.ysp + ((size_t)k * pg8::TAILROWS + t1) * DM) + F.lane;
#pragma unroll
                                for (int q = 0; q < 4; ++q) { const unsigned long long w = yp[64 * q]; const unsigned wl = (unsigned)w, wh = (unsigned)(w >> 32);
                                    tb[q] = tb[q] + (f32x4){__uint_as_float(wl << 16), __uint_as_float(wl & 0xffff0000u), __uint_as_float(wh << 16), __uint_as_float(wh & 0xffff0000u)}; } } }
                    }
#pragma unroll
                    for (int q = 0; q < 4; ++q) {
                        const unsigned al = (unsigned)ya[u][q], ah = (unsigned)(ya[u][q] >> 32), cl = (unsigned)yb[u][q], ch = (unsigned)(yb[u][q] >> 32);
                        f32x4 fa = {__uint_as_float(al << 16), __uint_as_float(al & 0xffff0000u), __uint_as_float(ah << 16), __uint_as_float(ah & 0xffff0000u)};
                        f32x4 fb = {__uint_as_float(cl << 16), __uint_as_float(cl & 0xffff0000u), __uint_as_float(ch << 16), __uint_as_float(ch & 0xffff0000u)};
                        if (TAILK) { fa = fa + ta[q]; fb = fb + tb[q]; }
                        v[u][q] = v[u][q] + cg[q] * (fa * w0[u] + fb * w1[u]);
                        if (!OUT_F32) { if (XBF) xob[64 * q] = (unsigned long long)pk2(v[u][q].x, v[u][q].y) | ((unsigned long long)pk2(v[u][q].z, v[u][q].w) << 32); else xo[64 * q] = v[u][q]; }
                    } }
            }
#pragma unroll
            for (int u = 0; u < 2; ++u) {
                const int row = row0 + u;
                float s = 0.f;
#pragma unroll
                for (int q = 0; q < 4; ++q) s += (v[u][q].x * v[u][q].x + v[u][q].y * v[u][q].y) + (v[u][q].z * v[u][q].z + v[u][q].w * v[u][q].w);
                const float r = 1.f / sqrtf(wave_sum(s) * (1.f / DM) + EPS);
#pragma unroll
                for (int q = 0; q < 4; ++q) {
                    const int col = 4 * F.lane + 256 * q;
                    v[u][q] = v[u][q] * r * gs[q];
                    if (MODULATE) v[u][q] = v[u][q] + shv[q];
                    if (OUT_F32) *(GAS f32x4*)(A.of32 + (size_t)row * DM + col) = (PROBE >= 30) ? v[u][q] * A.oscale : v[u][q];
                    else if (OUT_F8) *(GAS unsigned*)((GAS unsigned char*)A.ha + (size_t)row * DM + col) = pg8::pack4_fp8(v[u][q].x * pg8::F8_SA, v[u][q].y * pg8::F8_SA, v[u][q].z * pg8::F8_SA, v[u][q].w * pg8::F8_SA);
                    else *(GAS unsigned long long*)(A.ha + (size_t)row * DM + col) = (unsigned long long)pk2(v[u][q].x, v[u][q].y) | ((unsigned long long)pk2(v[u][q].z, v[u][q].w) << 32);
                }
                if (ROUTER) {
                    float lg[8];
#pragma unroll
                    for (int e = 0; e < 8; ++e) lg[e] = 0.f;
#pragma unroll
                    for (int q = 0; q < 4; ++q)
#pragma unroll
                        for (int t = 0; t < 4; ++t) { const float hv = v[u][q][t]; const f32x4 w0 = rwv[q * 4 + t][0], w1 = rwv[q * 4 + t][1];
                            lg[0] += hv * w0.x; lg[1] += hv * w0.y; lg[2] += hv * w0.z; lg[3] += hv * w0.w; lg[4] += hv * w1.x; lg[5] += hv * w1.y; lg[6] += hv * w1.z; lg[7] += hv * w1.w; }
#pragma unroll
                    for (int e = 0; e < 8; ++e) lg[e] = wave_sum(lg[e]);
                    if (F.lane == 0) {
                        int e0 = 0; float v0 = lg[0];
#pragma unroll
                        for (int e = 1; e < 8; ++e) if (lg[e] > v0) { v0 = lg[e]; e0 = e; }
                        int e1 = 0; float v1 = -INFINITY;
#pragma unroll
                        for (int e = 0; e < 8; ++e) if (e != e0 && lg[e] > v1) { v1 = lg[e]; e1 = e; }
                        const float p1 = __expf(v1 - v0), inv = 1.f / (1.f + p1);
                        A.slot_w_out[row * 2] = inv; A.slot_w_out[row * 2 + 1] = p1 * inv;
                        sE[(F.wave * 8 + j + u) * 2] = e0; sE[(F.wave * 8 + j + u) * 2 + 1] = e1;
                    }
                }
            }
        }
        if (ROUTER) {
            __syncthreads();
            if (F.tid < 8) { const int e = F.tid; int n = 0; for (int s = 0; s < 128; ++s) if (sE[s] == e) sR[s] = n++;
                sB[e] = n ? (int)__hip_atomic_fetch_add(A.cnt + e, (unsigned)n, __ATOMIC_RELAXED, __HIP_MEMORY_SCOPE_AGENT) : 0; }
            __syncthreads();
            if (F.tid < 128) { const int s = F.tid, tok = rb * 64 + (s >> 1), slot = tok * 2 + (s & 1), e = sE[s], pos = sB[e] + sR[s]; A.slot_e[slot] = e; A.slot_pos[slot] = pos; A.row_list[e * 16384 + pos] = tok; }
            __syncthreads();
        }
    }
}
__device__ __forceinline__ void moe_table(const Frame& F0, const unsigned* cnt) {
    Frame F = F0; asm volatile("" : "+v"(F.tid)); F.lane = F.tid & 63;
    LAS int* tab = (LAS int*)(F.lds + TAB_OFF);
    if (F.tid == 0) { int acc = 0;
        for (int e = 0; e < NE; ++e) { const int c = (int)__hip_atomic_load(cnt + e, __ATOMIC_RELAXED, __HIP_MEMORY_SCOPE_AGENT); tab[e] = acc; tab[160 + e] = c; const int pd = (c + 255) / 256 * 256; for (int ch = acc / 256; ch < (acc + pd) / 256 && ch < NCHUNK_MAX; ++ch) tab[16 + ch] = e; acc += pd; }
        tab[8] = acc / 256 < NCHUNK_MAX ? acc / 256 : NCHUNK_MAX; }
    __syncthreads();
}
__device__ __forceinline__ void gather_phase(const Frame& F0, const bf16* ha, bf16* xs, const int* slot_e, const int* slot_pos, int* dest_of) {
    Frame F = F0; asm volatile("" : "+v"(F.tid)); F.lane = F.tid & 63;
    const LAS int* tab = (const LAS int*)(F.lds + TAB_OFF);
    for (int s = F.vcu * NWAVES + F.wave; s < NTOK * 2; s += F.G * NWAVES) {
        const int tok = s >> 1, e = slot_e[s], dest = tab[e] + slot_pos[s];
        const GAS v4u* src = (const GAS v4u*)(ha + (size_t)tok * DM); GAS v4u* dst = (GAS v4u*)(xs + (size_t)dest * DM);
        const v4u a = src[F.lane], b = src[F.lane + 64]; dst[F.lane] = a; dst[F.lane + 64] = b;
        if (F.lane == 0) dest_of[s] = dest;
    }
}
__device__ __forceinline__ void vt_phase(const Frame& F0, const unsigned char* p8, unsigned char* vt) {
    Frame F = F0; asm volatile("" : "+v"(F.tid)); F.lane = F.tid & 63;
    constexpr int LP = 528;
    LAS unsigned char* tile = (LAS unsigned char*)(F.lds + RING_OFF);
    for (int rb = F.vcu; rb < NTOK / 64; rb += F.G) {
        const int tok0 = rb * 64, b = tok0 / SEQ, t0 = tok0 - b * SEQ;
        __syncthreads();
#pragma unroll
        for (int pss = 0; pss < 4; ++pss) { const int tk = pss * 16 + (F.tid >> 5), ch = F.tid & 31;
            const v4u v = *(const GAS v4u*)(p8 + (size_t)(tok0 + tk) * 1536 + 1024 + ch * 16); *(LAS v4u*)(tile + tk * LP + ch * 16) = v; }
        __syncthreads();
        const int col = F.tid, hh = col >> 7, d = col & 127;
        unsigned w[16];
#pragma unroll
        for (int j = 0; j < 16; ++j) { unsigned acc = 0u;
#pragma unroll
            for (int e = 0; e < 4; ++e) { const int pos = 4 * j + e, hi_ = pos >> 5, tl = (pos >> 4) & 1, r = pos & 15, key = 32 * tl + (r & 3) + 8 * (r >> 2) + 4 * hi_;
                acc |= (unsigned)tile[key * LP + col] << (8 * e); }
            w[j] = acc; }
        GAS v4u* dst = (GAS v4u*)(vt + ((size_t)((b * 4 + hh) * 128 + d)) * SEQ + t0);
#pragma unroll
        for (int q = 0; q < 4; ++q) { v4u o; o.x = w[4 * q]; o.y = w[4 * q + 1]; o.z = w[4 * q + 2]; o.w = w[4 * q + 3]; dst[q] = o; }
    }
    __syncthreads();
}
__device__ __forceinline__ void diff_combine(const Frame& F0, const bf16* od, bf16* att, int b, int h, int q0, float lam, float omli, const float* subg) {
    Frame F = F0; asm volatile("" : "+v"(F.tid)); F.lane = F.tid & 63;
    const float g0 = subg[2 * F.lane], g1 = subg[2 * F.lane + 1];
    for (int j = 0; j < 32; ++j) {
        const int tok = b * SEQ + q0 + F.wave * 32 + j;
        const unsigned w1 = __hip_atomic_load((const unsigned*)(od + (size_t)tok * 512 + h * 128) + F.lane, __ATOMIC_RELAXED, __HIP_MEMORY_SCOPE_AGENT);
        const unsigned w2 = __hip_atomic_load((const unsigned*)(od + ((size_t)NTOK + tok) * 512 + h * 128) + F.lane, __ATOMIC_RELAXED, __HIP_MEMORY_SCOPE_AGENT);
        const float v0 = __uint_as_float(w1 << 16) - lam * __uint_as_float(w2 << 16), v1 = __uint_as_float(w1 & 0xffff0000u) - lam * __uint_as_float(w2 & 0xffff0000u);
        const float r = 1.f / sqrtf(wave_sum(v0 * v0 + v1 * v1) * (1.f / 128.f) + EPS);
        *((GAS unsigned*)(att + (size_t)tok * DM + 512 + h * 128) + F.lane) = pk2(v0 * r * g0 * omli, v1 * r * g1 * omli);
    }
}

#ifndef CONV_NB
#define CONV_NB 64
#endif
#define REP(k) _Pragma("unroll 1") for (int rep_ = 0; rep_ < ((PROBE == (k)) ? 2 : 1); ++rep_)
constexpr int PH_PRO = 0, PH_FINAL = 1 + DEPTH * 10, PH_END = PH_FINAL + 1;
#define WSP(T, off) ((T*)(ws + (off)))
#define IN(k) (lo <= (k) && (k) < hi)
#define SEAM(k) do { if ((k) + 1 < hi) { xcd_barrier(bar); if (PROBE == 12) xcd_barrier(bar); } } while (0)
#define PH() Frame Fp = F; int bx = (int)blockIdx.x; asm volatile("" : "+s"(Fp.G), "+s"(Fp.vcu), "+s"(bx)); constexpr int l = l_, i2 = l_ >> 1; (void)l; (void)i2; (void)bx
template <int L> __device__ __forceinline__ void run_layer(const Frame& F, const XcdBarrier& bar, const int lo, const int hi, unsigned char* lds) {
    constexpr int l_ = L; constexpr int pb = 1 + L * 10; constexpr bool moe = (L & 1) != 0;
        if (IN(pb + 0)) { PH();
            CArgs ka = kargs(); unsigned char* ws = ka->p.ws; const float* ml = WSP(float, WS_MOD) + (size_t)l * 2 * MODB;
            if (l > 0) queue_convert(Fp, ka, l == 1 ? Q2 : (l == 2 ? Q6 : Q8), 1 << 20);
            NormArgs A; A.g = ka->p.in[5] + l * DM; A.sh = ml + 0 * DM; A.sc = ml + 1 * DM; A.ha = WSP(bf16, WS_HA); A.of32 = nullptr;
            A.rw = nullptr; A.slot_e = nullptr; A.slot_pos = nullptr; A.slot_w_out = nullptr; A.cnt = nullptr; A.row_list = nullptr;
            if (l > 0 && ((l - 1) & 1)) {
                unsigned char* pr = ws + WS_ROUTE + (size_t)((l - 1) >> 1) * ROUTE_LAYER;
                A.xin = nullptr; A.xout = nullptr; A.xinb = WSP(bf16, WS_XB); A.xoutb = WSP(bf16, WS_XB); A.ys = WSP(bf16, WS_YS); A.cslot_e = (const int*)pr; A.cslot_pos = (const int*)(pr + 128 * 1024); A.slot_w = (const float*)(pr + 256 * 1024); A.cgate = WSP(float, WS_MOD) + (size_t)(l - 1) * 2 * MODB + 5 * DM;
                moe_table(Fp, (const unsigned*)(F.ctl + CW_CNT + 64 * ((l - 1) >> 1)));
                norm_phase<true, true, false, false, true, false, pg8::F8_IN>(Fp, A);
            } else {
                A.xin = ka->p.in[0]; A.xout = nullptr; A.xinb = WSP(bf16, WS_XB); A.xoutb = nullptr; A.ys = nullptr; A.cslot_e = nullptr; A.cslot_pos = nullptr; A.slot_w = nullptr; A.cgate = nullptr;
                REP(7) norm_phase<false, true, false, false, (L > 0), false, pg8::F8_IN>(Fp, A);
            }
            SEAM(pb + 0);
        }
        if (IN(pb + 1)) { PH();
            CArgs ka = kargs(); unsigned char* ws = ka->p.ws;
            constexpr int nwg = (NTOK / 256) * (INC / 256); const int rounds = (nwg + Fp.G - 1) / Fp.G; int GW = (((nwg + rounds - 1) / rounds) + 7) & ~7; if ((Fp.G & 7) || GW > Fp.G) GW = Fp.G;
            if (bx < GW) {
                constexpr bool FI = pg8::F8_IN;
                pg8::Gemm g{WSP(bf16, WS_HA), (const bf16*)(ws + WS_WIN + (size_t)l * INC * DM * (FI ? 1 : 2)), NTOK, INC, DM}; pg8::StaticOrder S; S.init(NTOK, INC, GW, bx);
                pg8::EpiRope E{WSP(bf16, WS_PROJ), WSP(const float, WS_RC), WSP(const float, WS_RS), FI ? pg8::F8_INV1 : 1.f, pg8::F8_ATT ? ws + WS_PROJ8 : nullptr};
                REP(2) pg8::gemm_phase<pg8::EpiRope, pg8::StaticOrder, true, true, pg8::NoGather, FI>(F.lds + RING_OFF, g, S, E);
                if (GW == Fp.G && (rounds - 1) * Fp.G + bx >= nwg) queue_convert(Fp, kargs(), QEND, 2);
                __syncthreads(); if (threadIdx.x == 0) __hip_atomic_fetch_add(F.ctl + CW_IPDONE + l, 1u, __ATOMIC_RELAXED, __HIP_MEMORY_SCOPE_AGENT);
            } else queue_convert(Fp, kargs(), QEND, CONV_NB, F.ctl + CW_IPDONE + l, (unsigned)GW);
            SEAM(pb + 1);
        }
        if (IN(pb + 2)) { PH();
            if constexpr (pg8::F8_ATT) { CArgs ka = kargs(); unsigned char* ws = ka->p.ws; vt_phase(Fp, ws + WS_PROJ8, ws + WS_VT); if (hi - lo > 1) xcd_barrier(bar); }
            REP(3) for (int su = Fp.vcu; su < 256; su += Fp.G) {
                const int bh = su >> 5, b = bh >> 2, h = bh & 3, q0 = (su & 31) * 256;
#pragma unroll 1
                for (int u2 = 0; u2 < 2; ++u2) {
                    CArgs ka = kargs(); unsigned char* ws = ka->p.ws; const attn_body::bf16* pj = WSP(const attn_body::bf16, WS_PROJ) + (size_t)b * SEQ * INC;
                    const int ln = (int)(threadIdx.x & 63); const float li = ka->lam_init[l];
                    const float lam = __expf(wave_sum(ka->p.in[10][l * 64 + ln] * ka->p.in[11][l * 64 + ln])) - __expf(wave_sum(ka->p.in[12][l * 64 + ln] * ka->p.in[13][l * 64 + ln])) + li;
                    if constexpr (pg8::F8_ATT) attn_body::dattn_unit_f8<8>(ws + WS_PROJ8 + (size_t)b * SEQ * 1536, ws + WS_VT + (size_t)(b * 4 + h) * 128 * SEQ, h,
                        WSP(attn_body::bf16, WS_ATT) + (size_t)b * SEQ * DM + 512 + h * 128, q0 + u2 * 128, lam, 1.f - li, ka->p.in[14] + l * 128, (char*)lds + RING_OFF);
                    else attn_body::dattn_unit<8>(pj + COL_QD + h * 128, pj + COL_KD + h * 128, pj + COL_VD + h * 128,
                        WSP(attn_body::bf16, WS_ATT) + (size_t)b * SEQ * DM + 512 + h * 128, q0 + u2 * 128, lam, 1.f - li, ka->p.in[14] + l * 128, (char*)lds + RING_OFF);
                }
#pragma unroll 1
                for (int i_ = 0; i_ < ((PROBE == 13) ? 6 : 2); ++i_) { const int i = i_ & 1;
                    CArgs ka = kargs(); unsigned char* ws = ka->p.ws; const attn_body::bf16* pj = WSP(const attn_body::bf16, WS_PROJ) + (size_t)b * SEQ * INC;
                    const int hq = 2 * h + i, hkv = hq >> 2;
                    attn_body::attn_unit<8, true>(pj + COL_QA + hq * 64, pj + COL_KA + hkv * 64, pj + COL_VA + hkv * 64,
                        WSP(attn_body::bf16, WS_ATT) + (size_t)b * SEQ * DM + hq * 64, DM, q0, ka->p.in[9][l * 8 + hq] * 1.4426950408889634f, (char*)lds + RING_OFF);
                }
            }
            SEAM(pb + 2);
        }
        if (IN(pb + 3)) { PH();
            CArgs ka = kargs(); unsigned char* ws = ka->p.ws; const float* ml = WSP(float, WS_MOD) + (size_t)l * 2 * MODB;
            pg8::Gemm g{WSP(bf16, WS_ATT), WSP(const bf16, WS_WOUT) + (size_t)l * DM * DM, NTOK, DM, DM}; pg8::StaticOrder S; S.init(NTOK, DM, Fp.G, bx);
            using EpiO = pg8::EpiResGateB<(L == 0)>;
            EpiO E{(l == 0) ? (const void*)ka->p.in[0] : (const void*)WSP(bf16, WS_XB), WSP(pg8::bf16_t, WS_XB), ml + 2 * DM};
            pg8::gemm_phase<EpiO, pg8::StaticOrder, true, true>(F.lds + RING_OFF, g, S, E);
            SEAM(pb + 3);
        }
        if (IN(pb + 4)) { PH();
            CArgs ka = kargs(); unsigned char* ws = ka->p.ws; const float* ml = WSP(float, WS_MOD) + (size_t)l * 2 * MODB;
            unsigned char* route = ws + WS_ROUTE + (size_t)i2 * ROUTE_LAYER;
            NormArgs A; A.xin = nullptr; A.xout = nullptr; A.xinb = WSP(bf16, WS_XB); A.xoutb = nullptr; A.g = ka->p.in[6] + l * DM; A.sh = ml + 3 * DM; A.sc = ml + 4 * DM; A.ha = WSP(bf16, WS_HA); A.of32 = nullptr;
            A.ys = nullptr; A.cslot_e = nullptr; A.cslot_pos = nullptr; A.slot_w = nullptr; A.cgate = nullptr; A.row_list = nullptr;
            if (moe) { A.rw = ka->p.in[18] + (size_t)i2 * DM * NE; A.slot_e = (int*)route; A.slot_pos = (int*)(route + 128 * 1024); A.slot_w_out = (float*)(route + 256 * 1024); A.cnt = (unsigned*)(F.ctl + CW_CNT + 64 * i2); A.row_list = (int*)(route + 512 * 1024); norm_phase<false, true, true, false, true, false, pg8::F8_M1>(Fp, A);
                queue_convert(Fp, ka, l == 1 ? Q3A : Q8A, 1 << 20); }
            else { A.rw = nullptr; A.slot_e = nullptr; A.slot_pos = nullptr; A.slot_w_out = nullptr; A.cnt = nullptr; REP(11) norm_phase<false, true, false, false, true, false, pg8::F8_D1>(Fp, A); }
            SEAM(pb + 4);
        }
        if constexpr (!moe) {
            if (IN(pb + 5)) { PH();
                CArgs ka = kargs(); unsigned char* ws = ka->p.ws;
                constexpr bool F1 = pg8::F8_D1, F2 = pg8::F8_D2;
                pg8::Gemm g{WSP(bf16, WS_HA), (const bf16*)(ws + WS_WGU_D + (size_t)i2 * 2 * FF * DM * (F1 ? 1 : 2)), NTOK, 2 * FF, DM}; pg8::StaticOrder S; S.init(NTOK, 2 * FF, Fp.G, bx);
                if constexpr (F2) { pg8::EpiSwigluF8 E{ws + WS_HMID, FF, F1 ? pg8::F8_INV1 : 1.f, pg8::F8_SH}; REP(4) pg8::gemm_phase<pg8::EpiSwigluF8, pg8::StaticOrder, true, true, pg8::NoGather, F1>(F.lds + RING_OFF, g, S, E); }
                else { pg8::EpiSwiglu E{WSP(bf16, WS_HMID), FF, F1 ? pg8::F8_INV1 : 1.f}; REP(4) pg8::gemm_phase<pg8::EpiSwiglu, pg8::StaticOrder, true, true, pg8::NoGather, F1>(F.lds + RING_OFF, g, S, E); }
                SEAM(pb + 5);
            }
            if (IN(pb + 6)) { PH();
                CArgs ka = kargs(); unsigned char* ws = ka->p.ws; const float* ml = WSP(float, WS_MOD) + (size_t)l * 2 * MODB;
                constexpr bool F2 = pg8::F8_D2;
                pg8::Gemm g{WSP(bf16, WS_HMID), (const bf16*)(ws + WS_WD_D + (size_t)i2 * DM * FF * (F2 ? 1 : 2)), NTOK, DM, FF}; pg8::StaticOrder S; S.init(NTOK, DM, Fp.G, bx);
                using EpiF = pg8::EpiResGateB<false>;
                EpiF E{(const void*)WSP(bf16, WS_XB), WSP(pg8::bf16_t, WS_XB), ml + 5 * DM, F2 ? pg8::F8_INV2 : 1.f};
                pg8::gemm_phase<EpiF, pg8::StaticOrder, true, true, pg8::NoGather, F2>(F.lds + RING_OFF, g, S, E);
                SEAM(pb + 6);
            }
        } else {
            const int* tabp = (const int*)(lds + TAB_OFF);
            if (IN(pb + 6)) { PH();
                CArgs ka = kargs(); unsigned char* ws = ka->p.ws;
                moe_table(Fp, (const unsigned*)(F.ctl + CW_CNT + 64 * i2)); const int nch = tabp[8];
                constexpr bool F1 = pg8::F8_M1, F2 = pg8::F8_M2;
                pg8::Gemm g{WSP(bf16, WS_HA), (const bf16*)(ws + WS_WGU_M + (size_t)i2 * NE * 2 * FF * DM * (F1 ? 1 : 2)), nch * 256, 2 * FF, DM}; pg8::StaticOrder S; S.init(nch * 256, 2 * FF, Fp.G, bx, tabp + 16);
                { const int* rl = (const int*)(ws + WS_ROUTE + (size_t)i2 * ROUTE_LAYER + 512 * 1024); LAS int* idx = (LAS int*)(F.lds + IDX_OFF); const LAS int* tb = (const LAS int*)(F.lds + TAB_OFF);
                  pg8::Unit uu; int tl_ = (int)threadIdx.x; asm volatile("" : "+v"(tl_));
                  for (int i = 0; i < IDX_UNITS && S.next(i, uu); ++i) {
                      const int e = tb[16 + uu.pm], rbase = (uu.pm << 8) - tb[e], cnt_e = tb[160 + e];
                      if (tl_ < 256) { const int rr = rbase + tl_; idx[i * 256 + tl_] = rr < cnt_e ? rl[e * 16384 + rr] : 0; } }
                  __syncthreads(); }
                pg8::LdsGather GA{(const LAS int*)(F.lds + IDX_OFF)};
                if constexpr (F2) { pg8::EpiSwigluF8 E{ws + WS_HMID, FF, F1 ? pg8::F8_INV1 : 1.f, pg8::F8_SH}; REP(5) pg8::gemm_phase<pg8::EpiSwigluF8, pg8::StaticOrder, true, true, pg8::LdsGather, F1>(F.lds + RING_OFF, g, S, E, GA); }
                else { pg8::EpiSwiglu E{WSP(bf16, WS_HMID), FF, F1 ? pg8::F8_INV1 : 1.f}; REP(5) pg8::gemm_phase<pg8::EpiSwiglu, pg8::StaticOrder, true, true, pg8::LdsGather, F1>(F.lds + RING_OFF, g, S, E, GA); }
                queue_convert(Fp, kargs(), l == 1 ? Q3 : QEND, 1 << 20);
                SEAM(pb + 6);
            }
            if (IN(pb + 7)) { PH();
                CArgs ka = kargs(); unsigned char* ws = ka->p.ws;
                moe_table(Fp, (const unsigned*)(F.ctl + CW_CNT + 64 * i2)); const int nch = tabp[8];
                constexpr bool F2 = pg8::F8_M2; constexpr int KT = F2 ? 128 : 64;
                pg8::Gemm g{WSP(bf16, WS_HMID), (const bf16*)(ws + WS_WD_M + (size_t)i2 * NE * DM * FF * (F2 ? 1 : 2)), nch * 256, DM, FF};
                if constexpr (L == DEPTH - 1) {
                    pg8::TailOrder S; S.init(nch, DM, FF * 64 / KT, Fp.G, bx, Fp.vcu, tabp + 16);
                    pg8::EpiBf16T E{WSP(pg8::bf16_t, WS_YS), DM, WSP(pg8::bf16_t, WS_YSP), S.pm0, F2 ? pg8::F8_INV2 : 1.f};
                    pg8::gemm_phase<pg8::EpiBf16T, pg8::TailOrder, true, true, pg8::NoGather, F2>(F.lds + RING_OFF, g, S, E);
                } else {
                    pg8::StaticOrder S; S.init(nch * 256, DM, Fp.G, bx, tabp + 16);
                    pg8::EpiBf16 E{WSP(bf16, WS_YS), DM, F2 ? pg8::F8_INV2 : 1.f};
                    REP(6) pg8::gemm_phase<pg8::EpiBf16, pg8::StaticOrder, true, true, pg8::NoGather, F2>(F.lds + RING_OFF, g, S, E);
                    { const int nwg = nch * (DM / 256), rounds = (nwg + Fp.G - 1) / Fp.G; if ((rounds - 1) * Fp.G + bx >= nwg) queue_convert(Fp, kargs(), QEND, 7); }
                }
                SEAM(pb + 7);
            }
        }
}

__global__ void __launch_bounds__(NWAVES * 64, 2) mk_fwd(Args args_by_value_unused) {
    extern __shared__ __attribute__((aligned(16))) unsigned char lds[];
    Frame F;
    F.lds = (LAS unsigned char*)lds;
    F.MISC = (volatile LAS unsigned*)(F.lds + MISC_OFF);
    F.tid = threadIdx.x; F.lane = F.tid & 63; F.wave = __builtin_amdgcn_readfirstlane(F.tid >> 6);
    F.G = gridDim.x; { const int bx = blockIdx.x; F.vcu = (F.G % 8 == 0) ? (bx % 8) * (F.G / 8) + bx / 8 : bx; }
    int lo, hi_full; { CArgs ka = kargs(); lo = ka->ph_lo; hi_full = ka->ph_hi; F.ctl = (gu32*)(ka->p.ws + WS_CTL); }
    { const int hi = hi_full; (void)hi; }
    for (int u = F.tid; u < (LDS_BYTES - LDSCTL_OFF) / 4; u += NWAVES * 64) ((LAS unsigned*)(F.lds + LDSCTL_OFF))[u] = 0u;
    __syncthreads();
    XcdBarrier bar; bar.bar = (unsigned*)(F.ctl + CW_BAR); bar.x = 0; bar.st = nullptr;
    if (hi_full - lo > 1) bar = xcd_barrier_post((unsigned*)(F.ctl + CW_BAR), F.MISC + 8);
#if PROBE >= 100
    { constexpr int hi = PROBE - 100;
      if (IN(PH_PRO)) { p0_prologue(F, kargs()); SEAM(PH_PRO); }
      run_layer<0>(F, bar, lo, hi, lds); run_layer<1>(F, bar, lo, hi, lds); run_layer<2>(F, bar, lo, hi, lds); run_layer<3>(F, bar, lo, hi, lds);
      xcd_barrier(bar); if (blockIdx.x == 0 && F.tid < 128) F.ctl[CW_CNT + F.tid] = 0u; __syncthreads(); if (F.tid == 0) *(LAS int*)(F.lds + LDSCTL_OFF) = 0; __syncthreads(); }
#endif
    { const int hi = hi_full;
    if (IN(PH_PRO)) { REP(1) { p0_prologue(F, kargs()); if (PROBE == 1) { __syncthreads(); if (F.tid == 0) *(LAS int*)(F.lds + LDSCTL_OFF) = 0; __syncthreads(); } } SEAM(PH_PRO); }

    run_layer<0>(F, bar, lo, hi, lds); run_layer<1>(F, bar, lo, hi, lds); run_layer<2>(F, bar, lo, hi, lds); run_layer<3>(F, bar, lo, hi, lds);
    if (IN(PH_FINAL)) {
        constexpr int l_ = DEPTH; PH();
        CArgs ka = kargs(); unsigned char* ws = ka->p.ws;
        unsigned char* pr = ws + WS_ROUTE + (size_t)((DEPTH - 1) >> 1) * ROUTE_LAYER;
        NormArgs A; A.xin = nullptr; A.xout = nullptr; A.xinb = WSP(bf16, WS_XB); A.xoutb = nullptr; A.g = ka->p.in[22]; A.sh = nullptr; A.sc = nullptr; A.ha = nullptr; A.of32 = ka->p.out;
        A.ys = WSP(bf16, WS_YS); A.cslot_e = (const int*)pr; A.cslot_pos = (const int*)(pr + 128 * 1024); A.slot_w = (const float*)(pr + 256 * 1024); A.cgate = WSP(float, WS_MOD) + (size_t)(DEPTH - 1) * 2 * MODB + 5 * DM;
        moe_table(Fp, (const unsigned*)(F.ctl + CW_CNT + 64 * ((DEPTH - 1) >> 1)));
        A.rw = nullptr; A.slot_e = nullptr; A.slot_pos = nullptr; A.slot_w_out = nullptr; A.cnt = nullptr; A.row_list = nullptr;
        A.oscale = 1.f;
        { int MC, ts; pg8::tail_params(((const LAS int*)(F.lds + TAB_OFF))[8], DM / 256, FF / (pg8::F8_M2 ? 128 : 64), Fp.G, MC, ts); A.ysp = WSP(bf16, WS_YSP); A.tail0 = MC * 256; A.tails = ts; }
        norm_phase<true, false, false, true, true, true>(Fp, A);
    }
    }
#undef IN
#undef SEAM
}

#ifndef MK_PER_PHASE
#define MK_PER_PHASE 0
#endif
extern "C" void kernel_launch(void* const* d_in, const int* in_sizes, int n_in, void* d_out, int out_size, void* d_ws, size_t ws_size, hipStream_t stream) {
    static int grid = 0;
    if (grid == 0) {
        if (n_in != 23 || out_size != NTOK * DM || ws_size < WS_END) { fprintf(stderr, "kernel_launch: unexpected problem (n_in %d out %d ws %zu)\n", n_in, out_size, ws_size); grid = -1; return; }
        int dev = 0, cus = 0, per_cu = 0;
        if (hipGetDevice(&dev) != hipSuccess || hipDeviceGetAttribute(&cus, hipDeviceAttributeMultiprocessorCount, dev) != hipSuccess) { grid = -1; return; }
        if (hipFuncSetAttribute((const void*)mk_fwd, hipFuncAttributeMaxDynamicSharedMemorySize, LDS_BYTES) != hipSuccess) { grid = -1; return; }
        if (hipOccupancyMaxActiveBlocksPerMultiprocessor(&per_cu, (const void*)mk_fwd, NWAVES * 64, LDS_BYTES) != hipSuccess || per_cu < 1) { fprintf(stderr, "kernel_launch: occupancy query reports %d\n", per_cu); }
        (void)hipGetLastError();
        grid = cus;
    }
    if (grid < 0) return;
    if (hipMemsetAsync((char*)d_ws + WS_CTL, 0, CTL_ZERO_BYTES, stream) != hipSuccess) return;
    Args a; memset(&a, 0, sizeof(a));
    for (int i = 0; i < 23; ++i) a.p.in[i] = (const float*)d_in[i];
    a.p.out = (float*)d_out; a.p.ws = (unsigned char*)d_ws;
    for (int i = 0; i < 32; ++i) a.rf.inv[i] = (float)(1.0 / pow(10000.0, (double)((float)(2 * i) / 64.0f)));
    for (int l = 0; l < DEPTH; ++l) a.lam_init[l] = (float)(0.8 - 0.6 * exp(-0.3 * (double)l));
#if MK_PER_PHASE
    for (int ph = 0; ph < PH_END; ++ph) { a.ph_lo = ph; a.ph_hi = ph + 1; hipLaunchKernelGGL(mk_fwd, dim3(grid), dim3(NWAVES * 64), LDS_BYTES, stream, a); }
#else
    a.ph_lo = 0; a.ph_hi = PH_END;
    hipLaunchKernelGGL(mk_fwd, dim3(grid), dim3(NWAVES * 64), LDS_BYTES, stream, a);
#endif
}
```
